# Optimizing an MI355X kernel written in HIP

```python
import math
import jax
import jax.numpy as jnp
from jax import lax
import numpy as np

D_MODEL = 1024
BATCH = 32
SEQ = 2048
DEPTH = 4

CHUNK = 64
Q_BLOCK = 128
EPS = 1e-6

HEAD_DIM = 64
GROUP_HEADS = 4
GROUP_WIDTH = GROUP_HEADS * HEAD_DIM
N_MIXERS = 4
D_MIX = N_MIXERS * GROUP_WIDTH

MLA_HEADS = GROUP_HEADS
MLA_NOPE = 64
MLA_ROPE = 32
MLA_V = HEAD_DIM
MLA_Q_LORA = 192
MLA_KV_LORA = 128
ROPE_THETA = 10000.0

FOX_HEADS = GROUP_HEADS

CONV_CH = GROUP_WIDTH
CONV_WIDTH = 3

DIFF_HEADS = GROUP_HEADS
DIFF_HALF = HEAD_DIM // 2

T5_BUCKETS = 32
T5_MAX_DIST = 128

P_MLA = MLA_Q_LORA + MLA_KV_LORA + MLA_ROPE
P_FOX = 3 * GROUP_WIDTH + FOX_HEADS
P_CONV = 3 * CONV_CH
P_DIFF = 3 * GROUP_WIDTH
P_IN = P_MLA + P_FOX + P_CONV + P_DIFF

N_GROUPS = 8
EXPERTS_PER_GROUP = 8
N_EXPERTS = N_GROUPS * EXPERTS_PER_GROUP
TOP_K = 2
D_EXPERT = 512
MOE_BLOCK = 128
ADA_CHUNKS = 6

kernel_name = 'hybrid_chunk_causal_moe_trunk'


def rms_norm(t, g):
    tf = t.astype(jnp.float32)
    tf = tf * lax.rsqrt(jnp.mean(tf * tf, axis=-1, keepdims=True) + EPS)
    return (tf * g.astype(jnp.float32)).astype(t.dtype)


def to_heads(t, n_heads):
    return t.reshape(t.shape[0], t.shape[1], n_heads, -1).transpose(0, 2, 1, 3)


def from_heads(t):
    b, h, s, d = t.shape
    return t.transpose(0, 2, 1, 3).reshape(b, s, h * d)


def rope(t, positions):
    half = MLA_ROPE // 2
    inv_freq = ROPE_THETA ** (-jnp.arange(half, dtype=jnp.float32) / half)
    ang = positions.astype(jnp.float32)[:, :, None] * inv_freq
    ang = ang.reshape(ang.shape[:2] + (1,) * (t.ndim - 3) + (half,))
    cos, sin = jnp.cos(ang), jnp.sin(ang)
    t1 = t[..., :half].astype(jnp.float32)
    t2 = t[..., half:].astype(jnp.float32)
    return jnp.concatenate([t1 * cos - t2 * sin, t2 * cos + t1 * sin], axis=-1).astype(t.dtype)


def t5_bucket(rel):
    nb = T5_BUCKETS // 2
    max_exact = nb // 2
    bucket = jnp.where(rel > 0, nb, 0)
    n = jnp.abs(rel)
    large = max_exact + (jnp.log(jnp.maximum(n, 1).astype(jnp.float32) / max_exact)
                         / math.log(T5_MAX_DIST / max_exact) * (nb - max_exact)).astype(jnp.int32)
    large = jnp.minimum(large, nb - 1)
    return bucket + jnp.where(n < max_exact, n, large)


def block_causal_attention(q, k, v, scale, bias_fn, frame_causal):
    seq = q.shape[2]
    outs = []
    for q0 in range(0, seq, Q_BLOCK):
        kl = q0 + Q_BLOCK
        logits = jnp.einsum('bhqd,bhkd->bhqk', q[:, :, q0:kl], k[:, :, :kl]).astype(jnp.float32) * scale
        if bias_fn is not None:
            logits = logits + bias_fn(q0, kl)
        qi = jnp.arange(q0, kl)[:, None]
        ki = jnp.arange(kl)[None, :]
        allowed = (ki <= qi) if frame_causal else ((ki // CHUNK) <= (qi // CHUNK))
        logits = jnp.where(allowed, logits, -1e30)
        p = jax.nn.softmax(logits, axis=-1).astype(v.dtype)
        outs.append(jnp.einsum('bhqk,bhkd->bhqd', p, v[:, :, :kl]))
    return jnp.concatenate(outs, axis=2)


def hybrid_mixer(h, positions, t5_table, layer, w_in, q_norm_g, w_uq, kv_norm_g, w_ukv,
                 forget_b, conv_w, diff_lambda, subln_g, w_out):
    bsz, seq, _ = h.shape
    proj = jnp.einsum('bsd,dp->bsp', h, w_in)
    p_mla, p_fox, p_conv, p_diff = jnp.split(
        proj, [P_MLA, P_MLA + P_FOX, P_MLA + P_FOX + P_CONV], axis=-1)

    c_q, c_kv, k_rope = jnp.split(p_mla, [MLA_Q_LORA, MLA_Q_LORA + MLA_KV_LORA], axis=-1)
    q_a = jnp.einsum('bsr,rn->bsn', rms_norm(c_q, q_norm_g), w_uq).reshape(
        bsz, seq, MLA_HEADS, MLA_NOPE + MLA_ROPE)
    kv_a = jnp.einsum('bsr,rn->bsn', rms_norm(c_kv, kv_norm_g), w_ukv).reshape(
        bsz, seq, MLA_HEADS, MLA_NOPE + MLA_V)
    k_rope = rope(k_rope, positions)
    q_a = jnp.concatenate([q_a[..., :MLA_NOPE], rope(q_a[..., MLA_NOPE:], positions)], axis=-1)
    k_a = jnp.concatenate([kv_a[..., :MLA_NOPE],
                           jnp.broadcast_to(k_rope[:, :, None, :], (bsz, seq, MLA_HEADS, MLA_ROPE))], axis=-1)
    v_a = kv_a[..., MLA_NOPE:]
    out_a = block_causal_attention(q_a.transpose(0, 2, 1, 3), k_a.transpose(0, 2, 1, 3),
                                   v_a.transpose(0, 2, 1, 3), (MLA_NOPE + MLA_ROPE) ** -0.5, None, False)

    q_b, k_b, v_b, f_logit = jnp.split(p_fox, [GROUP_WIDTH, 2 * GROUP_WIDTH, 3 * GROUP_WIDTH], axis=-1)
    log_f = jax.nn.log_sigmoid(f_logit.astype(jnp.float32) + forget_b.astype(jnp.float32))
    cum_f = jnp.cumsum(log_f, axis=1).transpose(0, 2, 1)

    def forget_bias(q0, kl):
        return cum_f[:, :, q0:kl, None] - cum_f[:, :, None, :kl]

    out_b = block_causal_attention(to_heads(q_b, FOX_HEADS), to_heads(k_b, FOX_HEADS),
                                   to_heads(v_b, FOX_HEADS), HEAD_DIM ** -0.5, forget_bias, True)

    b_gate, c_gate, u = jnp.split(p_conv, [CONV_CH, 2 * CONV_CH], axis=-1)
    z = jnp.pad(c_gate * u, ((0, 0), (CONV_WIDTH - 1, 0), (0, 0)))
    conv = z[:, CONV_WIDTH - 1:] * conv_w[CONV_WIDTH - 1]
    for tap in range(CONV_WIDTH - 1):
        conv = conv + z[:, tap:tap + seq] * conv_w[tap]
    out_c = b_gate * conv

    q_d, k_d, v_d = jnp.split(p_diff, [GROUP_WIDTH, 2 * GROUP_WIDTH], axis=-1)

    def two_maps(t):
        t = t.reshape(bsz, seq, DIFF_HEADS, 2, DIFF_HALF).transpose(0, 3, 2, 1, 4)
        return t.reshape(bsz, 2 * DIFF_HEADS, seq, DIFF_HALF)

    v_d = to_heads(v_d, DIFF_HEADS)
    lam_init = 0.8 - 0.6 * math.exp(-0.3 * layer)
    lam_par = diff_lambda.astype(jnp.float32)
    lam = jnp.exp(jnp.sum(lam_par[0] * lam_par[1])) - jnp.exp(jnp.sum(lam_par[2] * lam_par[3])) + lam_init

    def t5_bias(q0, kl):
        rel = positions[:, None, :kl] - positions[:, q0:kl, None]
        b = t5_table[t5_bucket(rel)].astype(jnp.float32).transpose(0, 3, 1, 2)
        return jnp.concatenate([b, b], axis=1)

    o_d = block_causal_attention(two_maps(q_d), two_maps(k_d), jnp.concatenate([v_d, v_d], axis=1),
                                 DIFF_HALF ** -0.5, t5_bias, False)
    o_d = o_d[:, :DIFF_HEADS] - lam * o_d[:, DIFF_HEADS:]
    out_d = (rms_norm(o_d, subln_g) * (1.0 - lam_init)).astype(h.dtype)

    mixed = jnp.concatenate([from_heads(out_a), from_heads(out_b), out_c, from_heads(out_d)], axis=-1)
    return jnp.einsum('bsm,md->bsd', mixed, w_out)


def hierarchical_moe(h, rg_w, rg_b, re_w, re_b, w_gate, w_up, w_down):
    bsz, seq, d = h.shape
    xs = h.reshape(-1, d)
    n_tok = xs.shape[0]
    g_logits = jnp.einsum('nd,dg->ng', xs, rg_w).astype(jnp.float32) + rg_b.astype(jnp.float32)
    g_prob = jax.nn.softmax(g_logits, axis=-1)
    grp = jnp.argmax(g_logits, axis=-1).astype(jnp.int32)
    p_grp = jnp.take_along_axis(g_prob, grp[:, None], axis=-1)
    e_logits = (jnp.einsum('nd,de->ne', xs, re_w).astype(jnp.float32) + re_b.astype(jnp.float32)).reshape(
        n_tok, N_GROUPS, EXPERTS_PER_GROUP)
    e_logits = jnp.take_along_axis(e_logits, grp[:, None, None], axis=1)[:, 0]
    top_p, top_i = lax.top_k(jax.nn.softmax(e_logits, axis=-1), TOP_K)
    gates = p_grp * top_p / jnp.sum(top_p, axis=-1, keepdims=True)
    expert = grp[:, None] * EXPERTS_PER_GROUP + top_i.astype(jnp.int32)

    n_assign = n_tok * TOP_K
    e_flat = expert.reshape(n_assign)
    tok_flat = jnp.arange(n_assign, dtype=jnp.int32) // TOP_K
    order = jnp.argsort(e_flat)
    e_sorted = e_flat[order]
    counts = jnp.zeros((N_EXPERTS,), jnp.int32).at[e_flat].add(1)
    starts = jnp.cumsum(counts) - counts
    padded = (counts + MOE_BLOCK - 1) // MOE_BLOCK * MOE_BLOCK
    pad_ends = jnp.cumsum(padded)
    pad_starts = pad_ends - padded
    dest_sorted = pad_starts[e_sorted] + (jnp.arange(n_assign, dtype=jnp.int32) - starts[e_sorted])
    n_blocks = (n_assign + N_EXPERTS * (MOE_BLOCK - 1) + MOE_BLOCK - 1) // MOE_BLOCK
    n_slots = n_blocks * MOE_BLOCK
    slot_tok = jnp.full((n_slots,), n_tok, jnp.int32).at[dest_sorted].set(tok_flat[order])
    xs_pad = jnp.concatenate([xs, jnp.zeros((1, d), xs.dtype)], axis=0)
    x_slots = xs_pad[slot_tok].reshape(n_blocks, MOE_BLOCK, d)
    block_expert = jnp.minimum(
        jnp.searchsorted(pad_ends, jnp.arange(n_blocks, dtype=jnp.int32) * MOE_BLOCK, side='right'),
        N_EXPERTS - 1)

    def expert_block(args):
        xb, e = args
        hid = jax.nn.silu(xb @ w_gate[e]) * (xb @ w_up[e])
        return hid @ w_down[e]

    y_slots = lax.map(expert_block, (x_slots, block_expert)).reshape(n_slots, d)
    dest = jnp.zeros((n_assign,), jnp.int32).at[order].set(dest_sorted).reshape(n_tok, TOP_K)
    y = jnp.einsum('nk,nkd->nd', gates.astype(xs.dtype), y_slots[dest])
    return y.reshape(bsz, seq, d)


def setup_inputs(seed: int = 0) -> dict:
    key = jax.random.key(seed)
    ks = jax.random.split(key, 26)
    f32 = jnp.float32

    def nrm(k, shape, scale):
        return jax.random.normal(k, shape, f32) * scale

    def gain(k, shape):
        return 1.0 + 0.01 * jax.random.normal(k, shape, f32)

    offset = jax.random.randint(ks[2], (BATCH,), 0, 16) * CHUNK
    positions = (offset[:, None] + jnp.arange(SEQ)[None, :]).astype(jnp.int32)
    return {
        'x': nrm(ks[0], (BATCH, SEQ, D_MODEL), 1.0),
        'c': nrm(ks[1], (BATCH, D_MODEL), 1.0),
        'positions': positions,
        't5_table': nrm(ks[3], (T5_BUCKETS, DIFF_HEADS), 0.5),
        'ada_w': nrm(ks[4], (DEPTH, D_MODEL, ADA_CHUNKS * D_MODEL), 0.5 * D_MODEL ** -0.5),
        'ada_b': nrm(ks[5], (DEPTH, ADA_CHUNKS * D_MODEL), 0.02),
        'norm_mix_g': gain(ks[6], (DEPTH, D_MODEL)),
        'norm_ffn_g': gain(ks[7], (DEPTH, D_MODEL)),
        'w_in': nrm(ks[8], (DEPTH, D_MODEL, P_IN), D_MODEL ** -0.5),
        'mla_q_norm_g': gain(ks[9], (DEPTH, MLA_Q_LORA)),
        'mla_w_uq': nrm(ks[10], (DEPTH, MLA_Q_LORA, MLA_HEADS * (MLA_NOPE + MLA_ROPE)), MLA_Q_LORA ** -0.5),
        'mla_kv_norm_g': gain(ks[11], (DEPTH, MLA_KV_LORA)),
        'mla_w_ukv': nrm(ks[12], (DEPTH, MLA_KV_LORA, MLA_HEADS * (MLA_NOPE + MLA_V)), MLA_KV_LORA ** -0.5),
        'fox_forget_b': 2.0 + 0.5 * jax.random.normal(ks[13], (DEPTH, FOX_HEADS), f32),
        'conv_w': nrm(ks[14], (DEPTH, CONV_WIDTH, CONV_CH), CONV_WIDTH ** -0.5),
        'diff_lambda': nrm(ks[15], (DEPTH, 4, DIFF_HALF), 0.1),
        'diff_subln_g': gain(ks[16], (DEPTH, HEAD_DIM)),
        'w_out': nrm(ks[17], (DEPTH, D_MIX, D_MODEL), D_MIX ** -0.5),
        'router_group_w': nrm(ks[18], (DEPTH, D_MODEL, N_GROUPS), D_MODEL ** -0.5),
        'router_group_b': nrm(ks[19], (DEPTH, N_GROUPS), 0.01),
        'router_expert_w': nrm(ks[20], (DEPTH, D_MODEL, N_EXPERTS), D_MODEL ** -0.5),
        'router_expert_b': nrm(ks[21], (DEPTH, N_EXPERTS), 0.01),
        'expert_w_gate': nrm(ks[22], (DEPTH, N_EXPERTS, D_MODEL, D_EXPERT), D_MODEL ** -0.5),
        'expert_w_up': nrm(ks[23], (DEPTH, N_EXPERTS, D_MODEL, D_EXPERT), D_MODEL ** -0.5),
        'expert_w_down': nrm(ks[24], (DEPTH, N_EXPERTS, D_EXPERT, D_MODEL), D_EXPERT ** -0.5),
        'final_norm_g': gain(ks[25], (D_MODEL,)),
    }


def reference(x, c, positions, t5_table, ada_w, ada_b, norm_mix_g, norm_ffn_g, w_in,
              mla_q_norm_g, mla_w_uq, mla_kv_norm_g, mla_w_ukv, fox_forget_b, conv_w,
              diff_lambda, diff_subln_g, w_out, router_group_w, router_group_b,
              router_expert_w, router_expert_b, expert_w_gate, expert_w_up, expert_w_down,
              final_norm_g):
    cond = jax.nn.silu(c)
    for layer in range(DEPTH):
        mod = jnp.einsum('bd,dm->bm', cond, ada_w[layer]) + ada_b[layer]
        sh_m, sc_m, g_m, sh_f, sc_f, g_f = [m[:, None, :] for m in jnp.split(mod, ADA_CHUNKS, axis=-1)]
        h = rms_norm(x, norm_mix_g[layer]) * (1.0 + sc_m) + sh_m
        x = x + g_m * hybrid_mixer(h, positions, t5_table, layer, w_in[layer],
                                   mla_q_norm_g[layer], mla_w_uq[layer], mla_kv_norm_g[layer],
                                   mla_w_ukv[layer], fox_forget_b[layer], conv_w[layer],
                                   diff_lambda[layer], diff_subln_g[layer], w_out[layer])
        h = rms_norm(x, norm_ffn_g[layer]) * (1.0 + sc_f) + sh_f
        x = x + g_f * hierarchical_moe(h, router_group_w[layer], router_group_b[layer],
                                       router_expert_w[layer], router_expert_b[layer],
                                       expert_w_gate[layer], expert_w_up[layer], expert_w_down[layer])
    return rms_norm(x, final_norm_g)
```

```cpp
#include <hip/hip_runtime.h>
#include <cstdio>
#include <cstdint>

#ifndef MK_MULTI
#define MK_MULTI 0
#endif

#define GAS __attribute__((address_space(1)))
#define LAS __attribute__((address_space(3)))
typedef unsigned short bf16;
typedef unsigned v4u __attribute__((ext_vector_type(4)));
typedef unsigned v2u __attribute__((ext_vector_type(2)));
typedef float f32x4 __attribute__((ext_vector_type(4)));
typedef float f32x2 __attribute__((ext_vector_type(2)));
typedef float f32x16 __attribute__((ext_vector_type(16)));
typedef short bf16x8 __attribute__((ext_vector_type(8)));
typedef short s16x4 __attribute__((ext_vector_type(4)));
typedef int i32x4 __attribute__((ext_vector_type(4)));
typedef GAS unsigned gu32;

constexpr int NB = 32, SEQ = 2048, DM = 1024, NTOK = NB * SEQ, DEPTH = 4;
constexpr int P_IN = 2660, PN = 2816;
constexpr int PC_CKV = 256, PC_KROPE = 384, PC_FOX = 512, PC_CONV = 1280, PC_DIFF = 2048;
constexpr int SRC_CKV = 192, SRC_KROPE = 320, SRC_FOX = 352, SRC_FLOG = 1120, SRC_CONV = 1124, SRC_DIFF = 1892;
constexpr int KUP = 384, NUP = 1024;
constexpr int NEXP = 64, DEXP = 512, NLOG = 80;
constexpr int MAXMB = 576, MAXSLOT = MAXMB * 256;
constexpr float EPS = 1e-6f, LOG2E = 1.4426950408889634f;
constexpr int NPHASE = 2 + 8 * DEPTH;

constexpr size_t MiB = 1u << 20;
constexpr size_t WS_CTL = 0, CTL_ZERO_BYTES = 1 * MiB;
constexpr size_t WS_MOD = 1 * MiB;
constexpr size_t WS_T5 = 4 * MiB;
constexpr size_t WS_LAM = 4 * MiB + 64 * 1024;
constexpr size_t WS_WF = 4 * MiB + 128 * 1024;
constexpr size_t WS_WRT = 4 * MiB + 256 * 1024;
constexpr size_t WS_FLOG = 5 * MiB + 512 * 1024;
constexpr size_t WS_FB = 7 * MiB;
constexpr size_t WS_DEST = 8 * MiB;
constexpr size_t WS_GATE = 9 * MiB;
constexpr size_t WS_LIST = 10 * MiB;
constexpr size_t WS_WIN = 26 * MiB;
constexpr size_t WS_WUP = 48 * MiB;
constexpr size_t WS_WOUT = 51 * MiB;
constexpr size_t WS_WGU = 59 * MiB;
constexpr size_t WS_WD = 571 * MiB;
constexpr size_t WS_H = 827 * MiB;
constexpr size_t WS_PROJ = 955 * MiB;
constexpr size_t WS_MLA = 1307 * MiB;
constexpr size_t WS_MIX = 1435 * MiB;
constexpr size_t WS_END = 1563 * MiB;
constexpr size_t WS_Y = WS_PROJ, WS_HID = WS_MLA;
static_assert((size_t)MAXSLOT * 1024 * 2 <= WS_MLA - WS_PROJ && (size_t)MAXSLOT * 512 * 2 <= WS_END - WS_MLA, "overlays fit");
constexpr int CW_TMO = 0, CW_CODE = 1, CW_BAR = 4096, CW_Q = 8192  , CW_GCNT = 12288  ;

constexpr int RING_OFF = 0, RING_BYTES = 131072;
constexpr int TAB_OFF = RING_BYTES, TAB_BYTES = 16384;
constexpr int UT_OFF = TAB_OFF + TAB_BYTES;
constexpr int MISC_OFF = UT_OFF + 1024;
constexpr int LDS_BYTES = MISC_OFF + 128;
static_assert(LDS_BYTES <= 160 * 1024, "LDS");

#define RLX_AGENT __ATOMIC_RELAXED, __HIP_MEMORY_SCOPE_AGENT
#define LDS_WAIT() asm volatile("s_waitcnt lgkmcnt(0)" ::: "memory")
#define VM_WAIT() asm volatile("s_waitcnt vmcnt(0)" ::: "memory")
__device__ __forceinline__ unsigned f2bf(float f) { unsigned u = __builtin_bit_cast(unsigned, f); return (u + 0x7fffu + ((u >> 16) & 1u)) >> 16; }
__device__ __forceinline__ unsigned pk2(float lo, float hi) { return f2bf(lo) | (f2bf(hi) << 16); }
__device__ __forceinline__ float bflo(unsigned w) { return __builtin_bit_cast(float, w << 16); }
__device__ __forceinline__ float bfhi(unsigned w) { return __builtin_bit_cast(float, w & 0xffff0000u); }
__device__ __forceinline__ float bf2f(bf16 h) { return __builtin_bit_cast(float, (unsigned)h << 16); }
__device__ __forceinline__ float shx(float v, int o, int lane) { return __builtin_bit_cast(float, __builtin_amdgcn_ds_bpermute((lane ^ o) << 2, __builtin_bit_cast(int, v))); }
__device__ __forceinline__ float wave_sum(float v, int lane) {
#pragma unroll
    for (int o = 1; o < 64; o <<= 1) v += shx(v, o, lane);
    return v;
}
__device__ __forceinline__ int opq(int v) { asm volatile("" : "+v"(v)); return v; }
__device__ __forceinline__ float fast_exp2(float x) { return __builtin_amdgcn_exp2f(x); }
__device__ __forceinline__ float fast_rcp(float x) { return __builtin_amdgcn_rcpf(x); }
__device__ __forceinline__ float fast_rsq(float x) { return __builtin_amdgcn_rsqf(x); }
__device__ __forceinline__ float silu_f(float x) { return x * fast_rcp(1.f + fast_exp2(-x * LOG2E)); }

#define XB_TMO      128
#define XB_XCNT(j)  (256  + 64 * (j))
#define XB_XSUB(j)  (1280 + 64 * (j))
#define XB_XGEN(j)  (2304 + 64 * (j))
#define XB_TOP      3328
#define XB_TOPGEN   3392
#define XCD_BAR_WORDS 3456
#define XB_SPIN_CAP (1u << 22)
__device__ __forceinline__ unsigned xb_ld(unsigned* p)              { return __hip_atomic_load(p, __ATOMIC_RELAXED, __HIP_MEMORY_SCOPE_AGENT); }
__device__ __forceinline__ unsigned xb_add(unsigned* p, unsigned v) { return __hip_atomic_fetch_add(p, v, __ATOMIC_RELAXED, __HIP_MEMORY_SCOPE_AGENT); }
__device__ __forceinline__ unsigned xb_xcc_id() { return (unsigned)__builtin_amdgcn_s_getreg((3 << 11) | 20) & 0xFu; }
#define XB_SPIN(cond, bar) do { unsigned _sp = 0; while (cond) { __builtin_amdgcn_s_sleep(1); \
    if ((++_sp & 255u) == 0u) { if (xb_ld(&(bar)[XB_TMO])) break; if (_sp > XB_SPIN_CAP) { atomicAdd(&(bar)[XB_TMO], 1u); break; } } } } while (0)
struct XcdBarrier { unsigned* bar; unsigned x; volatile LAS unsigned* st; };
__device__ __forceinline__ XcdBarrier xcd_barrier_post(unsigned* bar, volatile LAS unsigned* st) {
    XcdBarrier b; b.bar = bar; b.x = xb_xcc_id(); b.st = st;
    if (threadIdx.x == 0) (void)xb_add(&bar[XB_XCNT(b.x)], 1u);
    return b;
}
__device__ __forceinline__ void xcd_barrier_complete(unsigned* bar, unsigned x, unsigned& nloc, unsigned& nx) {
    const unsigned G = gridDim.x * gridDim.y * gridDim.z;
    unsigned sum, cnt, mine, sp = 0u;
    for (;;) {
        sum = 0u; cnt = 0u; mine = 0u;
#pragma nounroll
        for (unsigned j = 0; j < 16; ++j) { const unsigned c = xb_ld(&bar[XB_XCNT(j)]); sum += c; cnt += (c > 0u) ? 1u : 0u; mine = (j == x) ? c : mine; }
        if (sum == G) break;
        __builtin_amdgcn_s_sleep(1);
        if ((++sp & 255u) == 0u) { if (xb_ld(&bar[XB_TMO])) break; if (sp > XB_SPIN_CAP) { atomicAdd(&bar[XB_TMO], 1u); break; } }
    }
    nloc = mine > 0u ? mine : 1u; nx = cnt > 0u ? cnt : 1u;
}
__device__ __forceinline__ void xcd_barrier(const XcdBarrier& b) {
    asm volatile("s_waitcnt vmcnt(0)" ::: "memory");
    __syncthreads();
    if (threadIdx.x == 0) {
        unsigned* bar = b.bar;
        __builtin_amdgcn_s_waitcnt(0);
        unsigned nloc = b.st[0], nx = b.st[1];
        if (nloc == 0u) { xcd_barrier_complete(bar, b.x, nloc, nx); b.st[0] = nloc; b.st[1] = nx; }
        const unsigned old = xb_add(&bar[XB_XSUB(b.x)], 1u);
        const unsigned gen = old / nloc;
        if (old + 1u == (gen + 1u) * nloc) {
            __builtin_amdgcn_fence(__ATOMIC_RELEASE, "agent");
            asm volatile("s_waitcnt vmcnt(0)" ::: "memory");
            const unsigned og = xb_add(&bar[XB_TOP], 1u);
            const unsigned tg = og / nx;
            if (og + 1u == (tg + 1u) * nx) xb_add(&bar[XB_TOPGEN], 1u);
            else XB_SPIN(xb_ld(&bar[XB_TOPGEN]) == tg, bar);
            __builtin_amdgcn_fence(__ATOMIC_ACQUIRE, "agent");
            xb_add(&bar[XB_XGEN(b.x)], 1u);
            asm volatile("s_waitcnt vmcnt(0)" ::: "memory");
        } else {
            XB_SPIN(xb_ld(&bar[XB_XGEN(b.x)]) == gen, bar);
            __builtin_amdgcn_fence(__ATOMIC_ACQUIRE, "agent");
            asm volatile("s_waitcnt vmcnt(0)" ::: "memory");
        }
    }
    __syncthreads();
}

namespace pg8 {
constexpr int BM = 256, BK = 64, HALF = 128, HTB = HALF * BK * 2, NXCD = 8, WGM = 8;
__host__ __device__ __forceinline__ int lds_byte(int r, int c) { const int st = (r >> 4) * 2 + (c >> 5), rr = r & 15, cc = c & 31, ob = rr * 64 + cc * 2; return st * 1024 + (ob ^ (((ob >> 9) & 1) << 5)); }
__host__ __device__ __forceinline__ void stage_rc(int b, int& R, int& C) { const int st = b / 1024, sb = b % 1024, swz = sb ^ (((sb >> 9) & 1) << 5); R = (st >> 1) * 16 + swz / 64; C = (st & 1) * 32 + (swz % 64) / 2; }
__host__ __device__ __forceinline__ int perm32(int rho) { const int n = rho >> 4, i = rho & 15; return 8 * (i >> 2) + 4 * n + (i & 3); }
struct Unit { int pm, pn, aux; };
struct Gemm { const bf16* A; const bf16* Bt; int K; int lda; };

struct StaticOrder {
    int nM, nN, nwg, G, c;
    __device__ void init(int M, int N, int G_, int c_) { nM = M / BM; nN = N / BM; nwg = nM * nN; G = G_; c = c_; }
    __device__ __forceinline__ bool next(int i, Unit& u) const {
        const long L = (long)i * G + c; if (L >= nwg) return false;
        int wgid = (int)L; { const int q = nwg / NXCD, r = nwg % NXCD, xcd = wgid % NXCD, off = wgid / NXCD; wgid = (xcd < r ? xcd * (q + 1) : r * (q + 1) + (xcd - r) * q) + off; }
        const int nig = WGM * nN, gid = wgid / nig, fm = gid * WGM, gsz = (nM - fm) < WGM ? (nM - fm) : WGM;
        u.pm = fm + ((wgid % nig) % gsz); u.pn = (wgid % nig) / gsz; u.aux = 0; return true;
    }
    __device__ __forceinline__ unsigned tok(const Unit&, int) const { return 0u; }
};
struct PanelOrder {
    int pm, nN;
    __device__ __forceinline__ bool next(int i, Unit& u) const { if (i >= nN) return false; int p_ = pm; asm volatile("" : "+s"(p_)); u.pm = p_; u.pn = i; u.aux = 0; return true; }
    __device__ __forceinline__ unsigned tok(const Unit&, int) const { return 0u; }
};
struct TableOrder {
    const LAS int* ut; const LAS unsigned* tokt; int n;
    __device__ __forceinline__ bool next(int i, Unit& u) const { if (i >= n) return false; const i32x4 d = *(const LAS i32x4*)(ut + 4 * i); u.pm = __builtin_amdgcn_readfirstlane(d.x); u.pn = __builtin_amdgcn_readfirstlane(d.y); u.aux = __builtin_amdgcn_readfirstlane(d.z); return true; }
    __device__ __forceinline__ unsigned tok(const Unit& u, int slot) const { return tokt[u.aux * 256 + slot]; }
};

__device__ __forceinline__ unsigned cvt_pk_bf16(float lo, float hi) { unsigned r; asm volatile("v_cvt_pk_bf16_f32 %0, %1, %2" : "=v"(r) : "v"(lo), "v"(hi)); return r; }

template <class Epi, class Sched, bool ALIGN_EPI, bool GATHER>
__device__ __forceinline__ void gemm_phase(LAS unsigned char* lds, const Gemm g, const Sched& S, const Epi& E, const int tid_in) {
    const int tid = opq(tid_in), wid = __builtin_amdgcn_readfirstlane(tid >> 6), lane = tid & 63, wr = wid >> 2, wc = wid & 3, fr = lane & 15, fq = lane >> 4;
    const int K = g.K, nt = K / BK, lda = g.lda;
    unsigned voffA[2], voffB[2]; int RA[2]; unsigned CA[2];
    const size_t kstep = (size_t)(BK * 2);
    const size_t hstepA = (size_t)HALF * lda * 2, hstepB = (size_t)HALF * K * 2;
    const size_t tstepA = 2 * hstepA, tstepB = 2 * hstepB;
#pragma unroll
    for (int i = 0; i < 2; ++i) { int R, C; stage_rc(tid * 16 + i * 8192, R, C); const int Rb = Epi::PERM ? ((R & ~31) + perm32(R & 31)) : R;
        RA[i] = R; CA[i] = (unsigned)C * 2u; voffB[i] = (unsigned)(Rb * K + C) * 2u; voffA[i] = (unsigned)(R * lda + C) * 2u; }
    const unsigned ldsw = (unsigned)wid * 1024u;
    const int aoff = lds_byte(wr * 64 + fr, fq * 8), boff = lds_byte(wc * 32 + fr, fq * 8);
#define PG8_SA(b, h) (((b) * 2 + (h)) * HTB)
#define PG8_SB(b, h) ((4 + (b) * 2 + (h)) * HTB)
#define PG8_GLDS(gp, bufoff, _i) __builtin_amdgcn_global_load_lds((const unsigned*)(gp), (LAS unsigned*)(lds + (bufoff) + ldsw + (_i) * 8192), 16, 0, 0)
#define PG8_STAGE_B(bufoff, gbase) do { _Pragma("unroll") for (int _i = 0; _i < 2; ++_i) PG8_GLDS((const char*)(gbase) + voffB[_i], bufoff, _i); } while (0)
#define PG8_STAGE_A(bufoff, gbase, OA, h) do { _Pragma("unroll") for (int _i = 0; _i < 2; ++_i) { if constexpr (GATHER) PG8_GLDS((const char*)(gbase) + OA[h][_i], bufoff, _i); else PG8_GLDS((const char*)(gbase) + (size_t)(h) * hstepA + voffA[_i], bufoff, _i); } } while (0)
#define PG8_LDA(dst, b, h) do { _Pragma("unroll") for (int m = 0; m < 4; ++m) _Pragma("unroll") for (int k = 0; k < 2; ++k) dst[m][k] = *(const LAS bf16x8*)(lds + PG8_SA(b, h) + aoff + m * 2048 + k * 1024); } while (0)
#define PG8_LDB(dst, b, h) do { _Pragma("unroll") for (int n = 0; n < 2; ++n) _Pragma("unroll") for (int k = 0; k < 2; ++k) dst[n][k] = *(const LAS bf16x8*)(lds + PG8_SB(b, h) + boff + n * 2048 + k * 1024); } while (0)
#define PG8_MMA(ai, bj, At, Bt) do { __builtin_amdgcn_s_setprio(1); _Pragma("unroll") for (int m = 0; m < 4; ++m) _Pragma("unroll") for (int n = 0; n < 2; ++n) _Pragma("unroll") for (int k = 0; k < 2; ++k) \
        acc[ai][bj][m][n] = __builtin_amdgcn_mfma_f32_16x16x32_bf16(Bt[n][k], At[m][k], acc[ai][bj][m][n], 0, 0, 0); __builtin_amdgcn_s_setprio(0); } while (0)
#define PG8_WAIT_V(n) asm volatile("s_waitcnt vmcnt(" #n ")" ::: "memory")
#define PG8_WAIT_L(n) asm volatile("s_waitcnt lgkmcnt(" #n ")" ::: "memory")
#define PG8_BAR __builtin_amdgcn_s_barrier()
#define PG8_SCHED __builtin_amdgcn_sched_barrier(0)
#define PG8_SETOA(OA, U) do { _Pragma("unroll") for (int _h = 0; _h < 2; ++_h) _Pragma("unroll") for (int _i = 0; _i < 2; ++_i) \
        OA[_h][_i] = GATHER ? (S.tok(U, _h * HALF + RA[_i]) * (unsigned)lda * 2u + CA[_i]) : 0u; } while (0)
    Unit cur, nxt; int ui = 0;
    if (!S.next(0, cur)) return;
    f32x4 acc[2][2][4][2];
#pragma unroll
    for (int a = 0; a < 2; ++a)
#pragma unroll
        for (int b = 0; b < 2; ++b)
#pragma unroll
            for (int m = 0; m < 4; ++m)
#pragma unroll
                for (int n = 0; n < 2; ++n) acc[a][b][m][n] = (f32x4){0.f, 0.f, 0.f, 0.f};
    bf16x8 At[4][2], B0[2][2], B1[2][2];
    unsigned oc[2][2], on[2][2];
    PG8_SETOA(oc, cur);
    const char* cA = (const char*)g.A + (GATHER ? (size_t)0 : (size_t)cur.pm * tstepA); const char* cB = (const char*)g.Bt + (size_t)cur.pn * tstepB;
    PG8_STAGE_B(PG8_SB(0, 0), cB); PG8_STAGE_B(PG8_SB(0, 1), cB + hstepB); PG8_STAGE_A(PG8_SA(0, 0), cA, oc, 0); PG8_STAGE_A(PG8_SA(0, 1), cA, oc, 1);
    if (wr == 1) PG8_BAR;
    PG8_WAIT_V(2); PG8_BAR;
    PG8_STAGE_B(PG8_SB(1, 0), cB + kstep); PG8_STAGE_A(PG8_SA(1, 0), cA + kstep, oc, 0); PG8_STAGE_B(PG8_SB(1, 1), cB + hstepB + kstep);
    PG8_WAIT_V(6); PG8_BAR;
    for (;;) {
        const bool has_next = S.next(ui + 1, nxt);
        const char* nA = has_next ? (const char*)g.A + (GATHER ? (size_t)0 : (size_t)nxt.pm * tstepA) : cA; const char* nB = has_next ? (const char*)g.Bt + (size_t)nxt.pn * tstepB : cB;
        if (has_next) { PG8_SETOA(on, nxt); } else {
#pragma unroll
            for (int _h = 0; _h < 2; ++_h)
#pragma unroll
                for (int _i = 0; _i < 2; ++_i) on[_h][_i] = oc[_h][_i]; }
#pragma nounroll
        for (int t = 0; t < nt; t += 2) {
            const bool last = (t == nt - 2);
            const char* a1 = cA + (size_t)(t + 1) * kstep;
            const char* a2 = last ? nA : cA + (size_t)(t + 2) * kstep; const char* b2 = last ? nB : cB + (size_t)(t + 2) * kstep;
            const char* a3 = a2 + kstep; const char* b3 = b2 + kstep;
            unsigned o2[2][2];
#pragma unroll
            for (int _h = 0; _h < 2; ++_h)
#pragma unroll
                for (int _i = 0; _i < 2; ++_i) o2[_h][_i] = last ? on[_h][_i] : oc[_h][_i];
            PG8_LDB(B0, 0, 0); PG8_LDB(B1, 0, 1); PG8_SCHED; PG8_LDA(At, 0, 0); PG8_STAGE_A(PG8_SA(1, 1), a1, oc, 1);
            PG8_WAIT_V(8); PG8_WAIT_L(0); PG8_BAR; PG8_MMA(0, 0, At, B0); PG8_MMA(0, 1, At, B1); PG8_BAR; PG8_SCHED;
            PG8_LDA(At, 0, 1); PG8_STAGE_B(PG8_SB(0, 0), b2); PG8_STAGE_B(PG8_SB(0, 1), b2 + hstepB); PG8_STAGE_A(PG8_SA(0, 0), a2, o2, 0);
            PG8_WAIT_V(8); PG8_WAIT_L(0); PG8_BAR; PG8_MMA(1, 0, At, B0); PG8_MMA(1, 1, At, B1); PG8_BAR; PG8_SCHED;
            PG8_LDB(B0, 1, 0); PG8_LDB(B1, 1, 1); PG8_SCHED; PG8_LDA(At, 1, 0); PG8_STAGE_A(PG8_SA(0, 1), a2, o2, 1);
            PG8_WAIT_V(8); PG8_WAIT_L(0); PG8_BAR; PG8_MMA(0, 0, At, B0); PG8_MMA(0, 1, At, B1); PG8_BAR; PG8_SCHED;
            PG8_LDA(At, 1, 1); PG8_STAGE_B(PG8_SB(1, 0), b3); PG8_STAGE_B(PG8_SB(1, 1), b3 + hstepB); PG8_STAGE_A(PG8_SA(1, 0), a3, o2, 0);
            PG8_WAIT_V(8); PG8_WAIT_L(0); PG8_BAR; PG8_MMA(1, 0, At, B0); PG8_MMA(1, 1, At, B1); PG8_BAR; PG8_SCHED;
        }
        if constexpr (ALIGN_EPI) { if (wr == 0) PG8_BAR; }
        E(acc, cur, wr, wc, fr, fq);
        if (!has_next) break;
#pragma unroll
        for (int a = 0; a < 2; ++a)
#pragma unroll
            for (int b = 0; b < 2; ++b)
#pragma unroll
                for (int m = 0; m < 4; ++m)
#pragma unroll
                    for (int n = 0; n < 2; ++n) acc[a][b][m][n] = (f32x4){0.f, 0.f, 0.f, 0.f};
        cur = nxt; cA = nA; cB = nB; ++ui;
#pragma unroll
        for (int _h = 0; _h < 2; ++_h)
#pragma unroll
            for (int _i = 0; _i < 2; ++_i) oc[_h][_i] = on[_h][_i];
        if constexpr (ALIGN_EPI) { if (wr == 1) PG8_BAR; }
    }
    PG8_WAIT_V(0);
    if constexpr (!ALIGN_EPI) { if (wr == 0) PG8_BAR; }
    PG8_BAR;
#undef PG8_SA
#undef PG8_SB
#undef PG8_GLDS
#undef PG8_STAGE_A
#undef PG8_STAGE_B
#undef PG8_LDA
#undef PG8_LDB
#undef PG8_MMA
#undef PG8_WAIT_V
#undef PG8_WAIT_L
#undef PG8_BAR
#undef PG8_SCHED
#undef PG8_SETOA
}
}

struct Args { const void* in[26]; float* out; unsigned char* ws; int ph_lo, ph_hi; };
typedef const __attribute__((address_space(4))) Args CArgs;
struct Frame {
    LAS unsigned char* lds;
    volatile LAS unsigned* MISC;
    gu32* ctl;
    int tid, lane, wave, G, c;
    unsigned char* ws; float* out;
};
#define IN_x ((const float*)A.in[0])
#define IN_cnd ((const float*)A.in[1])
#define IN_pos ((const int*)A.in[2])
#define IN_t5 ((const float*)A.in[3])
#define IN_ada_w ((const float*)A.in[4])
#define IN_ada_b ((const float*)A.in[5])
#define IN_g_mix ((const float*)A.in[6])
#define IN_g_ffn ((const float*)A.in[7])
#define IN_w_in ((const float*)A.in[8])
#define IN_gq ((const float*)A.in[9])
#define IN_w_uq ((const float*)A.in[10])
#define IN_gkv ((const float*)A.in[11])
#define IN_w_ukv ((const float*)A.in[12])
#define IN_fb ((const float*)A.in[13])
#define IN_conv_w ((const float*)A.in[14])
#define IN_dlam ((const float*)A.in[15])
#define IN_subln ((const float*)A.in[16])
#define IN_w_out ((const float*)A.in[17])
#define IN_rg_w ((const float*)A.in[18])
#define IN_rg_b ((const float*)A.in[19])
#define IN_re_w ((const float*)A.in[20])
#define IN_re_b ((const float*)A.in[21])
#define IN_wg ((const float*)A.in[22])
#define IN_wu ((const float*)A.in[23])
#define IN_wd ((const float*)A.in[24])
#define IN_g_fin ((const float*)A.in[25])
#define WSP(T, off) ((T*)(F.ws + (off)))

template <class Fn>
__device__ __forceinline__ void transpose_item(const Fn& f, bf16* dst, int ldd, int k0, int n0, LAS float* scr, int lane) {
    const int nq = lane & 15, kr = lane >> 4;
    f32x4 v[16];
#pragma unroll
    for (int i = 0; i < 16; ++i) v[i] = f(k0 + 4 * i + kr, n0 + 4 * nq);
#pragma unroll
    for (int i = 0; i < 16; ++i) { const int k = 4 * i + kr;
        scr[(4 * nq + 0) * 65 + k] = v[i].x; scr[(4 * nq + 1) * 65 + k] = v[i].y; scr[(4 * nq + 2) * 65 + k] = v[i].z; scr[(4 * nq + 3) * 65 + k] = v[i].w; }
    LDS_WAIT(); asm volatile("" ::: "memory");
    const int kc = lane & 7, nr = lane >> 3;
#pragma unroll
    for (int j = 0; j < 8; ++j) { const int n = nr + 8 * j; const LAS float* s = scr + n * 65 + 8 * kc;
        v4u o; o.x = pk2(s[0], s[1]); o.y = pk2(s[2], s[3]); o.z = pk2(s[4], s[5]); o.w = pk2(s[6], s[7]);
        *(GAS v4u*)(dst + (size_t)(n0 + n) * ldd + k0 + 8 * kc) = o; }
    LDS_WAIT(); asm volatile("" ::: "memory");
}
struct SrcPlain {
    const float* W; int ld; int coff; float scale;
    __device__ __forceinline__ f32x4 operator()(int k, int n) const { const f32x4 v = *(const GAS f32x4*)(W + (size_t)k * ld + n + coff); return v * scale; }
};
struct SrcZero { __device__ __forceinline__ f32x4 operator()(int, int) const { return (f32x4){0.f, 0.f, 0.f, 0.f}; } };
struct SrcKrope {
    const float* W;
    __device__ __forceinline__ f32x4 operator()(int k, int n) const { if (n >= PC_KROPE + 32) return (f32x4){0.f, 0.f, 0.f, 0.f}; return *(const GAS f32x4*)(W + (size_t)k * P_IN + SRC_KROPE + (n - PC_KROPE)); }
};
__device__ __forceinline__ int rope_dim_of_pos(int p) { return (p & 4) ? 16 + 4 * (p >> 3) + (p & 3) : 4 * (p >> 3) + (p & 3); }
struct SrcUp {
    const float* wuq; const float* gq; const float* wukv; const float* gkv; float c2a;
    __device__ __forceinline__ float one(int k, int n) const {
        if (n < 384) { if (k >= 192) return 0.f; const int h = n / 96, j = n % 96; const int col = h * 96 + (j < 64 ? j : 64 + rope_dim_of_pos(j - 64)); return gq[k] * wuq[(size_t)k * 384 + col] * c2a; }
        if (n < 512) return 0.f;
        if (k < 256) return 0.f;
        return gkv[k - 256] * wukv[(size_t)(k - 256) * 512 + (n - 512)];
    }
    __device__ __forceinline__ f32x4 operator()(int k, int n) const { return (f32x4){one(k, n), one(k, n + 1), one(k, n + 2), one(k, n + 3)}; }
};

constexpr float C2A = 0.10206207261596577f * LOG2E;
constexpr float C2B = 0.125f * LOG2E;
constexpr float C2D = 0.17677669529663687f * LOG2E;

__device__ __forceinline__ int t5_bucket(int rel) {
    const int n = rel < 0 ? -rel : rel; const int base = rel > 0 ? 16 : 0;
    if (n < 8) return base + n;
    const int fl = 31 - __builtin_clz((unsigned)(n * n));
    int large = 8 + fl - 6; if (large > 15) large = 15;
    return base + large;
}

__device__ __forceinline__ void prologue(Frame& F, CArgs& A) {
    const int gw = F.c * 8 + F.wave, NGW = F.G * 8;
    const int gt = F.c * 512 + F.tid, NGT = F.G * 512;
    {
        LAS float* cs = (LAS float*)(F.lds + RING_OFF);
        bool loaded = false;
        float* MOD = WSP(float, WS_MOD);
        for (int it = F.c; it < DEPTH * 96; it += F.G) {
            if (!loaded) { for (int e = F.tid; e < NB * DM; e += 512) { const int b = e >> 10, k = e & 1023; cs[k * 32 + b] = silu_f(IN_cnd[e]); } loaded = true; __syncthreads(); }
            const int l = it / 96, n0 = (it % 96) * 64;
            const int col = F.tid >> 3, ks = F.tid & 7;
            const float* W = IN_ada_w + (size_t)l * DM * 6144 + n0 + col;
            float acc[32];
#pragma unroll
            for (int b = 0; b < 32; ++b) acc[b] = 0.f;
            for (int kk = 0; kk < 128; ++kk) { const int k = 8 * kk + ks; const float w = W[(size_t)k * 6144];
#pragma unroll
                for (int b4 = 0; b4 < 8; ++b4) { const f32x4 c4 = *(const LAS f32x4*)(cs + k * 32 + 4 * b4); acc[4 * b4] += c4.x * w; acc[4 * b4 + 1] += c4.y * w; acc[4 * b4 + 2] += c4.z * w; acc[4 * b4 + 3] += c4.w * w; } }
#pragma unroll
            for (int b = 0; b < 32; ++b) { float v = acc[b]; v += shx(v, 1, F.lane); v += shx(v, 2, F.lane); v += shx(v, 4, F.lane); acc[b] = v; }
            if (ks == 0) { const float bias = IN_ada_b[l * 6144 + n0 + col];
#pragma unroll
                for (int b = 0; b < 32; ++b) MOD[((size_t)l * NB + b) * 6144 + n0 + col] = acc[b] + bias; }
        }
        __syncthreads();
    }
    { float* T5 = WSP(float, WS_T5);
      for (int i = gt; i < 4 * 2112; i += NGT) { const int h = i / 2112, r = i % 2112; T5[i] = IN_t5[t5_bucket(r - 2047) * 4 + h] * LOG2E; }
      float* LAM = WSP(float, WS_LAM);
      if (gt < DEPTH) { const int l = gt; const float* p = IN_dlam + l * 128; float s0 = 0.f, s1 = 0.f;
          for (int i = 0; i < 32; ++i) { s0 += p[i] * p[32 + i]; s1 += p[64 + i] * p[96 + i]; }
          LAM[l] = expf(s0) - expf(s1) + (0.8f - 0.6f * expf(-0.3f * (float)l)); }
      float* WF = WSP(float, WS_WF);
      for (int i = gt; i < DEPTH * 4 * DM; i += NGT) { const int l = i >> 12, j = (i >> 10) & 3, k = i & 1023; WF[i] = IN_w_in[((size_t)l * DM + k) * P_IN + SRC_FLOG + j]; }
      bf16* WRT = WSP(bf16, WS_WRT);
      for (int i = gt; i < DEPTH * NLOG * DM; i += NGT) { const int l = i / (NLOG * DM), r = i % (NLOG * DM), n = r >> 10, k = r & 1023;
          const float v = n < 8 ? IN_rg_w[((size_t)l * DM + k) * 8 + n] : (n < 72 ? IN_re_w[((size_t)l * DM + k) * 64 + (n - 8)] : 0.f);
          const unsigned hi = f2bf(v); const float lo = v - __builtin_bit_cast(float, hi << 16);
          WRT[((size_t)l * 2 + 0) * NLOG * DM + r] = (bf16)hi; WRT[((size_t)l * 2 + 1) * NLOG * DM + r] = (bf16)f2bf(lo); }
    }
    {
        LAS float* scr = (LAS float*)(F.lds + RING_OFF) + F.wave * (64 * 65);
        constexpr int I_IN = 16 * 44, I_UP = 6 * 16, I_OUT = 16 * 16, I_GU = 16 * 16 * NEXP, I_D = 8 * 16 * NEXP;
        constexpr int I_LAYER = I_IN + I_UP + I_OUT + I_GU + I_D;
        for (int it = gw; it < DEPTH * I_LAYER; it += NGW) {
            const int l = it / I_LAYER; int r = it % I_LAYER;
            if (r < I_IN) {
                const int nb = r / 16, kb = r % 16, n0 = nb * 64, k0 = kb * 64; bf16* dst = WSP(bf16, WS_WIN) + (size_t)l * PN * DM; const float* W = IN_w_in + (size_t)l * DM * P_IN;
                if (n0 < 192) transpose_item(SrcPlain{W, P_IN, 0, 1.f}, dst, DM, k0, n0, scr, F.lane);
                else if (n0 < 256) transpose_item(SrcZero{}, dst, DM, k0, n0, scr, F.lane);
                else if (n0 < 384) transpose_item(SrcPlain{W, P_IN, SRC_CKV - PC_CKV, 1.f}, dst, DM, k0, n0, scr, F.lane);
                else if (n0 < 448) transpose_item(SrcKrope{W}, dst, DM, k0, n0, scr, F.lane);
                else if (n0 < 512) transpose_item(SrcZero{}, dst, DM, k0, n0, scr, F.lane);
                else if (n0 < PC_CONV) transpose_item(SrcPlain{W, P_IN, SRC_FOX - PC_FOX, n0 < PC_FOX + 256 ? C2B : 1.f}, dst, DM, k0, n0, scr, F.lane);
                else if (n0 < PC_DIFF) transpose_item(SrcPlain{W, P_IN, SRC_CONV - PC_CONV, 1.f}, dst, DM, k0, n0, scr, F.lane);
                else transpose_item(SrcPlain{W, P_IN, SRC_DIFF - PC_DIFF, n0 < PC_DIFF + 256 ? C2D : 1.f}, dst, DM, k0, n0, scr, F.lane);
                continue; }
            r -= I_IN;
            if (r < I_UP) { const int nb = r / 6, kb = r % 6;
                transpose_item(SrcUp{IN_w_uq + (size_t)l * 192 * 384, IN_gq + l * 192, IN_w_ukv + (size_t)l * 128 * 512, IN_gkv + l * 128, C2A}, WSP(bf16, WS_WUP) + (size_t)l * NUP * KUP, KUP, kb * 64, nb * 64, scr, F.lane);
                continue; }
            r -= I_UP;
            if (r < I_OUT) { const int nb = r / 16, kb = r % 16;
                transpose_item(SrcPlain{IN_w_out + (size_t)l * DM * DM, DM, 0, 1.f}, WSP(bf16, WS_WOUT) + (size_t)l * DM * DM, DM, kb * 64, nb * 64, scr, F.lane);
                continue; }
            r -= I_OUT;
            if (r < I_GU) { const int e = r / 256, q = r % 256, nb = q / 16, kb = q % 16, n0 = nb * 64;
                const int pn = n0 >> 8, half = (n0 >> 7) & 1, j0 = n0 & 127;
                const float* W = (half ? IN_wu : IN_wg) + ((size_t)l * NEXP + e) * DM * DEXP;
                transpose_item(SrcPlain{W, DEXP, 128 * pn + j0 - n0, 1.f}, WSP(bf16, WS_WGU) + ((size_t)l * NEXP + e) * 1024 * 1024, DM, kb * 64, n0, scr, F.lane);
                continue; }
            r -= I_GU;
            { const int e = r / 128, q = r % 128, nb = q / 8, kb = q % 8;
              transpose_item(SrcPlain{IN_wd + ((size_t)l * NEXP + e) * DEXP * DM, DM, 0, 1.f}, WSP(bf16, WS_WD) + ((size_t)l * NEXP + e) * 1024 * DEXP, DEXP, kb * 64, nb * 64, scr, F.lane); }
        }
    }
}

__device__ __forceinline__ float rope_rev(int i) {
    constexpr float T[16] = {1.591549431e-01f, 8.949940161e-02f, 5.032921210e-02f, 2.830219583e-02f, 1.591549431e-02f, 8.949940161e-03f, 5.032921210e-03f, 2.830219583e-03f,
                             1.591549431e-03f, 8.949940161e-04f, 5.032921210e-04f, 2.830219583e-04f, 1.591549431e-04f, 8.949940161e-05f, 5.032921210e-05f, 2.830219583e-05f};
    return T[i];
}
__device__ __forceinline__ void rope_cs(float posf, float rev, float& c, float& s) { float a = posf * rev; a -= rintf(a); c = __builtin_amdgcn_cosf(a); s = __builtin_amdgcn_sinf(a); }

__device__ __forceinline__ void moe_block_starts(Frame& F, int lm) {
    LAS int* mbs = (LAS int*)(F.lds + UT_OFF + 256); LAS int* cnts = mbs + 72;
    if (F.tid < 64) cnts[F.tid] = (int)__hip_atomic_load(F.ctl + CW_GCNT + (lm * 64 + F.tid) * 16, RLX_AGENT);
    __syncthreads();
    if (F.tid == 0) { int a = 0; for (int e = 0; e < 64; ++e) { mbs[e] = a; a += (cnts[e] + 255) >> 8; } mbs[64] = a; }
    __syncthreads();
}

template <bool FINAL>
__device__ __forceinline__ void mix_norm_phase(Frame& F, CArgs& A, int l) {
    const bool comb = (l > 0);
    if (comb) moe_block_starts(F, l - 1);
    const LAS int* mbs = (const LAS int*)(F.lds + UT_OFF + 256);
    const float* MOD = WSP(float, WS_MOD);
    const bf16* Y = WSP(bf16, WS_Y); const int* DEST = WSP(int, WS_DEST); const float* GATE = WSP(float, WS_GATE);
    bf16* H = WSP(bf16, WS_H); float* FLOG = WSP(float, WS_FLOG);
    const float* xsrc = comb ? F.out : IN_x;
    for (int tile = F.c; tile < NTOK / 256; tile += F.G) {
        const int b = tile >> 3;
        f32x4 gv[4], scv[4], shv[4], gfv[4], wf[4][4];
#pragma unroll
        for (int j = 0; j < 4; ++j) { const int k = 4 * F.lane + 256 * j;
            if (FINAL) { gv[j] = *(const GAS f32x4*)(IN_g_fin + k); }
            else { gv[j] = *(const GAS f32x4*)(IN_g_mix + l * DM + k); scv[j] = *(const GAS f32x4*)(MOD + ((size_t)l * NB + b) * 6144 + 1024 + k); shv[j] = *(const GAS f32x4*)(MOD + ((size_t)l * NB + b) * 6144 + k);
#pragma unroll
                for (int q = 0; q < 4; ++q) wf[q][j] = *(const GAS f32x4*)(WSP(float, WS_WF) + ((size_t)l * 4 + q) * DM + k); }
            if (comb) gfv[j] = *(const GAS f32x4*)(MOD + ((size_t)(l - 1) * NB + b) * 6144 + 5 * 1024 + k); }
        for (int jr = 0; jr < 32; ++jr) {
            const size_t row = (size_t)tile * 256 + F.wave * 32 + jr;
            f32x4 v[4];
#pragma unroll
            for (int j = 0; j < 4; ++j) v[j] = *(const GAS f32x4*)(xsrc + row * DM + 4 * F.lane + 256 * j);
            if (comb) {
                const i32x4 d = *(const GAS i32x4*)(DEST + row * 4); const f32x2 gt = *(const GAS f32x2*)(GATE + row * 2);
                const size_t r0 = (size_t)256 * mbs[d.x] + d.y, r1 = (size_t)256 * mbs[d.z] + d.w;
#pragma unroll
                for (int j = 0; j < 4; ++j) { const v2u y0 = *(const GAS v2u*)(Y + r0 * DM + 4 * F.lane + 256 * j), y1 = *(const GAS v2u*)(Y + r1 * DM + 4 * F.lane + 256 * j);
                    f32x4 m; m.x = gt.x * bflo(y0.x) + gt.y * bflo(y1.x); m.y = gt.x * bfhi(y0.x) + gt.y * bfhi(y1.x); m.z = gt.x * bflo(y0.y) + gt.y * bflo(y1.y); m.w = gt.x * bfhi(y0.y) + gt.y * bfhi(y1.y);
                    v[j] = v[j] + gfv[j] * m; }
                if (!FINAL) {
#pragma unroll
                    for (int j = 0; j < 4; ++j) *(GAS f32x4*)(F.out + row * DM + 4 * F.lane + 256 * j) = v[j]; }
            }
            float ss = 0.f;
#pragma unroll
            for (int j = 0; j < 4; ++j) ss += (v[j].x * v[j].x + v[j].y * v[j].y) + (v[j].z * v[j].z + v[j].w * v[j].w);
            const float rs = 1.f / sqrtf(wave_sum(ss, F.lane) * (1.f / DM) + EPS);
            if (FINAL) {
#pragma unroll
                for (int j = 0; j < 4; ++j) *(GAS f32x4*)(F.out + row * DM + 4 * F.lane + 256 * j) = v[j] * rs * gv[j];
            } else {
                float fl[4] = {0.f, 0.f, 0.f, 0.f};
#pragma unroll
                for (int j = 0; j < 4; ++j) { const f32x4 hh = (v[j] * rs * gv[j]) * (scv[j] + 1.f) + shv[j];
                    v2u o; o.x = pk2(hh.x, hh.y); o.y = pk2(hh.z, hh.w);
                    *(GAS v2u*)(H + row * DM + 4 * F.lane + 256 * j) = o;
#pragma unroll
                    for (int q = 0; q < 4; ++q) fl[q] += (hh.x * wf[q][j].x + hh.y * wf[q][j].y) + (hh.z * wf[q][j].z + hh.w * wf[q][j].w); }
#pragma unroll
                for (int q = 0; q < 4; ++q) fl[q] = wave_sum(fl[q], F.lane);
                if (F.lane == 0) *(GAS f32x4*)(FLOG + row * 4) = (f32x4){fl[0], fl[1], fl[2], fl[3]};
            }
        }
    }
}

struct EpiStoreBf16 {
    static constexpr bool PERM = true;
    bf16* O; int ldc; int pn_mask;
    __device__ __forceinline__ void operator()(const f32x4 (&acc)[2][2][4][2], const pg8::Unit& u, int wr, int wc, int fr, int fq) const {
        const size_t row0 = (size_t)u.pm * 256 + wr * 64 + fr; const int col0 = (u.pn & pn_mask) * 256 + wc * 32 + 8 * fq;
#pragma unroll
        for (int ai = 0; ai < 2; ++ai)
#pragma unroll
            for (int m = 0; m < 4; ++m) { bf16* rowp = O + (row0 + ai * 128 + m * 16) * ldc + col0;
#pragma unroll
                for (int bj = 0; bj < 2; ++bj) { const f32x4 v0 = acc[ai][bj][m][0], v1 = acc[ai][bj][m][1]; v4u w;
                    w.x = pg8::cvt_pk_bf16(v0[0], v0[1]); w.y = pg8::cvt_pk_bf16(v0[2], v0[3]); w.z = pg8::cvt_pk_bf16(v1[0], v1[1]); w.w = pg8::cvt_pk_bf16(v1[2], v1[3]);
                    *(GAS v4u*)(rowp + bj * 128) = w; } }
    }
};
struct EpiOut {
    static constexpr bool PERM = false;
    const float* xin; float* xout; const float* gm;
    __device__ __forceinline__ void operator()(const f32x4 (&acc)[2][2][4][2], const pg8::Unit& u, int wr, int wc, int fr, int fq) const {
        const size_t row0 = (size_t)u.pm * 256 + wr * 64 + fr; const int col0 = u.pn * 256 + wc * 32 + 4 * fq; const int b = u.pm >> 3;
        f32x4 gvv[2][2];
#pragma unroll
        for (int bj = 0; bj < 2; ++bj)
#pragma unroll
            for (int n = 0; n < 2; ++n) gvv[bj][n] = *(const GAS f32x4*)(gm + (size_t)b * 6144 + col0 + bj * 128 + n * 16);
#pragma unroll
        for (int ai = 0; ai < 2; ++ai)
#pragma unroll
            for (int m = 0; m < 4; ++m) { const size_t ro = (row0 + ai * 128 + m * 16) * DM + col0;
#pragma unroll
                for (int bj = 0; bj < 2; ++bj)
#pragma unroll
                    for (int n = 0; n < 2; ++n) { const f32x4 xi = *(const GAS f32x4*)(xin + ro + bj * 128 + n * 16);
                        *(GAS f32x4*)(xout + ro + bj * 128 + n * 16) = xi + gvv[bj][n] * acc[ai][bj][m][n]; } }
    }
};
struct EpiGateUp {
    static constexpr bool PERM = true;
    bf16* O;
    __device__ __forceinline__ void operator()(const f32x4 (&acc)[2][2][4][2], const pg8::Unit& u, int wr, int wc, int fr, int fq) const {
        const size_t row0 = (size_t)u.pm * 256 + wr * 64 + fr; const int col0 = (u.pn & 3) * 128 + wc * 32 + 8 * fq;
#pragma unroll
        for (int ai = 0; ai < 2; ++ai)
#pragma unroll
            for (int m = 0; m < 4; ++m) { float hv[8];
#pragma unroll
                for (int n = 0; n < 2; ++n)
#pragma unroll
                    for (int i = 0; i < 4; ++i) hv[4 * n + i] = silu_f(acc[ai][0][m][n][i]) * acc[ai][1][m][n][i];
                v4u w; w.x = pg8::cvt_pk_bf16(hv[0], hv[1]); w.y = pg8::cvt_pk_bf16(hv[2], hv[3]); w.z = pg8::cvt_pk_bf16(hv[4], hv[5]); w.w = pg8::cvt_pk_bf16(hv[6], hv[7]);
                *(GAS v4u*)(O + (row0 + ai * 128 + m * 16) * DEXP + col0) = w; }
    }
};

__device__ __forceinline__ void mla_up_phase(Frame& F, CArgs& A, int l) {
    bf16* PROJ = WSP(bf16, WS_PROJ);
    {
        for (int tok = F.c * 512 + F.tid; tok < NTOK; tok += F.G * 512) {
            GAS v4u* p = (GAS v4u*)(PROJ + (size_t)tok * PN + PC_KROPE);
            v4u w[4]; float t[32], o[32];
#pragma unroll
            for (int i = 0; i < 4; ++i) w[i] = p[i];
#pragma unroll
            for (int i = 0; i < 4; ++i) { t[8 * i] = bflo(w[i].x); t[8 * i + 1] = bfhi(w[i].x); t[8 * i + 2] = bflo(w[i].y); t[8 * i + 3] = bfhi(w[i].y); t[8 * i + 4] = bflo(w[i].z); t[8 * i + 5] = bfhi(w[i].z); t[8 * i + 6] = bflo(w[i].w); t[8 * i + 7] = bfhi(w[i].w); }
            const float posf = (float)IN_pos[tok];
#pragma unroll
            for (int i = 0; i < 16; ++i) { float c, s; rope_cs(posf, rope_rev(i), c, s);
                const int p1 = 8 * (i >> 2) + (i & 3), p2 = p1 + 4;
                o[p1] = t[i] * c - t[i + 16] * s; o[p2] = t[i + 16] * c + t[i] * s; }
#pragma unroll
            for (int i = 0; i < 4; ++i) { v4u q; q.x = pk2(o[8 * i], o[8 * i + 1]); q.y = pk2(o[8 * i + 2], o[8 * i + 3]); q.z = pk2(o[8 * i + 4], o[8 * i + 5]); q.w = pk2(o[8 * i + 6], o[8 * i + 7]); p[i] = q; }
        }
    }
    {
        const float* FLOG = WSP(float, WS_FLOG); float* FB = WSP(float, WS_FB);
        LAS float* wt = (LAS float*)(F.lds + RING_OFF);
        for (int bh = F.c; bh < NB * 4; bh += F.G) {
            const int b = bh >> 2, h = bh & 3; const float fb = IN_fb[l * 4 + h];
            float v[4]; float run = 0.f;
#pragma unroll
            for (int j = 0; j < 4; ++j) { const float xx = FLOG[((size_t)b * SEQ + 4 * F.tid + j) * 4 + h] + fb; const float ls = fminf(xx, 0.f) - log1pf(expf(-fabsf(xx))); run += ls; v[j] = run; }
            float inc = run;
#pragma unroll
            for (int o = 1; o < 64; o <<= 1) { const float n = __builtin_bit_cast(float, __builtin_amdgcn_ds_bpermute((F.lane - o) << 2, __builtin_bit_cast(int, inc))); if (F.lane >= o) inc += n; }
            if (F.lane == 63) wt[F.wave] = inc;
            __syncthreads();
            float base = inc - run;
            for (int w = 0; w < F.wave; ++w) base += wt[w];
#pragma unroll
            for (int j = 0; j < 4; ++j) FB[((size_t)b * 4 + h) * SEQ + 4 * F.tid + j] = -LOG2E * (base + v[j]);
            __syncthreads();
        }
    }
    for (int pm = F.c; pm < NTOK / 256; pm += F.G) {
        for (int jr = 0; jr < 32; ++jr) { const size_t row = (size_t)pm * 256 + F.wave * 32 + jr;
            const bool isq = F.lane < 24, iskv = (F.lane >= 32 && F.lane < 48);
            GAS v4u* p = (GAS v4u*)(PROJ + row * PN + (isq ? 8 * F.lane : PC_CKV + 8 * (F.lane & 15)));
            float a[8]; float sq = 0.f, skv = 0.f;
            if (isq || iskv) { const v4u w = *p; a[0] = bflo(w.x); a[1] = bfhi(w.x); a[2] = bflo(w.y); a[3] = bfhi(w.y); a[4] = bflo(w.z); a[5] = bfhi(w.z); a[6] = bflo(w.w); a[7] = bfhi(w.w);
                const float ss = (a[0] * a[0] + a[1] * a[1]) + (a[2] * a[2] + a[3] * a[3]) + (a[4] * a[4] + a[5] * a[5]) + (a[6] * a[6] + a[7] * a[7]);
                if (isq) sq = ss; else skv = ss; }
            sq = wave_sum(sq, F.lane); skv = wave_sum(skv, F.lane);
            const float rs = isq ? 1.f / sqrtf(sq * (1.f / 192.f) + EPS) : 1.f / sqrtf(skv * (1.f / 128.f) + EPS);
            if (isq || iskv) { v4u o; o.x = pk2(a[0] * rs, a[1] * rs); o.y = pk2(a[2] * rs, a[3] * rs); o.z = pk2(a[4] * rs, a[5] * rs); o.w = pk2(a[6] * rs, a[7] * rs); *p = o; } }
        VM_WAIT();
        __syncthreads();
        pg8::Gemm g{PROJ, WSP(bf16, WS_WUP) + (size_t)l * NUP * KUP, KUP, PN};
        int nn4 = 4; asm volatile("" : "+s"(nn4));
        pg8::PanelOrder S{pm, nn4};
        EpiStoreBf16 E{WSP(bf16, WS_MLA), 1024, 0xffff};
        pg8::gemm_phase<EpiStoreBf16, pg8::PanelOrder, true, false>(F.lds + RING_OFF, g, S, E, F.tid);
        __syncthreads();
    }
}

__device__ __forceinline__ int crow(int r, int hi) { return (r & 3) + 8 * (r >> 2) + 4 * hi; }
typedef short v4i16_t __attribute__((ext_vector_type(4)));
__device__ __forceinline__ s16x4 vtr(const LAS unsigned char* p) { return __builtin_bit_cast(s16x4, __builtin_amdgcn_ds_read_tr16_b64_v4i16((LAS v4i16_t*)p)); }
__device__ __forceinline__ float half_swap_max(float m) { auto rr = __builtin_amdgcn_permlane32_swap(__float_as_uint(m), __float_as_uint(m), false, false); return fmaxf(__uint_as_float(rr[0]), __uint_as_float(rr[1])); }
__device__ __forceinline__ float half_swap_sum(float m) { auto rr = __builtin_amdgcn_permlane32_swap(__float_as_uint(m), __float_as_uint(m), false, false); return __uint_as_float(rr[0]) + __uint_as_float(rr[1]); }
__device__ __forceinline__ bf16x8 pack8(const f32x16& p, int b0) {
    v4u w; w.x = pg8::cvt_pk_bf16(p[b0], p[b0 + 1]); w.y = pg8::cvt_pk_bf16(p[b0 + 2], p[b0 + 3]); w.z = pg8::cvt_pk_bf16(p[b0 + 4], p[b0 + 5]); w.w = pg8::cvt_pk_bf16(p[b0 + 6], p[b0 + 7]);
    return __builtin_bit_cast(bf16x8, w);
}
__device__ __forceinline__ void softmax_tile(f32x16& p0, f32x16& p1, float& m, float& lsum, f32x16& o0, f32x16& o1) {
    float a = fmaxf(p0[0], p1[0]);
#pragma unroll
    for (int r = 1; r < 16; ++r) a = fmaxf(a, fmaxf(p0[r], p1[r]));
    const float rm = half_swap_max(a);
    const float mn = fmaxf(m, rm); const float alpha = fast_exp2(m - mn); m = mn;
    float s = 0.f;
#pragma unroll
    for (int r = 0; r < 16; ++r) { p0[r] = fast_exp2(p0[r] - mn); p1[r] = fast_exp2(p1[r] - mn); s += p0[r] + p1[r]; }
    lsum = lsum * alpha + s;
#pragma unroll
    for (int r = 0; r < 16; ++r) { o0[r] *= alpha; o1[r] *= alpha; }
}

constexpr int AT_KB = 16384, AT_VB = 8192, AT_TBL = 2 * AT_KB + 2 * AT_VB;

template <int MODE>
__device__ __forceinline__ void attn_unit(Frame& F, CArgs& A, int l, int b, int h, int qb) {
    const int tid = F.tid, lane = F.lane, wid = F.wave, r32 = lane & 31, hi = lane >> 5;
    constexpr int ND0 = (MODE == 0) ? 6 : (MODE == 1 ? 4 : 2);
    LAS unsigned char* kb0 = F.lds + RING_OFF; LAS unsigned char* vb0 = F.lds + RING_OFF + 2 * AT_KB; LAS float* tbl = (LAS float*)(F.lds + RING_OFF + AT_TBL);
    const size_t rowbase = (size_t)b * SEQ; const int q0 = qb * 256, NT = 4 * qb + 4, tw = 4 * qb + (wid >> 1), qw0 = q0 + 32 * wid;
    const bf16* PROJ = WSP(bf16, WS_PROJ); const bf16* MLA = WSP(bf16, WS_MLA);
    const bf16* Qp; const bf16* Kp; const bf16* Vp; int pitch;
    if (MODE == 0) { Qp = MLA + h * 96; Kp = MLA + 512 + h * 128; Vp = Kp + 64; pitch = 1024; }
    else if (MODE == 1) { Qp = PROJ + PC_FOX + h * 64; Kp = Qp + 256; Vp = Qp + 512; pitch = PN; }
    else { Qp = PROJ + PC_DIFF + h * 64; Kp = Qp + 256; Vp = Qp + 512; pitch = PN; }
    v4u kreg, vreg, kreg2;
    const int skey = tid >> 3, sch = tid & 7, skey2 = tid >> 2, sch2 = 8 + (tid & 3);
    const int kdst = sch * 1024 + ((skey ^ sch) * 16), vdst = (sch >> 2) * 4096 + (skey >> 4) * 1024 + (skey & 15) * 64 + (sch & 3) * 16, kdst2 = sch2 * 1024 + ((skey2 ^ (sch2 & 7)) * 16);
#define AT_ISSUE(t) do { const size_t _r = rowbase + 64 * (t) + skey; kreg = *(const GAS v4u*)(Kp + _r * pitch + sch * 8); vreg = *(const GAS v4u*)(Vp + _r * pitch + sch * 8); \
        if (MODE == 0 && tid < 256) kreg2 = *(const GAS v4u*)(PROJ + (rowbase + 64 * (t) + skey2) * PN + PC_KROPE + (tid & 3) * 8); } while (0)
#define AT_COMMIT(buf) do { *(LAS v4u*)(kb0 + (buf) * AT_KB + kdst) = kreg; *(LAS v4u*)(vb0 + (buf) * AT_VB + vdst) = vreg; \
        if (MODE == 0 && tid < 256) *(LAS v4u*)(kb0 + (buf) * AT_KB + kdst2) = kreg2; } while (0)
    AT_ISSUE(0);
    if (MODE == 1) { const float* FBp = WSP(float, WS_FB) + ((size_t)b * 4 + h) * SEQ; if (4 * tid < NT * 64) *(LAS f32x4*)(tbl + 4 * tid) = *(const GAS f32x4*)(FBp + 4 * tid); }
    if (MODE == 2) { const float* T5p = WSP(float, WS_T5) + h * 2112; for (int i = tid; i < 528; i += 512) *(LAS f32x4*)(tbl + 4 * i) = *(const GAS f32x4*)(T5p + 4 * i); }
    bf16x8 qf[(MODE == 2) ? 4 : ND0];
    { const bf16* Qw = Qp + (rowbase + qw0 + r32) * pitch + hi * 8;
#pragma unroll
      for (int d = 0; d < ((MODE == 2) ? 4 : ND0); ++d) qf[d] = *(const GAS bf16x8*)(Qw + d * 16); }
    if (MODE == 0) {
        const float posf = (float)IN_pos[rowbase + qw0 + r32];
#pragma unroll
        for (int j = 0; j < 2; ++j) { const v4u w = __builtin_bit_cast(v4u, qf[(MODE == 0) ? 4 + j : 0]);
            float t1[4] = {bflo(w.x), bfhi(w.x), bflo(w.y), bfhi(w.y)}, t2[4] = {bflo(w.z), bfhi(w.z), bflo(w.w), bfhi(w.w)};
#pragma unroll
            for (int i = 0; i < 4; ++i) { float c, s; rope_cs(posf, hi ? rope_rev(4 * (2 * j + 1) + i) : rope_rev(4 * (2 * j) + i), c, s); const float a = t1[i], bb = t2[i]; t1[i] = a * c - bb * s; t2[i] = bb * c + a * s; }
            v4u o; o.x = pk2(t1[0], t1[1]); o.y = pk2(t1[2], t1[3]); o.z = pk2(t2[0], t2[1]); o.w = pk2(t2[2], t2[3]);
            qf[(MODE == 0) ? 4 + j : 0] = __builtin_bit_cast(bf16x8, o); }
    }
    float m1 = -1e30f, l1 = 0.f, m2 = -1e30f, l2 = 0.f; f32x16 o1[2], o2[2];
#pragma unroll
    for (int r = 0; r < 16; ++r) { o1[0][r] = 0.f; o1[1][r] = 0.f; o2[0][r] = 0.f; o2[1][r] = 0.f; }
    const int vlane = ((lane >> 4) & 1) * 32 + (lane & 3) * 8 + (4 * hi + ((lane & 15) >> 2)) * 64;
    AT_COMMIT(0);
    __syncthreads();
    for (int t = 0; t < NT; ++t) {
        if (t + 1 < NT) AT_ISSUE(t + 1);
        if (t <= tw) {
            const LAS unsigned char* kb = kb0 + (t & 1) * AT_KB; const LAS unsigned char* vb = vb0 + (t & 1) * AT_VB + vlane;
            bf16x8 vf[2][4];
#pragma unroll
            for (int d0 = 0; d0 < 2; ++d0)
#pragma unroll
                for (int ks = 0; ks < 4; ++ks) { const s16x4 lo = vtr(vb + d0 * 4096 + ks * 1024), hh = vtr(vb + d0 * 4096 + ks * 1024 + 512);
                    vf[d0][ks] = (bf16x8){lo[0], lo[1], lo[2], lo[3], hh[0], hh[1], hh[2], hh[3]}; }
#pragma unroll
            for (int mp = 0; mp < ((MODE == 2) ? 2 : 1); ++mp) {
                f32x16 p0, p1;
                if (MODE == 0) {
#pragma unroll
                    for (int r = 0; r < 16; ++r) { p0[r] = 0.f; p1[r] = 0.f; }
                } else if (MODE == 1) {
#pragma unroll
                    for (int g4 = 0; g4 < 4; ++g4) { const f32x4 a = *(const LAS f32x4*)(tbl + 64 * t + 8 * g4 + 4 * hi), c = *(const LAS f32x4*)(tbl + 64 * t + 32 + 8 * g4 + 4 * hi);
                        p0[4 * g4] = a.x; p0[4 * g4 + 1] = a.y; p0[4 * g4 + 2] = a.z; p0[4 * g4 + 3] = a.w; p1[4 * g4] = c.x; p1[4 * g4 + 1] = c.y; p1[4 * g4 + 2] = c.z; p1[4 * g4 + 3] = c.w; }
                } else {
                    if (64 * t + 191 > qw0) {
                        const LAS float* tp = tbl + (64 * t - (qw0 + r32) + 2047 + 4 * hi);
#pragma unroll
                        for (int r = 0; r < 16; ++r) { p0[r] = tp[(r & 3) + 8 * (r >> 2)]; p1[r] = tp[32 + (r & 3) + 8 * (r >> 2)]; }
                    } else { const float cfar = tbl[0];
#pragma unroll
                        for (int r = 0; r < 16; ++r) { p0[r] = cfar; p1[r] = cfar; } }
                }
#pragma unroll
                for (int d0 = 0; d0 < ND0; ++d0) { const int c = 2 * d0 + hi + ((MODE == 2) ? 4 * mp : 0);
                    const LAS unsigned char* ka = kb + c * 1024 + ((r32 ^ (c & 7)) * 16);
                    const bf16x8 k0 = *(const LAS bf16x8*)ka, k1 = *(const LAS bf16x8*)(ka + 512);
                    p0 = __builtin_amdgcn_mfma_f32_32x32x16_bf16(k0, qf[(MODE == 2) ? 2 * mp + d0 : d0], p0, 0, 0, 0);
                    p1 = __builtin_amdgcn_mfma_f32_32x32x16_bf16(k1, qf[(MODE == 2) ? 2 * mp + d0 : d0], p1, 0, 0, 0); }
                if (MODE == 1 && t == tw) {
                    const int ql = 32 * (wid & 1) + r32;
#pragma unroll
                    for (int r = 0; r < 16; ++r) { const int kl = crow(r, hi); if (kl > ql) p0[r] = -1e30f; if (kl + 32 > ql) p1[r] = -1e30f; }
                }
                if (mp == 0) softmax_tile(p0, p1, m1, l1, o1[0], o1[1]); else softmax_tile(p0, p1, m2, l2, o2[0], o2[1]);
                const bf16x8 pa0 = pack8(p0, 0), pa1 = pack8(p0, 8), pa2 = pack8(p1, 0), pa3 = pack8(p1, 8);
#pragma unroll
                for (int d0 = 0; d0 < 2; ++d0) {
                    if (mp == 0) { o1[d0] = __builtin_amdgcn_mfma_f32_32x32x16_bf16(vf[d0][0], pa0, o1[d0], 0, 0, 0); o1[d0] = __builtin_amdgcn_mfma_f32_32x32x16_bf16(vf[d0][1], pa1, o1[d0], 0, 0, 0);
                                   o1[d0] = __builtin_amdgcn_mfma_f32_32x32x16_bf16(vf[d0][2], pa2, o1[d0], 0, 0, 0); o1[d0] = __builtin_amdgcn_mfma_f32_32x32x16_bf16(vf[d0][3], pa3, o1[d0], 0, 0, 0); }
                    else         { o2[d0] = __builtin_amdgcn_mfma_f32_32x32x16_bf16(vf[d0][0], pa0, o2[d0], 0, 0, 0); o2[d0] = __builtin_amdgcn_mfma_f32_32x32x16_bf16(vf[d0][1], pa1, o2[d0], 0, 0, 0);
                                   o2[d0] = __builtin_amdgcn_mfma_f32_32x32x16_bf16(vf[d0][2], pa2, o2[d0], 0, 0, 0); o2[d0] = __builtin_amdgcn_mfma_f32_32x32x16_bf16(vf[d0][3], pa3, o2[d0], 0, 0, 0); }
                }
            }
        }
        if (t + 1 < NT) AT_COMMIT((t + 1) & 1);
        __syncthreads();
    }
#undef AT_ISSUE
#undef AT_COMMIT
    bf16* MIX = WSP(bf16, WS_MIX);
    const float inv1 = 1.f / half_swap_sum(l1);
    bf16* orow = MIX + (rowbase + qw0 + r32) * DM + ((MODE == 0) ? h * 64 : (MODE == 1) ? 256 + h * 64 : 768 + h * 64) + 4 * hi;
    if (MODE != 2) {
#pragma unroll
        for (int d0 = 0; d0 < 2; ++d0)
#pragma unroll
            for (int j = 0; j < 4; ++j) { v2u w; w.x = pg8::cvt_pk_bf16(o1[d0][4 * j] * inv1, o1[d0][4 * j + 1] * inv1); w.y = pg8::cvt_pk_bf16(o1[d0][4 * j + 2] * inv1, o1[d0][4 * j + 3] * inv1);
                *(GAS v2u*)(orow + 32 * d0 + 8 * j) = w; }
    } else {
        const float inv2 = 1.f / half_swap_sum(l2); const float lam = WSP(float, WS_LAM)[l]; const float li = 0.8f - 0.6f * expf(-0.3f * (float)l);
        const float c2 = lam * inv2; float ss = 0.f;
#pragma unroll
        for (int d0 = 0; d0 < 2; ++d0)
#pragma unroll
            for (int r = 0; r < 16; ++r) { const float v = o1[d0][r] * inv1 - o2[d0][r] * c2; o1[d0][r] = v; ss += v * v; }
        const float rsn = (1.f - li) / sqrtf(half_swap_sum(ss) * (1.f / 64.f) + EPS);
        const float* sg = IN_subln + l * 64 + 4 * hi;
#pragma unroll
        for (int d0 = 0; d0 < 2; ++d0)
#pragma unroll
            for (int j = 0; j < 4; ++j) { const f32x4 g4 = *(const GAS f32x4*)(sg + 32 * d0 + 8 * j);
                v2u w; w.x = pg8::cvt_pk_bf16(o1[d0][4 * j] * rsn * g4.x, o1[d0][4 * j + 1] * rsn * g4.y); w.y = pg8::cvt_pk_bf16(o1[d0][4 * j + 2] * rsn * g4.z, o1[d0][4 * j + 3] * rsn * g4.w);
                *(GAS v2u*)(orow + 32 * d0 + 8 * j) = w; }
    }
}

__device__ __forceinline__ void conv_unit(Frame& F, CArgs& A, int l, int tile) {
    const bf16* PROJ = WSP(bf16, WS_PROJ); bf16* MIX = WSP(bf16, WS_MIX);
    const int c8 = (F.tid & 31) * 8, rsub = F.tid >> 5;
    float w0[8], w1[8], w2[8];
#pragma unroll
    for (int i = 0; i < 8; ++i) { w0[i] = IN_conv_w[(l * 3 + 0) * 256 + c8 + i]; w1[i] = IN_conv_w[(l * 3 + 1) * 256 + c8 + i]; w2[i] = IN_conv_w[(l * 3 + 2) * 256 + c8 + i]; }
    for (int j = 0; j < 16; ++j) {
        const size_t row = (size_t)tile * 256 + rsub + 16 * j; const int s = (int)(row & (SEQ - 1));
        const bf16* pr = PROJ + row * PN + PC_CONV + c8;
        const v4u bb = *(const GAS v4u*)pr, c0 = *(const GAS v4u*)(pr + 256), u0 = *(const GAS v4u*)(pr + 512);
        v4u c1 = (v4u){0u, 0u, 0u, 0u}, u1 = c1, c2 = c1, u2 = c1;
        if (s >= 1) { c1 = *(const GAS v4u*)(pr - PN + 256); u1 = *(const GAS v4u*)(pr - PN + 512); }
        if (s >= 2) { c2 = *(const GAS v4u*)(pr - 2 * PN + 256); u2 = *(const GAS v4u*)(pr - 2 * PN + 512); }
        float o[8];
#define CV(i, W, sel) { const float z0 = sel(c0.W) * sel(u0.W), z1 = sel(c1.W) * sel(u1.W), z2 = sel(c2.W) * sel(u2.W); o[i] = sel(bb.W) * (w2[i] * z0 + w1[i] * z1 + w0[i] * z2); }
        CV(0, x, bflo) CV(1, x, bfhi) CV(2, y, bflo) CV(3, y, bfhi) CV(4, z, bflo) CV(5, z, bfhi) CV(6, w, bflo) CV(7, w, bfhi)
#undef CV
        v4u q; q.x = pk2(o[0], o[1]); q.y = pk2(o[2], o[3]); q.z = pk2(o[4], o[5]); q.w = pk2(o[6], o[7]);
        *(GAS v4u*)(MIX + row * DM + 512 + c8) = q;
    }
}

#define ATTN_LOOP(TYPE, MODE_) for (;;) { \
        if (F.tid == 0) F.MISC[0] = __hip_atomic_fetch_add(F.ctl + CW_Q + 64 * l + 16 * (TYPE), 1u, RLX_AGENT); \
        __syncthreads(); const int idx = (int)F.MISC[0]; __syncthreads(); \
        if (idx >= 1024) break; \
        const int qb = 7 - (idx >> 7), bh = idx & 127; attn_unit<MODE_>(F, A, l, bh >> 2, bh & 3, qb); }
__device__ __forceinline__ void attn_phase(Frame& F, CArgs& A, int l) {
    ATTN_LOOP(0, 2)
    ATTN_LOOP(1, 0)
    ATTN_LOOP(2, 1)
    for (int tile = F.c; tile < NTOK / 256; tile += F.G) conv_unit(F, A, l, tile);
}

__device__ __forceinline__ void ffn_router_phase(Frame& F, CArgs& A, int l) {
    const float* MOD = WSP(float, WS_MOD); const bf16* WRT = WSP(bf16, WS_WRT) + (size_t)l * 2 * NLOG * DM;
    bf16* H = WSP(bf16, WS_H); int* DEST = WSP(int, WS_DEST); float* GATE = WSP(float, WS_GATE); int* LIST = WSP(int, WS_LIST);
    LAS float* G2P = (LAS float*)(F.lds + RING_OFF); LAS float* SHF = G2P + 1024; LAS float* SHWB = G2P + 2048; LAS int* hist = (LAS int*)(G2P + 2176); LAS int* base = hist + 64;
    LAS int* rinfo = (LAS int*)(G2P + 2304);
    LAS float* LG = G2P + 5120 + F.wave * 2560;
    const int tk = F.lane & 15, kg = F.lane >> 4;
    for (int tile = F.c; tile < NTOK / 256; tile += F.G) {
        const int b = tile >> 3;
        for (int k = F.tid; k < DM; k += 512) { G2P[k] = IN_g_ffn[l * DM + k] * (1.f + MOD[((size_t)l * NB + b) * 6144 + 4 * 1024 + k]); SHF[k] = MOD[((size_t)l * NB + b) * 6144 + 3 * 1024 + k]; }
        if (F.tid < 64) hist[F.tid] = 0;
        __syncthreads();
        for (int n = F.wave; n < NLOG; n += 8) { float s = 0.f;
#pragma unroll
            for (int j = 0; j < 4; ++j) { const int k = 4 * F.lane + 256 * j; const v2u wh = *(const GAS v2u*)(WRT + (size_t)n * DM + k), wl = *(const GAS v2u*)(WRT + (size_t)(NLOG + n) * DM + k);
                s += SHF[k] * (bflo(wh.x) + bflo(wl.x)) + SHF[k + 1] * (bfhi(wh.x) + bfhi(wl.x)) + SHF[k + 2] * (bflo(wh.y) + bflo(wl.y)) + SHF[k + 3] * (bfhi(wh.y) + bfhi(wl.y)); }
            s = wave_sum(s, F.lane);
            if (F.lane == 0) SHWB[n] = s + (n < 8 ? IN_rg_b[l * 8 + n] : (n < 72 ? IN_re_b[l * 64 + n - 8] : 0.f)); }
        __syncthreads();
        const size_t rowA = (size_t)tile * 256 + F.wave * 32 + tk, rowB = rowA + 16;
        f32x4 acc[2][5];
#pragma unroll
        for (int rb = 0; rb < 2; ++rb)
#pragma unroll
            for (int nb = 0; nb < 5; ++nb) acc[rb][nb] = (f32x4){0.f, 0.f, 0.f, 0.f};
        float ssA = 0.f, ssB = 0.f;
        for (int s = 0; s < 32; ++s) {
            const int k = 32 * s + 8 * kg;
            const f32x4 xa0 = *(const GAS f32x4*)(F.out + rowA * DM + k), xa1 = *(const GAS f32x4*)(F.out + rowA * DM + k + 4), xb0 = *(const GAS f32x4*)(F.out + rowB * DM + k), xb1 = *(const GAS f32x4*)(F.out + rowB * DM + k + 4);
            const f32x4 g0 = *(const LAS f32x4*)(G2P + k), g1 = *(const LAS f32x4*)(G2P + k + 4);
            ssA += (xa0.x * xa0.x + xa0.y * xa0.y) + (xa0.z * xa0.z + xa0.w * xa0.w) + (xa1.x * xa1.x + xa1.y * xa1.y) + (xa1.z * xa1.z + xa1.w * xa1.w);
            ssB += (xb0.x * xb0.x + xb0.y * xb0.y) + (xb0.z * xb0.z + xb0.w * xb0.w) + (xb1.x * xb1.x + xb1.y * xb1.y) + (xb1.z * xb1.z + xb1.w * xb1.w);
            const f32x4 ua0 = xa0 * g0, ua1 = xa1 * g1, ub0 = xb0 * g0, ub1 = xb1 * g1;
            bf16x8 hA, lA, hB, lB;
#define SPLIT8(H_, L_, U0, U1) { v4u hw, lw; unsigned q0, q1; \
            q0 = f2bf(U0.x); q1 = f2bf(U0.y); hw.x = q0 | (q1 << 16); lw.x = pk2(U0.x - __builtin_bit_cast(float, q0 << 16), U0.y - __builtin_bit_cast(float, q1 << 16)); \
            q0 = f2bf(U0.z); q1 = f2bf(U0.w); hw.y = q0 | (q1 << 16); lw.y = pk2(U0.z - __builtin_bit_cast(float, q0 << 16), U0.w - __builtin_bit_cast(float, q1 << 16)); \
            q0 = f2bf(U1.x); q1 = f2bf(U1.y); hw.z = q0 | (q1 << 16); lw.z = pk2(U1.x - __builtin_bit_cast(float, q0 << 16), U1.y - __builtin_bit_cast(float, q1 << 16)); \
            q0 = f2bf(U1.z); q1 = f2bf(U1.w); hw.w = q0 | (q1 << 16); lw.w = pk2(U1.z - __builtin_bit_cast(float, q0 << 16), U1.w - __builtin_bit_cast(float, q1 << 16)); \
            H_ = __builtin_bit_cast(bf16x8, hw); L_ = __builtin_bit_cast(bf16x8, lw); }
            SPLIT8(hA, lA, ua0, ua1) SPLIT8(hB, lB, ub0, ub1)
#undef SPLIT8
#pragma unroll
            for (int nb = 0; nb < 5; ++nb) {
                const bf16x8 wh = *(const GAS bf16x8*)(WRT + (size_t)(16 * nb + tk) * DM + k), wl = *(const GAS bf16x8*)(WRT + (size_t)(NLOG + 16 * nb + tk) * DM + k);
                acc[0][nb] = __builtin_amdgcn_mfma_f32_16x16x32_bf16(wh, hA, acc[0][nb], 0, 0, 0); acc[0][nb] = __builtin_amdgcn_mfma_f32_16x16x32_bf16(wh, lA, acc[0][nb], 0, 0, 0); acc[0][nb] = __builtin_amdgcn_mfma_f32_16x16x32_bf16(wl, hA, acc[0][nb], 0, 0, 0);
                acc[1][nb] = __builtin_amdgcn_mfma_f32_16x16x32_bf16(wh, hB, acc[1][nb], 0, 0, 0); acc[1][nb] = __builtin_amdgcn_mfma_f32_16x16x32_bf16(wh, lB, acc[1][nb], 0, 0, 0); acc[1][nb] = __builtin_amdgcn_mfma_f32_16x16x32_bf16(wl, hB, acc[1][nb], 0, 0, 0);
            }
        }
        ssA += shx(ssA, 16, F.lane); ssA += shx(ssA, 32, F.lane); ssB += shx(ssB, 16, F.lane); ssB += shx(ssB, 32, F.lane);
        const float rsA = 1.f / sqrtf(ssA * (1.f / DM) + EPS), rsB = 1.f / sqrtf(ssB * (1.f / DM) + EPS);
#pragma unroll
        for (int nb = 0; nb < 5; ++nb) { const f32x4 sb = *(const LAS f32x4*)(SHWB + 16 * nb + 4 * kg);
            *(LAS f32x4*)(LG + tk * NLOG + 16 * nb + 4 * kg) = acc[0][nb] * rsA + sb; *(LAS f32x4*)(LG + (16 + tk) * NLOG + 16 * nb + 4 * kg) = acc[1][nb] * rsB + sb; }
        LDS_WAIT(); asm volatile("" ::: "memory");
        if (F.lane < 32) {
            const LAS float* lg = LG + F.lane * NLOG;
            float gl[8];
#pragma unroll
            for (int j = 0; j < 8; ++j) gl[j] = lg[j];
            int g = 0; float mx = gl[0];
#pragma unroll
            for (int j = 1; j < 8; ++j) if (gl[j] > mx) { mx = gl[j]; g = j; }
            float Z = 0.f;
#pragma unroll
            for (int j = 0; j < 8; ++j) Z += expf(gl[j] - mx);
            const float pg = 1.f / Z;
            const LAS float* el = lg + 8 + 8 * g; float ev[8];
#pragma unroll
            for (int j = 0; j < 8; ++j) ev[j] = el[j];
            int i1 = 0; float m1v = ev[0];
#pragma unroll
            for (int j = 1; j < 8; ++j) if (ev[j] > m1v) { m1v = ev[j]; i1 = j; }
            int i2 = -1; float m2v = -3.0e38f;
#pragma unroll
            for (int j = 0; j < 8; ++j) if (j != i1 && ev[j] > m2v) { m2v = ev[j]; i2 = j; }
            const float eb = expf(m2v - m1v), den = 1.f / (1.f + eb);
            const int e0 = 8 * g + i1, e1 = 8 * g + i2;
            const int r0 = __hip_atomic_fetch_add(hist + e0, 1, __ATOMIC_RELAXED, __HIP_MEMORY_SCOPE_WORKGROUP), r1 = __hip_atomic_fetch_add(hist + e1, 1, __ATOMIC_RELAXED, __HIP_MEMORY_SCOPE_WORKGROUP);
            LAS int* ri = rinfo + (F.wave * 32 + F.lane) * 8;
            ri[0] = e0; ri[1] = r0; ri[2] = e1; ri[3] = r1; ri[4] = __float_as_int(pg * den); ri[5] = __float_as_int(pg * eb * den);
        }
        __syncthreads();
        if (F.tid < 64) { const int hc = hist[F.tid]; base[F.tid] = hc ? (int)__hip_atomic_fetch_add(F.ctl + CW_GCNT + (l * 64 + F.tid) * 16, (unsigned)hc, RLX_AGENT) : 0; }
        __syncthreads();
        if (F.tid < 256) { const LAS int* ri = rinfo + F.tid * 8; const size_t row = (size_t)tile * 256 + F.tid;
            const int e0 = ri[0], s0 = base[e0] + ri[1], e1 = ri[2], s1 = base[e1] + ri[3];
            LIST[(size_t)e0 * 65536 + s0] = (int)row; LIST[(size_t)e1 * 65536 + s1] = (int)row;
            *(GAS i32x4*)(DEST + row * 4) = (i32x4){e0, s0, e1, s1}; *(GAS f32x2*)(GATE + row * 2) = (f32x2){__int_as_float(ri[4]), __int_as_float(ri[5])}; }
        for (int s = 0; s < 32; ++s) {
            const int k = 32 * s + 8 * kg;
            const f32x4 xa0 = *(const GAS f32x4*)(F.out + rowA * DM + k), xa1 = *(const GAS f32x4*)(F.out + rowA * DM + k + 4), xb0 = *(const GAS f32x4*)(F.out + rowB * DM + k), xb1 = *(const GAS f32x4*)(F.out + rowB * DM + k + 4);
            const f32x4 g0 = *(const LAS f32x4*)(G2P + k), g1 = *(const LAS f32x4*)(G2P + k + 4), h0 = *(const LAS f32x4*)(SHF + k), h1 = *(const LAS f32x4*)(SHF + k + 4);
            const f32x4 a0 = (xa0 * rsA) * g0 + h0, a1 = (xa1 * rsA) * g1 + h1, b0 = (xb0 * rsB) * g0 + h0, b1 = (xb1 * rsB) * g1 + h1;
            v4u wa, wb; wa.x = pk2(a0.x, a0.y); wa.y = pk2(a0.z, a0.w); wa.z = pk2(a1.x, a1.y); wa.w = pk2(a1.z, a1.w); wb.x = pk2(b0.x, b0.y); wb.y = pk2(b0.z, b0.w); wb.z = pk2(b1.x, b1.y); wb.w = pk2(b1.z, b1.w);
            *(GAS v4u*)(H + rowA * DM + k) = wa; *(GAS v4u*)(H + rowB * DM + k) = wb;
        }
        __syncthreads();
    }
}

template <bool GATHER_TOK>
__device__ __forceinline__ int moe_build_tables(Frame& F, int l, int chunk) {
    LAS int* ut = (LAS int*)(F.lds + UT_OFF); LAS unsigned* tokt = (LAS unsigned*)(F.lds + TAB_OFF);
    const LAS int* mbs = (const LAS int*)(F.lds + UT_OFF + 256); const LAS int* cnts = mbs + 72;
    const int NU = 4 * mbs[64];
    if (F.tid < 16) { const int U = F.c + (F.tid + 16 * chunk) * F.G; int e = 0, mbid = 0, pnl = 0;
        if (U < NU) { mbid = U >> 2; pnl = U & 3; for (int j = 1; j < 64; ++j) if (mbs[j] <= mbid) e = j; }
        ut[4 * F.tid] = mbid; ut[4 * F.tid + 1] = e * 4 + pnl; ut[4 * F.tid + 2] = F.tid; ut[4 * F.tid + 3] = (U < NU) ? e : -1; }
    __syncthreads();
    int n = 0;
    for (int i = 0; i < 16; ++i) if (ut[4 * i + 3] >= 0) n = i + 1;
    if (GATHER_TOK) {
        const int* LIST = WSP(int, WS_LIST);
        for (int i = F.tid >> 8; i < n; i += 2) { const int e = ut[4 * i + 3], mbid = ut[4 * i], sl = F.tid & 255; const int s = 256 * (mbid - mbs[e]) + sl;
            tokt[i * 256 + sl] = (s < cnts[e]) ? (unsigned)LIST[(size_t)e * 65536 + s] : 0u; }
    }
    __syncthreads();
    return n;
}
__device__ __forceinline__ void moe_gateup_phase(Frame& F, int l) {
    moe_block_starts(F, l);
    const int NU = 4 * ((const LAS int*)(F.lds + UT_OFF + 256))[64];
    for (int chunk = 0; chunk * 16 * F.G < NU; ++chunk) {
        const int n = moe_build_tables<true>(F, l, chunk);
        pg8::Gemm g{WSP(bf16, WS_H), WSP(bf16, WS_WGU) + (size_t)l * NEXP * 1024 * 1024, DM, DM};
        pg8::TableOrder S{(const LAS int*)(F.lds + UT_OFF), (const LAS unsigned*)(F.lds + TAB_OFF), n};
        EpiGateUp E{WSP(bf16, WS_HID)};
        pg8::gemm_phase<EpiGateUp, pg8::TableOrder, true, true>(F.lds + RING_OFF, g, S, E, F.tid);
        __syncthreads();
    }
}
__device__ __forceinline__ void moe_down_phase(Frame& F, int l) {
    moe_block_starts(F, l);
    const int NU = 4 * ((const LAS int*)(F.lds + UT_OFF + 256))[64];
    for (int chunk = 0; chunk * 16 * F.G < NU; ++chunk) {
        const int n = moe_build_tables<false>(F, l, chunk);
        pg8::Gemm g{WSP(bf16, WS_HID), WSP(bf16, WS_WD) + (size_t)l * NEXP * 1024 * DEXP, DEXP, DEXP};
        pg8::TableOrder S{(const LAS int*)(F.lds + UT_OFF), (const LAS unsigned*)(F.lds + TAB_OFF), n};
        EpiStoreBf16 E{WSP(bf16, WS_Y), DM, 3};
        pg8::gemm_phase<EpiStoreBf16, pg8::TableOrder, true, false>(F.lds + RING_OFF, g, S, E, F.tid);
        __syncthreads();
    }
}

template <int PHSEL>
__global__ void __launch_bounds__(512, 2) trunk_fwd(Args args) {
    extern __shared__ __attribute__((aligned(16))) unsigned char lds_raw[];
    Frame F;
    F.lds = (LAS unsigned char*)lds_raw; F.MISC = (volatile LAS unsigned*)(F.lds + MISC_OFF);
    F.tid = threadIdx.x; F.lane = F.tid & 63; F.wave = __builtin_amdgcn_readfirstlane(F.tid >> 6); F.G = gridDim.x; F.c = blockIdx.x;
    const int wave0 = F.wave;
    F.ws = args.ws; F.out = args.out; F.ctl = (gu32*)(args.ws + WS_CTL);
    for (int u = F.tid; u < 32; u += 512) F.MISC[u] = 0u;
    __syncthreads();
    const int lo = args.ph_lo, hi = args.ph_hi;
    if (hi - lo > 1) (void)xcd_barrier_post((unsigned*)(F.ctl + CW_BAR), F.MISC + 8);
#define EN(j) (PHSEL < 0 || PHSEL == (j))
#define PB() CArgs* Ap_ = (CArgs*)__builtin_amdgcn_kernarg_segment_ptr(); asm volatile("" : "+s"(Ap_)); CArgs& A_ = *Ap_; do { { int c_ = (int)blockIdx.x, g_ = (int)gridDim.x, w_ = wave0; asm volatile("" : "+s"(c_), "+s"(g_), "+s"(w_)); F.c = c_; F.G = g_; F.wave = w_; } { int ln_; asm volatile("v_mbcnt_lo_u32_b32 %0, -1, 0\n\tv_mbcnt_hi_u32_b32 %0, -1, %0" : "=v"(ln_)); F.lane = ln_; } F.tid = F.wave * 64 + F.lane; F.ws = A_.ws; F.out = A_.out; F.ctl = (gu32*)(A_.ws + WS_CTL); } while (0)
#define IN(k) (lo <= (k) && (k) < hi)
#define SEAM(k) do { if (IN(k) && IN((k) + 1)) { XcdBarrier b_; b_.bar = (unsigned*)(F.ctl + CW_BAR); b_.x = xb_xcc_id(); b_.st = F.MISC + 8; xcd_barrier(b_); } } while (0)
    if (EN(0) && IN(0)) { PB(); prologue(F, A_); SEAM(0); }
    for (int l = 0; l < DEPTH; ++l) {
        const int p0 = 1 + 8 * l;
        if (EN(1) && IN(p0)) { PB(); int lq = l; asm volatile("" : "+s"(lq)); mix_norm_phase<false>(F, A_, lq); SEAM(p0); }
        if (EN(2) && IN(p0 + 1)) { PB(); int lq = l; asm volatile("" : "+s"(lq));
            pg8::Gemm g{WSP(bf16, WS_H), WSP(bf16, WS_WIN) + (size_t)lq * PN * DM, DM, DM}; pg8::StaticOrder S; S.init(NTOK, PN, F.G, F.c);
            EpiStoreBf16 E{WSP(bf16, WS_PROJ), PN, 0xffff};
            pg8::gemm_phase<EpiStoreBf16, pg8::StaticOrder, true, false>(F.lds + RING_OFF, g, S, E, F.tid);
            SEAM(p0 + 1); }
        if (EN(3) && IN(p0 + 2)) { PB(); int lq = l; asm volatile("" : "+s"(lq)); mla_up_phase(F, A_, lq); SEAM(p0 + 2); }
        if (EN(4) && IN(p0 + 3)) { PB(); int lq = l; asm volatile("" : "+s"(lq)); attn_phase(F, A_, lq); SEAM(p0 + 3); }
        if (EN(5) && IN(p0 + 4)) { PB(); int lq = l; asm volatile("" : "+s"(lq));
            pg8::Gemm g{WSP(bf16, WS_MIX), WSP(bf16, WS_WOUT) + (size_t)lq * DM * DM, DM, DM}; pg8::StaticOrder S; S.init(NTOK, DM, F.G, F.c);
            EpiOut E{lq == 0 ? (const float*)A_.in[0] : F.out, F.out, WSP(float, WS_MOD) + (size_t)lq * NB * 6144 + 2 * 1024};
            pg8::gemm_phase<EpiOut, pg8::StaticOrder, true, false>(F.lds + RING_OFF, g, S, E, F.tid);
            SEAM(p0 + 4); }
        if (EN(6) && IN(p0 + 5)) { PB(); int lq = l; asm volatile("" : "+s"(lq)); ffn_router_phase(F, A_, lq); SEAM(p0 + 5); }
        if (EN(7) && IN(p0 + 6)) { PB(); int lq = l; asm volatile("" : "+s"(lq)); moe_gateup_phase(F, lq); SEAM(p0 + 6); }
        if (EN(8) && IN(p0 + 7)) { PB(); int lq = l; asm volatile("" : "+s"(lq)); moe_down_phase(F, lq); SEAM(p0 + 7); }
    }
    if (EN(9) && IN(NPHASE - 1)) { PB(); mix_norm_phase<true>(F, A_, DEPTH); }
#undef IN
#undef SEAM
}

extern "C" void kernel_launch(void* const* d_in, const int* in_sizes, int n_in, void* d_out, int out_size, void* d_ws, size_t ws_size, hipStream_t stream) {
    static int grid = 0;
    if (grid == 0) {
        if (n_in != 26 || out_size != NTOK * DM || ws_size < WS_END) { fprintf(stderr, "kernel_launch: unexpected shapes (n_in %d, out %d, ws %zu < %zu); nothing launched\n", n_in, out_size, ws_size, (size_t)WS_END); grid = -1; return; }
        int dev = 0, cus = 0, per_cu = 0;
        if (hipGetDevice(&dev) != hipSuccess || hipDeviceGetAttribute(&cus, hipDeviceAttributeMultiprocessorCount, dev) != hipSuccess) { grid = -1; return; }
#if MK_MULTI
#define SA(T) if (hipFuncSetAttribute((const void*)trunk_fwd<T>, hipFuncAttributeMaxDynamicSharedMemorySize, LDS_BYTES) != hipSuccess) { fprintf(stderr, "kernel_launch: hipFuncSetAttribute failed\n"); grid = -1; return; }
        SA(0) SA(1) SA(2) SA(3) SA(4) SA(5) SA(6) SA(7) SA(8) SA(9)
#undef SA
#else
        if (hipFuncSetAttribute((const void*)trunk_fwd<-1>, hipFuncAttributeMaxDynamicSharedMemorySize, LDS_BYTES) != hipSuccess) { fprintf(stderr, "kernel_launch: hipFuncSetAttribute failed\n"); grid = -1; return; }
        if (hipOccupancyMaxActiveBlocksPerMultiprocessor(&per_cu, (const void*)trunk_fwd<-1>, 512, LDS_BYTES) != hipSuccess || per_cu < 1) { fprintf(stderr, "kernel_launch: occupancy query says %d\n", per_cu); (void)hipGetLastError(); }
#endif
        (void)per_cu;
        grid = cus;
    }
    if (grid < 0) return;
    (void)hipMemsetAsync((char*)d_ws + WS_CTL, 0, CTL_ZERO_BYTES, stream);
    Args a{};
    for (int i = 0; i < 26; ++i) a.in[i] = d_in[i];
    a.out = (float*)d_out; a.ws = (unsigned char*)d_ws;
#if MK_MULTI
    for (int p = 0; p < NPHASE; ++p) { a.ph_lo = p; a.ph_hi = p + 1; const int ty = (p == 0) ? 0 : (p == NPHASE - 1) ? 9 : 1 + (p - 1) % 8;
        switch (ty) {
#define LK(T) case T: hipLaunchKernelGGL(trunk_fwd<T>, dim3(grid), dim3(512), LDS_BYTES, stream, a); break;
            LK(0) LK(1) LK(2) LK(3) LK(4) LK(5) LK(6) LK(7) LK(8) LK(9)
#undef LK
        } }
#else
    a.ph_lo = 0; a.ph_hi = NPHASE;
    hipLaunchKernelGGL(trunk_fwd<-1>, dim3(grid), dim3(512), LDS_BYTES, stream, a);
#endif
    const hipError_t le = hipPeekAtLastError();
    if (le != hipSuccess) fprintf(stderr, "kernel_launch: launch failed: %s\n", hipGetErrorName(le));
}
```

```cpp
#include <hip/hip_runtime.h>
#include <cstdio>
#include <cstdint>

#ifndef MK_MULTI
#define MK_MULTI 0
#endif

#define GAS __attribute__((address_space(1)))
#define LAS __attribute__((address_space(3)))
typedef unsigned short bf16;
typedef unsigned v4u __attribute__((ext_vector_type(4)));
typedef unsigned v2u __attribute__((ext_vector_type(2)));
typedef float f32x4 __attribute__((ext_vector_type(4)));
typedef float f32x2 __attribute__((ext_vector_type(2)));
typedef float f32x16 __attribute__((ext_vector_type(16)));
typedef short bf16x8 __attribute__((ext_vector_type(8)));
typedef short s16x4 __attribute__((ext_vector_type(4)));
typedef int i32x4 __attribute__((ext_vector_type(4)));
typedef GAS unsigned gu32;

constexpr int NB = 32, SEQ = 2048, DM = 1024, NTOK = NB * SEQ, DEPTH = 4;
constexpr int P_IN = 2660, PN = 2816;
constexpr int PC_CKV = 256, PC_KROPE = 384, PC_FOX = 512, PC_CONV = 1280, PC_DIFF = 2048;
constexpr int SRC_CKV = 192, SRC_KROPE = 320, SRC_FOX = 352, SRC_FLOG = 1120, SRC_CONV = 1124, SRC_DIFF = 1892;
constexpr int KUP = 384, NUP = 1024;
constexpr int NEXP = 64, DEXP = 512, NLOG = 80;
constexpr int MAXMB = 576, MAXSLOT = MAXMB * 256;
constexpr float EPS = 1e-6f, LOG2E = 1.4426950408889634f;
constexpr int NPHASE = 2 + 8 * DEPTH;

constexpr size_t MiB = 1u << 20;
constexpr size_t WS_CTL = 0, CTL_ZERO_BYTES = 1 * MiB;
constexpr size_t WS_MOD = 1 * MiB;
constexpr size_t WS_T5 = 4 * MiB;
constexpr size_t WS_LAM = 4 * MiB + 64 * 1024;
constexpr size_t WS_WF = 4 * MiB + 128 * 1024;
constexpr size_t WS_WRT = 4 * MiB + 256 * 1024;
constexpr size_t WS_FLOG = 5 * MiB + 512 * 1024;
constexpr size_t WS_SS = 1563 * MiB;
constexpr size_t WS_FB = 7 * MiB;
constexpr size_t WS_DEST = 8 * MiB;
constexpr size_t WS_GATE = 9 * MiB;
constexpr size_t WS_LIST = 10 * MiB;
constexpr size_t WS_WIN = 26 * MiB;
constexpr size_t WS_WUP = 48 * MiB;
constexpr size_t WS_WOUT = 51 * MiB;
constexpr size_t WS_WGU = 59 * MiB;
constexpr size_t WS_WD = 571 * MiB;
constexpr size_t WS_H = 827 * MiB;
constexpr size_t WS_PROJ = 955 * MiB;
constexpr size_t WS_MLA = 1307 * MiB;
constexpr size_t WS_MIX = 1435 * MiB;
constexpr size_t WS_END = 1567 * MiB;
constexpr size_t WS_Y = WS_PROJ, WS_HID = WS_MLA;
static_assert((size_t)MAXSLOT * 1024 * 2 <= WS_MLA - WS_PROJ && (size_t)MAXSLOT * 512 * 2 <= WS_SS - WS_MLA, "overlays fit");
constexpr int CW_TMO = 0, CW_CODE = 1, CW_BAR = 4096, CW_Q = 8192  , CW_GCNT = 12288  ;

constexpr int RING_OFF = 0, RING_BYTES = 131072;
constexpr int TAB_OFF = RING_BYTES, TAB_BYTES = 16384;
constexpr int UT_OFF = TAB_OFF + TAB_BYTES;
constexpr int MISC_OFF = UT_OFF + 1024;
constexpr int LDS_BYTES = MISC_OFF + 128;
static_assert(LDS_BYTES <= 160 * 1024, "LDS");

#define RLX_AGENT __ATOMIC_RELAXED, __HIP_MEMORY_SCOPE_AGENT
#define LDS_WAIT() asm volatile("s_waitcnt lgkmcnt(0)" ::: "memory")
#define VM_WAIT() asm volatile("s_waitcnt vmcnt(0)" ::: "memory")
__device__ __forceinline__ unsigned f2bf(float f) { unsigned u = __builtin_bit_cast(unsigned, f); return (u + 0x7fffu + ((u >> 16) & 1u)) >> 16; }
__device__ __forceinline__ unsigned pk2(float lo, float hi) { return f2bf(lo) | (f2bf(hi) << 16); }
__device__ __forceinline__ float bflo(unsigned w) { return __builtin_bit_cast(float, w << 16); }
__device__ __forceinline__ float bfhi(unsigned w) { return __builtin_bit_cast(float, w & 0xffff0000u); }
__device__ __forceinline__ float bf2f(bf16 h) { return __builtin_bit_cast(float, (unsigned)h << 16); }
__device__ __forceinline__ float shx(float v, int o, int lane) { return __builtin_bit_cast(float, __builtin_amdgcn_ds_bpermute((lane ^ o) << 2, __builtin_bit_cast(int, v))); }
__device__ __forceinline__ float wave_sum(float v, int lane) {
#pragma unroll
    for (int o = 1; o < 64; o <<= 1) v += shx(v, o, lane);
    return v;
}
__device__ __forceinline__ int opq(int v) { asm volatile("" : "+v"(v)); return v; }
__device__ __forceinline__ float fast_exp2(float x) { return __builtin_amdgcn_exp2f(x); }
__device__ __forceinline__ float fast_rcp(float x) { return __builtin_amdgcn_rcpf(x); }
__device__ __forceinline__ float fast_rsq(float x) { return __builtin_amdgcn_rsqf(x); }
__device__ __forceinline__ float silu_f(float x) { return x * fast_rcp(1.f + fast_exp2(-x * LOG2E)); }

#define XB_TMO      128
#define XB_XCNT(j)  (256  + 64 * (j))
#define XB_XSUB(j)  (1280 + 64 * (j))
#define XB_XGEN(j)  (2304 + 64 * (j))
#define XB_TOP      3328
#define XB_TOPGEN   3392
#define XCD_BAR_WORDS 3456
#define XB_SPIN_CAP (1u << 22)
__device__ __forceinline__ unsigned xb_ld(unsigned* p)              { return __hip_atomic_load(p, __ATOMIC_RELAXED, __HIP_MEMORY_SCOPE_AGENT); }
__device__ __forceinline__ unsigned xb_add(unsigned* p, unsigned v) { return __hip_atomic_fetch_add(p, v, __ATOMIC_RELAXED, __HIP_MEMORY_SCOPE_AGENT); }
__device__ __forceinline__ unsigned xb_xcc_id() { return (unsigned)__builtin_amdgcn_s_getreg((3 << 11) | 20) & 0xFu; }
#define XB_SPIN(cond, bar) do { unsigned _sp = 0; while (cond) { __builtin_amdgcn_s_sleep(1); \
    if ((++_sp & 255u) == 0u) { if (xb_ld(&(bar)[XB_TMO])) break; if (_sp > XB_SPIN_CAP) { atomicAdd(&(bar)[XB_TMO], 1u); break; } } } } while (0)
struct XcdBarrier { unsigned* bar; unsigned x; volatile LAS unsigned* st; };
__device__ __forceinline__ XcdBarrier xcd_barrier_post(unsigned* bar, volatile LAS unsigned* st) {
    XcdBarrier b; b.bar = bar; b.x = xb_xcc_id(); b.st = st;
    if (threadIdx.x == 0) (void)xb_add(&bar[XB_XCNT(b.x)], 1u);
    return b;
}
__device__ __forceinline__ void xcd_barrier_complete(unsigned* bar, unsigned x, unsigned& nloc, unsigned& nx) {
    const unsigned G = gridDim.x * gridDim.y * gridDim.z;
    unsigned sum, cnt, mine, sp = 0u;
    for (;;) {
        sum = 0u; cnt = 0u; mine = 0u;
#pragma nounroll
        for (unsigned j = 0; j < 16; ++j) { const unsigned c = xb_ld(&bar[XB_XCNT(j)]); sum += c; cnt += (c > 0u) ? 1u : 0u; mine = (j == x) ? c : mine; }
        if (sum == G) break;
        __builtin_amdgcn_s_sleep(1);
        if ((++sp & 255u) == 0u) { if (xb_ld(&bar[XB_TMO])) break; if (sp > XB_SPIN_CAP) { atomicAdd(&bar[XB_TMO], 1u); break; } }
    }
    nloc = mine > 0u ? mine : 1u; nx = cnt > 0u ? cnt : 1u;
}
__device__ __forceinline__ void xcd_barrier(const XcdBarrier& b) {
    asm volatile("s_waitcnt vmcnt(0)" ::: "memory");
    __syncthreads();
    if (threadIdx.x == 0) {
        unsigned* bar = b.bar;
        __builtin_amdgcn_s_waitcnt(0);
        unsigned nloc = b.st[0], nx = b.st[1];
        if (nloc == 0u) { xcd_barrier_complete(bar, b.x, nloc, nx); b.st[0] = nloc; b.st[1] = nx; }
        const unsigned old = xb_add(&bar[XB_XSUB(b.x)], 1u);
        const unsigned gen = old / nloc;
        if (old + 1u == (gen + 1u) * nloc) {
            __builtin_amdgcn_fence(__ATOMIC_RELEASE, "agent");
            asm volatile("s_waitcnt vmcnt(0)" ::: "memory");
            const unsigned og = xb_add(&bar[XB_TOP], 1u);
            const unsigned tg = og / nx;
            if (og + 1u == (tg + 1u) * nx) xb_add(&bar[XB_TOPGEN], 1u);
            else XB_SPIN(xb_ld(&bar[XB_TOPGEN]) == tg, bar);
            __builtin_amdgcn_fence(__ATOMIC_ACQUIRE, "agent");
            xb_add(&bar[XB_XGEN(b.x)], 1u);
            asm volatile("s_waitcnt vmcnt(0)" ::: "memory");
        } else {
            XB_SPIN(xb_ld(&bar[XB_XGEN(b.x)]) == gen, bar);
            __builtin_amdgcn_fence(__ATOMIC_ACQUIRE, "agent");
            asm volatile("s_waitcnt vmcnt(0)" ::: "memory");
        }
    }
    __syncthreads();
}

namespace pg8 {
constexpr int BM = 256, BK = 64, HALF = 128, HTB = HALF * BK * 2, NXCD = 8, WGM = 8;
__host__ __device__ __forceinline__ int lds_byte(int r, int c) { const int st = (r >> 4) * 2 + (c >> 5), rr = r & 15, cc = c & 31, ob = rr * 64 + cc * 2; return st * 1024 + (ob ^ (((ob >> 9) & 1) << 5)); }
__host__ __device__ __forceinline__ void stage_rc(int b, int& R, int& C) { const int st = b / 1024, sb = b % 1024, swz = sb ^ (((sb >> 9) & 1) << 5); R = (st >> 1) * 16 + swz / 64; C = (st & 1) * 32 + (swz % 64) / 2; }
__host__ __device__ __forceinline__ int perm32(int rho) { const int n = rho >> 4, i = rho & 15; return 8 * (i >> 2) + 4 * n + (i & 3); }
struct Unit { int pm, pn, aux; };
struct Gemm { const bf16* A; const bf16* Bt; int K; int lda; };

struct StaticOrder {
    int nM, nN, nwg, G, c;
    __device__ void init(int M, int N, int G_, int c_) { nM = M / BM; nN = N / BM; nwg = nM * nN; G = G_; c = c_; }
    __device__ __forceinline__ bool next(int i, Unit& u) const {
        const long L = (long)i * G + c; if (L >= nwg) return false;
        int wgid = (int)L; { const int q = nwg / NXCD, r = nwg % NXCD, xcd = wgid % NXCD, off = wgid / NXCD; wgid = (xcd < r ? xcd * (q + 1) : r * (q + 1) + (xcd - r) * q) + off; }
        const int nig = WGM * nN, gid = wgid / nig, fm = gid * WGM, gsz = (nM - fm) < WGM ? (nM - fm) : WGM;
        u.pm = fm + ((wgid % nig) % gsz); u.pn = (wgid % nig) / gsz; u.aux = 0; return true;
    }
    __device__ __forceinline__ unsigned tok(const Unit&, int) const { return 0u; }
};
struct PanelOrder {
    int pm, nN;
    __device__ __forceinline__ bool next(int i, Unit& u) const { if (i >= nN) return false; int p_ = pm; asm volatile("" : "+s"(p_)); u.pm = p_; u.pn = i; u.aux = 0; return true; }
    __device__ __forceinline__ unsigned tok(const Unit&, int) const { return 0u; }
};
struct TableOrder {
    const LAS int* ut; const LAS unsigned* tokt; int n;
    __device__ __forceinline__ bool next(int i, Unit& u) const { if (i >= n) return false; const i32x4 d = *(const LAS i32x4*)(ut + 4 * i); u.pm = __builtin_amdgcn_readfirstlane(d.x); u.pn = __builtin_amdgcn_readfirstlane(d.y); u.aux = __builtin_amdgcn_readfirstlane(d.z); return true; }
    __device__ __forceinline__ unsigned tok(const Unit& u, int slot) const { return tokt[u.aux * 256 + slot]; }
};

__device__ __forceinline__ unsigned cvt_pk_bf16(float lo, float hi) { unsigned r; asm volatile("v_cvt_pk_bf16_f32 %0, %1, %2" : "=v"(r) : "v"(lo), "v"(hi)); return r; }

template <class Epi, class Sched, bool ALIGN_EPI, bool GATHER>
__device__ __forceinline__ void gemm_phase(LAS unsigned char* lds, const Gemm g, const Sched& S, const Epi& E, const int tid_in) {
    const int tid = opq(tid_in), wid = __builtin_amdgcn_readfirstlane(tid >> 6), lane = tid & 63, wr = wid >> 2, wc = wid & 3, fr = lane & 15, fq = lane >> 4;
    const int K = g.K, nt = K / BK, lda = g.lda;
    unsigned voffA[2], voffB[2]; int RA[2]; unsigned CA[2];
    const size_t kstep = (size_t)(BK * 2);
    const size_t hstepA = (size_t)HALF * lda * 2, hstepB = (size_t)HALF * K * 2;
    const size_t tstepA = 2 * hstepA, tstepB = 2 * hstepB;
#pragma unroll
    for (int i = 0; i < 2; ++i) { int R, C; stage_rc(tid * 16 + i * 8192, R, C); const int Rb = Epi::PERM ? ((R & ~31) + perm32(R & 31)) : R;
        RA[i] = R; CA[i] = (unsigned)C * 2u; voffB[i] = (unsigned)(Rb * K + C) * 2u; voffA[i] = (unsigned)(R * lda + C) * 2u; }
    const unsigned ldsw = (unsigned)wid * 1024u;
    const int aoff = lds_byte(wr * 64 + fr, fq * 8), boff = lds_byte(wc * 32 + fr, fq * 8);
#define PG8_SA(b, h) (((b) * 2 + (h)) * HTB)
#define PG8_SB(b, h) ((4 + (b) * 2 + (h)) * HTB)
#define PG8_GLDS(gp, bufoff, _i) __builtin_amdgcn_global_load_lds((const unsigned*)(gp), (LAS unsigned*)(lds + (bufoff) + ldsw + (_i) * 8192), 16, 0, 0)
#define PG8_STAGE_B(bufoff, gbase) do { _Pragma("unroll") for (int _i = 0; _i < 2; ++_i) PG8_GLDS((const char*)(gbase) + voffB[_i], bufoff, _i); } while (0)
#define PG8_STAGE_A(bufoff, gbase, OA, h) do { _Pragma("unroll") for (int _i = 0; _i < 2; ++_i) { if constexpr (GATHER) PG8_GLDS((const char*)(gbase) + OA[h][_i], bufoff, _i); else PG8_GLDS((const char*)(gbase) + (size_t)(h) * hstepA + voffA[_i], bufoff, _i); } } while (0)
#define PG8_LDA(dst, b, h) do { _Pragma("unroll") for (int m = 0; m < 4; ++m) _Pragma("unroll") for (int k = 0; k < 2; ++k) dst[m][k] = *(const LAS bf16x8*)(lds + PG8_SA(b, h) + aoff + m * 2048 + k * 1024); } while (0)
#define PG8_LDB(dst, b, h) do { _Pragma("unroll") for (int n = 0; n < 2; ++n) _Pragma("unroll") for (int k = 0; k < 2; ++k) dst[n][k] = *(const LAS bf16x8*)(lds + PG8_SB(b, h) + boff + n * 2048 + k * 1024); } while (0)
#define PG8_MMA(ai, bj, At, Bt) do { __builtin_amdgcn_s_setprio(1); _Pragma("unroll") for (int m = 0; m < 4; ++m) _Pragma("unroll") for (int n = 0; n < 2; ++n) _Pragma("unroll") for (int k = 0; k < 2; ++k) \
        acc[ai][bj][m][n] = __builtin_amdgcn_mfma_f32_16x16x32_bf16(Bt[n][k], At[m][k], acc[ai][bj][m][n], 0, 0, 0); __builtin_amdgcn_s_setprio(0); } while (0)
#define PG8_WAIT_V(n) asm volatile("s_waitcnt vmcnt(" #n ")" ::: "memory")
#define PG8_WAIT_L(n) asm volatile("s_waitcnt lgkmcnt(" #n ")" ::: "memory")
#define PG8_BAR __builtin_amdgcn_s_barrier()
#define PG8_SCHED __builtin_amdgcn_sched_barrier(0)
#define PG8_SETOA(OA, U) do { _Pragma("unroll") for (int _h = 0; _h < 2; ++_h) _Pragma("unroll") for (int _i = 0; _i < 2; ++_i) \
        OA[_h][_i] = GATHER ? (S.tok(U, _h * HALF + RA[_i]) * (unsigned)lda * 2u + CA[_i]) : 0u; } while (0)
    Unit cur, nxt; int ui = 0;
    if (!S.next(0, cur)) return;
    f32x4 acc[2][2][4][2];
#pragma unroll
    for (int a = 0; a < 2; ++a)
#pragma unroll
        for (int b = 0; b < 2; ++b)
#pragma unroll
            for (int m = 0; m < 4; ++m)
#pragma unroll
                for (int n = 0; n < 2; ++n) acc[a][b][m][n] = (f32x4){0.f, 0.f, 0.f, 0.f};
    bf16x8 At[4][2], B0[2][2], B1[2][2];
    unsigned oc[2][2], on[2][2];
    PG8_SETOA(oc, cur);
    const char* cA = (const char*)g.A + (GATHER ? (size_t)0 : (size_t)cur.pm * tstepA); const char* cB = (const char*)g.Bt + (size_t)cur.pn * tstepB;
    PG8_STAGE_B(PG8_SB(0, 0), cB); PG8_STAGE_B(PG8_SB(0, 1), cB + hstepB); PG8_STAGE_A(PG8_SA(0, 0), cA, oc, 0); PG8_STAGE_A(PG8_SA(0, 1), cA, oc, 1);
    if (wr == 1) PG8_BAR;
    PG8_WAIT_V(2); PG8_BAR;
    PG8_STAGE_B(PG8_SB(1, 0), cB + kstep); PG8_STAGE_A(PG8_SA(1, 0), cA + kstep, oc, 0); PG8_STAGE_B(PG8_SB(1, 1), cB + hstepB + kstep);
    PG8_WAIT_V(6); PG8_BAR;
    for (;;) {
        const bool has_next = S.next(ui + 1, nxt);
        const char* nA = has_next ? (const char*)g.A + (GATHER ? (size_t)0 : (size_t)nxt.pm * tstepA) : cA; const char* nB = has_next ? (const char*)g.Bt + (size_t)nxt.pn * tstepB : cB;
        if (has_next) { PG8_SETOA(on, nxt); } else {
#pragma unroll
            for (int _h = 0; _h < 2; ++_h)
#pragma unroll
                for (int _i = 0; _i < 2; ++_i) on[_h][_i] = oc[_h][_i]; }
#pragma nounroll
        for (int t = 0; t < nt; t += 2) {
            const bool last = (t == nt - 2);
            const char* a1 = cA + (size_t)(t + 1) * kstep;
            const char* a2 = last ? nA : cA + (size_t)(t + 2) * kstep; const char* b2 = last ? nB : cB + (size_t)(t + 2) * kstep;
            const char* a3 = a2 + kstep; const char* b3 = b2 + kstep;
            unsigned o2[2][2];
#pragma unroll
            for (int _h = 0; _h < 2; ++_h)
#pragma unroll
                for (int _i = 0; _i < 2; ++_i) o2[_h][_i] = last ? on[_h][_i] : oc[_h][_i];
            PG8_LDB(B0, 0, 0); PG8_LDB(B1, 0, 1); PG8_SCHED; PG8_LDA(At, 0, 0); PG8_STAGE_A(PG8_SA(1, 1), a1, oc, 1);
            PG8_WAIT_V(8); PG8_WAIT_L(0); PG8_BAR; PG8_MMA(0, 0, At, B0); PG8_MMA(0, 1, At, B1); PG8_BAR; PG8_SCHED;
            PG8_LDA(At, 0, 1); PG8_STAGE_B(PG8_SB(0, 0), b2); PG8_STAGE_B(PG8_SB(0, 1), b2 + hstepB); PG8_STAGE_A(PG8_SA(0, 0), a2, o2, 0);
            PG8_WAIT_V(8); PG8_WAIT_L(0); PG8_BAR; PG8_MMA(1, 0, At, B0); PG8_MMA(1, 1, At, B1); PG8_BAR; PG8_SCHED;
            PG8_LDB(B0, 1, 0); PG8_LDB(B1, 1, 1); PG8_SCHED; PG8_LDA(At, 1, 0); PG8_STAGE_A(PG8_SA(0, 1), a2, o2, 1);
            PG8_WAIT_V(8); PG8_WAIT_L(0); PG8_BAR; PG8_MMA(0, 0, At, B0); PG8_MMA(0, 1, At, B1); PG8_BAR; PG8_SCHED;
            PG8_LDA(At, 1, 1); PG8_STAGE_B(PG8_SB(1, 0), b3); PG8_STAGE_B(PG8_SB(1, 1), b3 + hstepB); PG8_STAGE_A(PG8_SA(1, 0), a3, o2, 0);
            PG8_WAIT_V(8); PG8_WAIT_L(0); PG8_BAR; PG8_MMA(1, 0, At, B0); PG8_MMA(1, 1, At, B1); PG8_BAR; PG8_SCHED;
        }
        if constexpr (ALIGN_EPI) { if (wr == 0) PG8_BAR; }
        E(acc, cur, wr, wc, fr, fq);
        if (!has_next) break;
#pragma unroll
        for (int a = 0; a < 2; ++a)
#pragma unroll
            for (int b = 0; b < 2; ++b)
#pragma unroll
                for (int m = 0; m < 4; ++m)
#pragma unroll
                    for (int n = 0; n < 2; ++n) acc[a][b][m][n] = (f32x4){0.f, 0.f, 0.f, 0.f};
        cur = nxt; cA = nA; cB = nB; ++ui;
#pragma unroll
        for (int _h = 0; _h < 2; ++_h)
#pragma unroll
            for (int _i = 0; _i < 2; ++_i) oc[_h][_i] = on[_h][_i];
        if constexpr (ALIGN_EPI) { if (wr == 1) PG8_BAR; }
    }
    PG8_WAIT_V(0);
    if constexpr (!ALIGN_EPI) { if (wr == 0) PG8_BAR; }
    PG8_BAR;
#undef PG8_SA
#undef PG8_SB
#undef PG8_GLDS
#undef PG8_STAGE_A
#undef PG8_STAGE_B
#undef PG8_LDA
#undef PG8_LDB
#undef PG8_MMA
#undef PG8_WAIT_V
#undef PG8_WAIT_L
#undef PG8_BAR
#undef PG8_SCHED
#undef PG8_SETOA
}
}

struct Args { const void* in[26]; float* out; unsigned char* ws; int ph_lo, ph_hi; };
typedef const __attribute__((address_space(4))) Args CArgs;
struct Frame {
    LAS unsigned char* lds;
    volatile LAS unsigned* MISC;
    gu32* ctl;
    int tid, lane, wave, G, c;
    unsigned char* ws; float* out;
};
#define IN_x ((const float*)A.in[0])
#define IN_cnd ((const float*)A.in[1])
#define IN_pos ((const int*)A.in[2])
#define IN_t5 ((const float*)A.in[3])
#define IN_ada_w ((const float*)A.in[4])
#define IN_ada_b ((const float*)A.in[5])
#define IN_g_mix ((const float*)A.in[6])
#define IN_g_ffn ((const float*)A.in[7])
#define IN_w_in ((const float*)A.in[8])
#define IN_gq ((const float*)A.in[9])
#define IN_w_uq ((const float*)A.in[10])
#define IN_gkv ((const float*)A.in[11])
#define IN_w_ukv ((const float*)A.in[12])
#define IN_fb ((const float*)A.in[13])
#define IN_conv_w ((const float*)A.in[14])
#define IN_dlam ((const float*)A.in[15])
#define IN_subln ((const float*)A.in[16])
#define IN_w_out ((const float*)A.in[17])
#define IN_rg_w ((const float*)A.in[18])
#define IN_rg_b ((const float*)A.in[19])
#define IN_re_w ((const float*)A.in[20])
#define IN_re_b ((const float*)A.in[21])
#define IN_wg ((const float*)A.in[22])
#define IN_wu ((const float*)A.in[23])
#define IN_wd ((const float*)A.in[24])
#define IN_g_fin ((const float*)A.in[25])
#define WSP(T, off) ((T*)(F.ws + (off)))

template <class Fn>
__device__ __forceinline__ void transpose_item(const Fn& f, bf16* dst, int ldd, int k0, int n0, LAS float* scr, int lane) {
    const int nq = lane & 15, kr = lane >> 4;
    f32x4 v[16];
#pragma unroll
    for (int i = 0; i < 16; ++i) v[i] = f(k0 + 4 * i + kr, n0 + 4 * nq);
#pragma unroll
    for (int i = 0; i < 16; ++i) { const int k = 4 * i + kr;
        scr[(4 * nq + 0) * 65 + k] = v[i].x; scr[(4 * nq + 1) * 65 + k] = v[i].y; scr[(4 * nq + 2) * 65 + k] = v[i].z; scr[(4 * nq + 3) * 65 + k] = v[i].w; }
    LDS_WAIT(); asm volatile("" ::: "memory");
    const int kc = lane & 7, nr = lane >> 3;
#pragma unroll
    for (int j = 0; j < 8; ++j) { const int n = nr + 8 * j; const LAS float* s = scr + n * 65 + 8 * kc;
        v4u o; o.x = pk2(s[0], s[1]); o.y = pk2(s[2], s[3]); o.z = pk2(s[4], s[5]); o.w = pk2(s[6], s[7]);
        *(GAS v4u*)(dst + (size_t)(n0 + n) * ldd + k0 + 8 * kc) = o; }
    LDS_WAIT(); asm volatile("" ::: "memory");
}
struct SrcPlain {
    const float* W; int ld; int coff; float scale;
    __device__ __forceinline__ f32x4 operator()(int k, int n) const { const f32x4 v = *(const GAS f32x4*)(W + (size_t)k * ld + n + coff); return v * scale; }
};
struct SrcZero { __device__ __forceinline__ f32x4 operator()(int, int) const { return (f32x4){0.f, 0.f, 0.f, 0.f}; } };
struct SrcKrope {
    const float* W;
    __device__ __forceinline__ f32x4 operator()(int k, int n) const { if (n >= PC_KROPE + 32) return (f32x4){0.f, 0.f, 0.f, 0.f}; return *(const GAS f32x4*)(W + (size_t)k * P_IN + SRC_KROPE + (n - PC_KROPE)); }
};
__device__ __forceinline__ int rope_dim_of_pos(int p) { return (p & 4) ? 16 + 4 * (p >> 3) + (p & 3) : 4 * (p >> 3) + (p & 3); }
struct SrcUp {
    const float* wuq; const float* gq; const float* wukv; const float* gkv; float c2a;
    __device__ __forceinline__ float one(int k, int n) const {
        if (n < 384) { if (k >= 192) return 0.f; const int h = n / 96, j = n % 96; const int col = h * 96 + (j < 64 ? j : 64 + rope_dim_of_pos(j - 64)); return gq[k] * wuq[(size_t)k * 384 + col] * c2a; }
        if (n < 512) return 0.f;
        if (k < 256) return 0.f;
        return gkv[k - 256] * wukv[(size_t)(k - 256) * 512 + (n - 512)];
    }
    __device__ __forceinline__ f32x4 operator()(int k, int n) const { return (f32x4){one(k, n), one(k, n + 1), one(k, n + 2), one(k, n + 3)}; }
};

constexpr float C2A = 0.10206207261596577f * LOG2E;
constexpr float C2B = 0.125f * LOG2E;
constexpr float C2D = 0.17677669529663687f * LOG2E;

__device__ __forceinline__ int t5_bucket(int rel) {
    const int n = rel < 0 ? -rel : rel; const int base = rel > 0 ? 16 : 0;
    if (n < 8) return base + n;
    const int fl = 31 - __builtin_clz((unsigned)(n * n));
    int large = 8 + fl - 6; if (large > 15) large = 15;
    return base + large;
}

__device__ __forceinline__ void prologue(Frame& F, CArgs& A) {
    const int gw = F.c * 8 + F.wave, NGW = F.G * 8;
    const int gt = F.c * 512 + F.tid, NGT = F.G * 512;
    {
        LAS float* cs = (LAS float*)(F.lds + RING_OFF);
        bool loaded = false;
        float* MOD = WSP(float, WS_MOD);
        for (int it = F.c; it < DEPTH * 96; it += F.G) {
            if (!loaded) { for (int e = F.tid; e < NB * DM; e += 512) { const int b = e >> 10, k = e & 1023; cs[k * 32 + b] = silu_f(IN_cnd[e]); } loaded = true; __syncthreads(); }
            const int l = it / 96, n0 = (it % 96) * 64;
            const int col = F.tid >> 3, ks = F.tid & 7;
            const float* W = IN_ada_w + (size_t)l * DM * 6144 + n0 + col;
            float acc[32];
#pragma unroll
            for (int b = 0; b < 32; ++b) acc[b] = 0.f;
            for (int kk = 0; kk < 128; ++kk) { const int k = 8 * kk + ks; const float w = W[(size_t)k * 6144];
#pragma unroll
                for (int b4 = 0; b4 < 8; ++b4) { const f32x4 c4 = *(const LAS f32x4*)(cs + k * 32 + 4 * b4); acc[4 * b4] += c4.x * w; acc[4 * b4 + 1] += c4.y * w; acc[4 * b4 + 2] += c4.z * w; acc[4 * b4 + 3] += c4.w * w; } }
#pragma unroll
            for (int b = 0; b < 32; ++b) { float v = acc[b]; v += shx(v, 1, F.lane); v += shx(v, 2, F.lane); v += shx(v, 4, F.lane); acc[b] = v; }
            if (ks == 0) { const float bias = IN_ada_b[l * 6144 + n0 + col];
#pragma unroll
                for (int b = 0; b < 32; ++b) MOD[((size_t)l * NB + b) * 6144 + n0 + col] = acc[b] + bias; }
        }
        __syncthreads();
    }
    { float* T5 = WSP(float, WS_T5);
      for (int i = gt; i < 4 * 2112; i += NGT) { const int h = i / 2112, r = i % 2112; T5[i] = IN_t5[t5_bucket(r - 2047) * 4 + h] * LOG2E; }
      float* LAM = WSP(float, WS_LAM);
      if (gt < DEPTH) { const int l = gt; const float* p = IN_dlam + l * 128; float s0 = 0.f, s1 = 0.f;
          for (int i = 0; i < 32; ++i) { s0 += p[i] * p[32 + i]; s1 += p[64 + i] * p[96 + i]; }
          LAM[l] = expf(s0) - expf(s1) + (0.8f - 0.6f * expf(-0.3f * (float)l)); }
      float* WF = WSP(float, WS_WF);
      for (int i = gt; i < DEPTH * 4 * DM; i += NGT) { const int l = i >> 12, j = (i >> 10) & 3, k = i & 1023; WF[i] = IN_w_in[((size_t)l * DM + k) * P_IN + SRC_FLOG + j]; }
      bf16* WRT = WSP(bf16, WS_WRT);
      for (int i = gt; i < DEPTH * NLOG * DM; i += NGT) { const int l = i / (NLOG * DM), r = i % (NLOG * DM), n = r >> 10, k = r & 1023;
          const float v = n < 8 ? IN_rg_w[((size_t)l * DM + k) * 8 + n] : (n < 72 ? IN_re_w[((size_t)l * DM + k) * 64 + (n - 8)] : 0.f);
          const unsigned hi = f2bf(v); const float lo = v - __builtin_bit_cast(float, hi << 16);
          WRT[((size_t)l * 2 + 0) * NLOG * DM + r] = (bf16)hi; WRT[((size_t)l * 2 + 1) * NLOG * DM + r] = (bf16)f2bf(lo); }
    }
    {
        LAS float* scr = (LAS float*)(F.lds + RING_OFF) + F.wave * (64 * 65);
        constexpr int I_IN = 16 * 44, I_UP = 6 * 16, I_OUT = 16 * 16, I_GU = 16 * 16 * NEXP, I_D = 8 * 16 * NEXP;
        constexpr int I_LAYER = I_IN + I_UP + I_OUT + I_GU + I_D;
        for (int it = gw; it < DEPTH * I_LAYER; it += NGW) {
            const int l = it / I_LAYER; int r = it % I_LAYER;
            if (r < I_IN) {
                const int nb = r / 16, kb = r % 16, n0 = nb * 64, k0 = kb * 64; bf16* dst = WSP(bf16, WS_WIN) + (size_t)l * PN * DM; const float* W = IN_w_in + (size_t)l * DM * P_IN;
                if (n0 < 192) transpose_item(SrcPlain{W, P_IN, 0, 1.f}, dst, DM, k0, n0, scr, F.lane);
                else if (n0 < 256) transpose_item(SrcZero{}, dst, DM, k0, n0, scr, F.lane);
                else if (n0 < 384) transpose_item(SrcPlain{W, P_IN, SRC_CKV - PC_CKV, 1.f}, dst, DM, k0, n0, scr, F.lane);
                else if (n0 < 448) transpose_item(SrcKrope{W}, dst, DM, k0, n0, scr, F.lane);
                else if (n0 < 512) transpose_item(SrcZero{}, dst, DM, k0, n0, scr, F.lane);
                else if (n0 < PC_CONV) transpose_item(SrcPlain{W, P_IN, SRC_FOX - PC_FOX, n0 < PC_FOX + 256 ? C2B : 1.f}, dst, DM, k0, n0, scr, F.lane);
                else if (n0 < PC_DIFF) transpose_item(SrcPlain{W, P_IN, SRC_CONV - PC_CONV, 1.f}, dst, DM, k0, n0, scr, F.lane);
                else transpose_item(SrcPlain{W, P_IN, SRC_DIFF - PC_DIFF, n0 < PC_DIFF + 256 ? C2D : 1.f}, dst, DM, k0, n0, scr, F.lane);
                continue; }
            r -= I_IN;
            if (r < I_UP) { const int nb = r / 6, kb = r % 6;
                transpose_item(SrcUp{IN_w_uq + (size_t)l * 192 * 384, IN_gq + l * 192, IN_w_ukv + (size_t)l * 128 * 512, IN_gkv + l * 128, C2A}, WSP(bf16, WS_WUP) + (size_t)l * NUP * KUP, KUP, kb * 64, nb * 64, scr, F.lane);
                continue; }
            r -= I_UP;
            if (r < I_OUT) { const int nb = r / 16, kb = r % 16;
                transpose_item(SrcPlain{IN_w_out + (size_t)l * DM * DM, DM, 0, 1.f}, WSP(bf16, WS_WOUT) + (size_t)l * DM * DM, DM, kb * 64, nb * 64, scr, F.lane);
                continue; }
            r -= I_OUT;
            if (r < I_GU) { const int e = r / 256, q = r % 256, nb = q / 16, kb = q % 16, n0 = nb * 64;
                const int pn = n0 >> 8, half = (n0 >> 7) & 1, j0 = n0 & 127;
                const float* W = (half ? IN_wu : IN_wg) + ((size_t)l * NEXP + e) * DM * DEXP;
                transpose_item(SrcPlain{W, DEXP, 128 * pn + j0 - n0, 1.f}, WSP(bf16, WS_WGU) + ((size_t)l * NEXP + e) * 1024 * 1024, DM, kb * 64, n0, scr, F.lane);
                continue; }
            r -= I_GU;
            { const int e = r / 128, q = r % 128, nb = q / 8, kb = q % 8;
              transpose_item(SrcPlain{IN_wd + ((size_t)l * NEXP + e) * DEXP * DM, DM, 0, 1.f}, WSP(bf16, WS_WD) + ((size_t)l * NEXP + e) * 1024 * DEXP, DEXP, kb * 64, nb * 64, scr, F.lane); }
        }
    }
}

__device__ __forceinline__ float rope_rev(int i) {
    constexpr float T[16] = {1.591549431e-01f, 8.949940161e-02f, 5.032921210e-02f, 2.830219583e-02f, 1.591549431e-02f, 8.949940161e-03f, 5.032921210e-03f, 2.830219583e-03f,
                             1.591549431e-03f, 8.949940161e-04f, 5.032921210e-04f, 2.830219583e-04f, 1.591549431e-04f, 8.949940161e-05f, 5.032921210e-05f, 2.830219583e-05f};
    return T[i];
}
__device__ __forceinline__ void rope_cs(float posf, float rev, float& c, float& s) { float a = posf * rev; a -= rintf(a); c = __builtin_amdgcn_cosf(a); s = __builtin_amdgcn_sinf(a); }

__device__ __forceinline__ void moe_block_starts(Frame& F, int lm) {
    LAS int* mbs = (LAS int*)(F.lds + UT_OFF + 256); LAS int* cnts = mbs + 72;
    if (F.tid < 64) cnts[F.tid] = (int)__hip_atomic_load(F.ctl + CW_GCNT + (lm * 64 + F.tid) * 16, RLX_AGENT);
    __syncthreads();
    if (F.tid == 0) { int a = 0; for (int e = 0; e < 64; ++e) { mbs[e] = a; a += (cnts[e] + 255) >> 8; } mbs[64] = a; }
    __syncthreads();
}

template <bool FINAL>
__device__ __forceinline__ void mix_norm_phase(Frame& F, CArgs& A, int l) {
    const bool comb = (l > 0);
    if (comb) moe_block_starts(F, l - 1);
    const LAS int* mbs = (const LAS int*)(F.lds + UT_OFF + 256);
    const float* MOD = WSP(float, WS_MOD);
    const bf16* Y = WSP(bf16, WS_Y); const int* DEST = WSP(int, WS_DEST); const float* GATE = WSP(float, WS_GATE);
    bf16* H = WSP(bf16, WS_H); float* FLOG = WSP(float, WS_FLOG);
    const float* xsrc = comb ? F.out : IN_x;
    for (int tile = F.c; tile < NTOK / 256; tile += F.G) {
        const int b = tile >> 3;
        f32x4 gv[4], scv[4], shv[4], gfv[4], wf[4][4];
#pragma unroll
        for (int j = 0; j < 4; ++j) { const int k = 4 * F.lane + 256 * j;
            if (FINAL) { gv[j] = *(const GAS f32x4*)(IN_g_fin + k); }
            else { gv[j] = *(const GAS f32x4*)(IN_g_mix + l * DM + k); scv[j] = *(const GAS f32x4*)(MOD + ((size_t)l * NB + b) * 6144 + 1024 + k); shv[j] = *(const GAS f32x4*)(MOD + ((size_t)l * NB + b) * 6144 + k);
#pragma unroll
                for (int q = 0; q < 4; ++q) wf[q][j] = *(const GAS f32x4*)(WSP(float, WS_WF) + ((size_t)l * 4 + q) * DM + k); }
            if (comb) gfv[j] = *(const GAS f32x4*)(MOD + ((size_t)(l - 1) * NB + b) * 6144 + 5 * 1024 + k); }
        for (int jr = 0; jr < 32; ++jr) {
            const size_t row = (size_t)tile * 256 + F.wave * 32 + jr;
            f32x4 v[4];
#pragma unroll
            for (int j = 0; j < 4; ++j) v[j] = *(const GAS f32x4*)(xsrc + row * DM + 4 * F.lane + 256 * j);
            if (comb) {
                const i32x4 d = *(const GAS i32x4*)(DEST + row * 4); const f32x2 gt = *(const GAS f32x2*)(GATE + row * 2);
                const size_t r0 = (size_t)256 * mbs[d.x] + d.y, r1 = (size_t)256 * mbs[d.z] + d.w;
#pragma unroll
                for (int j = 0; j < 4; ++j) { const v2u y0 = *(const GAS v2u*)(Y + r0 * DM + 4 * F.lane + 256 * j), y1 = *(const GAS v2u*)(Y + r1 * DM + 4 * F.lane + 256 * j);
                    f32x4 m; m.x = gt.x * bflo(y0.x) + gt.y * bflo(y1.x); m.y = gt.x * bfhi(y0.x) + gt.y * bfhi(y1.x); m.z = gt.x * bflo(y0.y) + gt.y * bflo(y1.y); m.w = gt.x * bfhi(y0.y) + gt.y * bfhi(y1.y);
                    v[j] = v[j] + gfv[j] * m; }
                if (!FINAL) {
#pragma unroll
                    for (int j = 0; j < 4; ++j) *(GAS f32x4*)(F.out + row * DM + 4 * F.lane + 256 * j) = v[j]; }
            }
            float ss = 0.f;
#pragma unroll
            for (int j = 0; j < 4; ++j) ss += (v[j].x * v[j].x + v[j].y * v[j].y) + (v[j].z * v[j].z + v[j].w * v[j].w);
            const float rs = 1.f / sqrtf(wave_sum(ss, F.lane) * (1.f / DM) + EPS);
            if (FINAL) {
#pragma unroll
                for (int j = 0; j < 4; ++j) *(GAS f32x4*)(F.out + row * DM + 4 * F.lane + 256 * j) = v[j] * rs * gv[j];
            } else {
                float fl[4] = {0.f, 0.f, 0.f, 0.f};
#pragma unroll
                for (int j = 0; j < 4; ++j) { const f32x4 hh = (v[j] * rs * gv[j]) * (scv[j] + 1.f) + shv[j];
                    v2u o; o.x = pk2(hh.x, hh.y); o.y = pk2(hh.z, hh.w);
                    *(GAS v2u*)(H + row * DM + 4 * F.lane + 256 * j) = o;
#pragma unroll
                    for (int q = 0; q < 4; ++q) fl[q] += (hh.x * wf[q][j].x + hh.y * wf[q][j].y) + (hh.z * wf[q][j].z + hh.w * wf[q][j].w); }
#pragma unroll
                for (int q = 0; q < 4; ++q) fl[q] = wave_sum(fl[q], F.lane);
                if (F.lane == 0) *(GAS f32x4*)(FLOG + row * 4) = (f32x4){fl[0], fl[1], fl[2], fl[3]};
            }
        }
    }
}

struct EpiStoreBf16 {
    static constexpr bool PERM = true;
    bf16* O; int ldc; int pn_mask;
    __device__ __forceinline__ void operator()(const f32x4 (&acc)[2][2][4][2], const pg8::Unit& u, int wr, int wc, int fr, int fq) const {
        const size_t row0 = (size_t)u.pm * 256 + wr * 64 + fr; const int col0 = (u.pn & pn_mask) * 256 + wc * 32 + 8 * fq;
#pragma unroll
        for (int ai = 0; ai < 2; ++ai)
#pragma unroll
            for (int m = 0; m < 4; ++m) { bf16* rowp = O + (row0 + ai * 128 + m * 16) * ldc + col0;
#pragma unroll
                for (int bj = 0; bj < 2; ++bj) { const f32x4 v0 = acc[ai][bj][m][0], v1 = acc[ai][bj][m][1]; v4u w;
                    w.x = pg8::cvt_pk_bf16(v0[0], v0[1]); w.y = pg8::cvt_pk_bf16(v0[2], v0[3]); w.z = pg8::cvt_pk_bf16(v1[0], v1[1]); w.w = pg8::cvt_pk_bf16(v1[2], v1[3]);
                    *(GAS v4u*)(rowp + bj * 128) = w; } }
    }
};
struct EpiOut {
    static constexpr bool PERM = false;
    const float* xin; float* xout; const float* gm; float* SS;
    __device__ __forceinline__ void operator()(const f32x4 (&acc)[2][2][4][2], const pg8::Unit& u, int wr, int wc, int fr, int fq) const {
        const size_t row0 = (size_t)u.pm * 256 + wr * 64 + fr; const int col0 = u.pn * 256 + wc * 32 + 4 * fq; const int b = u.pm >> 3; const int lane = fq * 16 + fr;
        f32x4 gvv[2][2];
#pragma unroll
        for (int bj = 0; bj < 2; ++bj)
#pragma unroll
            for (int n = 0; n < 2; ++n) gvv[bj][n] = *(const GAS f32x4*)(gm + (size_t)b * 6144 + col0 + bj * 128 + n * 16);
#pragma unroll
        for (int ai = 0; ai < 2; ++ai)
#pragma unroll
            for (int m = 0; m < 4; ++m) { const size_t ro = (row0 + ai * 128 + m * 16) * DM + col0; float ss = 0.f;
#pragma unroll
                for (int bj = 0; bj < 2; ++bj)
#pragma unroll
                    for (int n = 0; n < 2; ++n) { const f32x4 xi = *(const GAS f32x4*)(xin + ro + bj * 128 + n * 16); const f32x4 xo = xi + gvv[bj][n] * acc[ai][bj][m][n];
                        *(GAS f32x4*)(xout + ro + bj * 128 + n * 16) = xo; ss += (xo.x * xo.x + xo.y * xo.y) + (xo.z * xo.z + xo.w * xo.w); }
                ss += shx(ss, 16, lane); ss += shx(ss, 32, lane);
                if (fq == 0) SS[(row0 + ai * 128 + m * 16) * 16 + u.pn * 4 + wc] = ss; }
    }
};
struct EpiGateUp {
    static constexpr bool PERM = true;
    bf16* O;
    __device__ __forceinline__ void operator()(const f32x4 (&acc)[2][2][4][2], const pg8::Unit& u, int wr, int wc, int fr, int fq) const {
        const size_t row0 = (size_t)u.pm * 256 + wr * 64 + fr; const int col0 = (u.pn & 3) * 128 + wc * 32 + 8 * fq;
#pragma unroll
        for (int ai = 0; ai < 2; ++ai)
#pragma unroll
            for (int m = 0; m < 4; ++m) { float hv[8];
#pragma unroll
                for (int n = 0; n < 2; ++n)
#pragma unroll
                    for (int i = 0; i < 4; ++i) hv[4 * n + i] = silu_f(acc[ai][0][m][n][i]) * acc[ai][1][m][n][i];
                v4u w; w.x = pg8::cvt_pk_bf16(hv[0], hv[1]); w.y = pg8::cvt_pk_bf16(hv[2], hv[3]); w.z = pg8::cvt_pk_bf16(hv[4], hv[5]); w.w = pg8::cvt_pk_bf16(hv[6], hv[7]);
                *(GAS v4u*)(O + (row0 + ai * 128 + m * 16) * DEXP + col0) = w; }
    }
};

__device__ __forceinline__ void mla_up_phase(Frame& F, CArgs& A, int l) {
    bf16* PROJ = WSP(bf16, WS_PROJ);
    {
        for (int tok = F.c * 512 + F.tid; tok < NTOK; tok += F.G * 512) {
            GAS v4u* p = (GAS v4u*)(PROJ + (size_t)tok * PN + PC_KROPE);
            v4u w[4]; float t[32], o[32];
#pragma unroll
            for (int i = 0; i < 4; ++i) w[i] = p[i];
#pragma unroll
            for (int i = 0; i < 4; ++i) { t[8 * i] = bflo(w[i].x); t[8 * i + 1] = bfhi(w[i].x); t[8 * i + 2] = bflo(w[i].y); t[8 * i + 3] = bfhi(w[i].y); t[8 * i + 4] = bflo(w[i].z); t[8 * i + 5] = bfhi(w[i].z); t[8 * i + 6] = bflo(w[i].w); t[8 * i + 7] = bfhi(w[i].w); }
            const float posf = (float)IN_pos[tok];
#pragma unroll
            for (int i = 0; i < 16; ++i) { float c, s; rope_cs(posf, rope_rev(i), c, s);
                const int p1 = 8 * (i >> 2) + (i & 3), p2 = p1 + 4;
                o[p1] = t[i] * c - t[i + 16] * s; o[p2] = t[i + 16] * c + t[i] * s; }
#pragma unroll
            for (int i = 0; i < 4; ++i) { v4u q; q.x = pk2(o[8 * i], o[8 * i + 1]); q.y = pk2(o[8 * i + 2], o[8 * i + 3]); q.z = pk2(o[8 * i + 4], o[8 * i + 5]); q.w = pk2(o[8 * i + 6], o[8 * i + 7]); p[i] = q; }
        }
    }
    {
        const float* FLOG = WSP(float, WS_FLOG); float* FB = WSP(float, WS_FB);
        LAS float* wt = (LAS float*)(F.lds + RING_OFF);
        for (int bh = F.c; bh < NB * 4; bh += F.G) {
            const int b = bh >> 2, h = bh & 3; const float fb = IN_fb[l * 4 + h];
            float v[4]; float run = 0.f;
#pragma unroll
            for (int j = 0; j < 4; ++j) { const float xx = FLOG[((size_t)b * SEQ + 4 * F.tid + j) * 4 + h] + fb; const float ls = fminf(xx, 0.f) - log1pf(expf(-fabsf(xx))); run += ls; v[j] = run; }
            float inc = run;
#pragma unroll
            for (int o = 1; o < 64; o <<= 1) { const float n = __builtin_bit_cast(float, __builtin_amdgcn_ds_bpermute((F.lane - o) << 2, __builtin_bit_cast(int, inc))); if (F.lane >= o) inc += n; }
            if (F.lane == 63) wt[F.wave] = inc;
            __syncthreads();
            float base = inc - run;
            for (int w = 0; w < F.wave; ++w) base += wt[w];
#pragma unroll
            for (int j = 0; j < 4; ++j) FB[((size_t)b * 4 + h) * SEQ + 4 * F.tid + j] = -LOG2E * (base + v[j]);
            __syncthreads();
        }
    }
    for (int pm = F.c; pm < NTOK / 256; pm += F.G) {
        for (int jr = 0; jr < 32; ++jr) { const size_t row = (size_t)pm * 256 + F.wave * 32 + jr;
            const bool isq = F.lane < 24, iskv = (F.lane >= 32 && F.lane < 48);
            GAS v4u* p = (GAS v4u*)(PROJ + row * PN + (isq ? 8 * F.lane : PC_CKV + 8 * (F.lane & 15)));
            float a[8]; float sq = 0.f, skv = 0.f;
            if (isq || iskv) { const v4u w = *p; a[0] = bflo(w.x); a[1] = bfhi(w.x); a[2] = bflo(w.y); a[3] = bfhi(w.y); a[4] = bflo(w.z); a[5] = bfhi(w.z); a[6] = bflo(w.w); a[7] = bfhi(w.w);
                const float ss = (a[0] * a[0] + a[1] * a[1]) + (a[2] * a[2] + a[3] * a[3]) + (a[4] * a[4] + a[5] * a[5]) + (a[6] * a[6] + a[7] * a[7]);
                if (isq) sq = ss; else skv = ss; }
            sq = wave_sum(sq, F.lane); skv = wave_sum(skv, F.lane);
            const float rs = isq ? 1.f / sqrtf(sq * (1.f / 192.f) + EPS) : 1.f / sqrtf(skv * (1.f / 128.f) + EPS);
            if (isq || iskv) { v4u o; o.x = pk2(a[0] * rs, a[1] * rs); o.y = pk2(a[2] * rs, a[3] * rs); o.z = pk2(a[4] * rs, a[5] * rs); o.w = pk2(a[6] * rs, a[7] * rs); *p = o; } }
        VM_WAIT();
        __syncthreads();
        pg8::Gemm g{PROJ, WSP(bf16, WS_WUP) + (size_t)l * NUP * KUP, KUP, PN};
        int nn4 = 4; asm volatile("" : "+s"(nn4));
        pg8::PanelOrder S{pm, nn4};
        EpiStoreBf16 E{WSP(bf16, WS_MLA), 1024, 0xffff};
        pg8::gemm_phase<EpiStoreBf16, pg8::PanelOrder, true, false>(F.lds + RING_OFF, g, S, E, F.tid);
        __syncthreads();
    }
}

__device__ __forceinline__ int crow(int r, int hi) { return (r & 3) + 8 * (r >> 2) + 4 * hi; }
typedef short v4i16_t __attribute__((ext_vector_type(4)));
__device__ __forceinline__ s16x4 vtr(const LAS unsigned char* p) { return __builtin_bit_cast(s16x4, __builtin_amdgcn_ds_read_tr16_b64_v4i16((LAS v4i16_t*)p)); }
__device__ __forceinline__ float half_swap_max(float m) { auto rr = __builtin_amdgcn_permlane32_swap(__float_as_uint(m), __float_as_uint(m), false, false); return fmaxf(__uint_as_float(rr[0]), __uint_as_float(rr[1])); }
__device__ __forceinline__ float half_swap_sum(float m) { auto rr = __builtin_amdgcn_permlane32_swap(__float_as_uint(m), __float_as_uint(m), false, false); return __uint_as_float(rr[0]) + __uint_as_float(rr[1]); }
__device__ __forceinline__ bf16x8 pack8(const f32x16& p, int b0) {
    v4u w; w.x = pg8::cvt_pk_bf16(p[b0], p[b0 + 1]); w.y = pg8::cvt_pk_bf16(p[b0 + 2], p[b0 + 3]); w.z = pg8::cvt_pk_bf16(p[b0 + 4], p[b0 + 5]); w.w = pg8::cvt_pk_bf16(p[b0 + 6], p[b0 + 7]);
    return __builtin_bit_cast(bf16x8, w);
}
__device__ __forceinline__ void softmax_tile(f32x16& p0, f32x16& p1, float& m, float& lsum, f32x16& negm, const float cbase, f32x16& o0, f32x16& o1, const bool first) {
    float a = fmaxf(fmaxf(p0[0], p0[1]), p1[0]), b = fmaxf(fmaxf(p0[2], p0[3]), p1[1]); a = fmaxf(fmaxf(a, p1[2]), p1[3]);
#pragma unroll
    for (int r = 4; r < 16; r += 4) { a = fmaxf(fmaxf(a, p0[r]), p0[r + 1]); b = fmaxf(fmaxf(b, p0[r + 2]), p0[r + 3]); a = fmaxf(fmaxf(a, p1[r]), p1[r + 1]); b = fmaxf(fmaxf(b, p1[r + 2]), p1[r + 3]); }
    const float rm = half_swap_max(fmaxf(a, b));
    if (first || __any(rm > 8.f)) {
        const float dl = first ? rm : fmaxf(rm, 0.f); m += dl;
#pragma unroll
        for (int r = 0; r < 16; ++r) { p0[r] -= dl; p1[r] -= dl; negm[r] = cbase - m; }
        if (!first) { const float f = fast_exp2(-dl); lsum *= f;
#pragma unroll
            for (int r = 0; r < 16; ++r) { o0[r] *= f; o1[r] *= f; } }
    }
    float s0 = 0.f, s1 = 0.f;
#pragma unroll
    for (int r = 0; r < 16; ++r) { p0[r] = fast_exp2(p0[r]); p1[r] = fast_exp2(p1[r]); s0 += p0[r]; s1 += p1[r]; }
    lsum += s0 + s1;
}

constexpr int AT_KB = 16384, AT_VB = 8192, AT_TBL = 2 * AT_KB + 3 * AT_VB;

template <int MODE>
__device__ __forceinline__ void attn_unit(Frame& F, CArgs& A, int l, int b, int h, int qb) {
    const int tid = F.tid, lane = F.lane, wid = F.wave, r32 = lane & 31, hi = lane >> 5;
    constexpr int ND0 = (MODE == 0) ? 6 : (MODE == 1 ? 4 : 2);
    LAS unsigned char* kb0 = F.lds + RING_OFF; LAS unsigned char* vb0 = F.lds + RING_OFF + 2 * AT_KB; LAS float* tbl = (LAS float*)(F.lds + RING_OFF + AT_TBL);
    const size_t rowbase = (size_t)b * SEQ; const int q0 = qb * 256, NT = 4 * qb + 4, tw = 4 * qb + (wid >> 1), qw0 = q0 + 32 * wid;
    const bf16* PROJ = WSP(bf16, WS_PROJ); const bf16* MLA = WSP(bf16, WS_MLA);
    const bf16* Qp; const bf16* Kp; const bf16* Vp; int pitch;
    if (MODE == 0) { Qp = MLA + h * 96; Kp = MLA + 512 + h * 128; Vp = Kp + 64; pitch = 1024; }
    else if (MODE == 1) { Qp = PROJ + PC_FOX + h * 64; Kp = Qp + 256; Vp = Qp + 512; pitch = PN; }
    else { Qp = PROJ + PC_DIFF + h * 64; Kp = Qp + 256; Vp = Qp + 512; pitch = PN; }
    const GAS bf16* ksrc = (const GAS bf16*)(Kp + (rowbase + (lane ^ wid)) * pitch + wid * 8);
    const GAS bf16* vsrc = (const GAS bf16*)(Vp + (rowbase + 16 * (wid & 3) + (lane >> 2)) * pitch + (wid >> 2) * 32 + (lane & 3) * 8);
    const GAS bf16* ksrc2 = (const GAS bf16*)(PROJ + (rowbase + (lane ^ (wid & 3))) * PN + PC_KROPE + (wid & 3) * 8);
#define AT_DMA(t, kbo, vso) do { \
        __builtin_amdgcn_global_load_lds((const GAS unsigned*)(ksrc + (size_t)(t) * 64 * pitch), (LAS unsigned*)(kb0 + (kbo) + wid * 1024), 16, 0, 0); \
        __builtin_amdgcn_global_load_lds((const GAS unsigned*)(vsrc + (size_t)(t) * 64 * pitch), (LAS unsigned*)(vb0 + (vso) + wid * 1024), 16, 0, 0); \
        if (MODE == 0 && wid < 4) __builtin_amdgcn_global_load_lds((const GAS unsigned*)(ksrc2 + (size_t)(t) * 64 * PN), (LAS unsigned*)(kb0 + (kbo) + (8 + wid) * 1024), 16, 0, 0); } while (0)
    AT_DMA(0, 0, 0);
    if (MODE == 1) { const float* FBp = WSP(float, WS_FB) + ((size_t)b * 4 + h) * SEQ; if (4 * tid < NT * 64) *(LAS f32x4*)(tbl + 4 * tid) = *(const GAS f32x4*)(FBp + 4 * tid); }
    if (MODE == 2) { const float* T5p = WSP(float, WS_T5) + h * 2112; const float c0 = T5p[0]; for (int i = tid; i < 528; i += 512) *(LAS f32x4*)(tbl + 4 * i) = *(const GAS f32x4*)(T5p + 4 * i) - c0; }
    bf16x8 qf[(MODE == 2) ? 4 : ND0];
    { const bf16* Qw = Qp + (rowbase + qw0 + r32) * pitch + hi * 8;
#pragma unroll
      for (int d = 0; d < ((MODE == 2) ? 4 : ND0); ++d) qf[d] = *(const GAS bf16x8*)(Qw + d * 16); }
    if (MODE == 0) {
        const float posf = (float)IN_pos[rowbase + qw0 + r32];
#pragma unroll
        for (int j = 0; j < 2; ++j) { const v4u w = __builtin_bit_cast(v4u, qf[(MODE == 0) ? 4 + j : 0]);
            float t1[4] = {bflo(w.x), bfhi(w.x), bflo(w.y), bfhi(w.y)}, t2[4] = {bflo(w.z), bfhi(w.z), bflo(w.w), bfhi(w.w)};
#pragma unroll
            for (int i = 0; i < 4; ++i) { float c, s; rope_cs(posf, hi ? rope_rev(4 * (2 * j + 1) + i) : rope_rev(4 * (2 * j) + i), c, s); const float a = t1[i], bb = t2[i]; t1[i] = a * c - bb * s; t2[i] = bb * c + a * s; }
            v4u o; o.x = pk2(t1[0], t1[1]); o.y = pk2(t1[2], t1[3]); o.z = pk2(t2[0], t2[1]); o.w = pk2(t2[2], t2[3]);
            qf[(MODE == 0) ? 4 + j : 0] = __builtin_bit_cast(bf16x8, o); }
    }
    float m1 = 0.f, l1 = 0.f, m2 = 0.f, l2 = 0.f; f32x16 o1[2], o2[2], negm1;
    const float cbase = (MODE == 2) ? WSP(float, WS_T5)[h * 2112] : 0.f;
#pragma unroll
    for (int r = 0; r < 16; ++r) { o1[0][r] = 0.f; o1[1][r] = 0.f; o2[0][r] = 0.f; o2[1][r] = 0.f; negm1[r] = cbase; }
    const int vlane = ((lane >> 4) & 1) * 32 + (lane & 3) * 8 + (4 * hi + ((lane & 15) >> 2)) * 64;
    VM_WAIT();
    __syncthreads();
    const bool lag = false;
    bf16x8 dpa0, dpa1, dpa2, dpa3;
    dpa0 = dpa1 = dpa2 = dpa3 = (bf16x8){0, 0, 0, 0, 0, 0, 0, 0};
#define AT_PV(O, VB, A0, A1, A2, A3) do { bf16x8 vf[2][4]; \
        _Pragma("unroll") for (int d0 = 0; d0 < 2; ++d0) _Pragma("unroll") for (int ks = 0; ks < 4; ++ks) { const s16x4 lo = vtr((VB) + d0 * 4096 + ks * 1024), hh = vtr((VB) + d0 * 4096 + ks * 1024 + 512); \
            vf[d0][ks] = (bf16x8){lo[0], lo[1], lo[2], lo[3], hh[0], hh[1], hh[2], hh[3]}; } \
        _Pragma("unroll") for (int d0 = 0; d0 < 2; ++d0) { O[d0] = __builtin_amdgcn_mfma_f32_32x32x16_bf16(vf[d0][0], A0, O[d0], 0, 0, 0); O[d0] = __builtin_amdgcn_mfma_f32_32x32x16_bf16(vf[d0][1], A1, O[d0], 0, 0, 0); \
            O[d0] = __builtin_amdgcn_mfma_f32_32x32x16_bf16(vf[d0][2], A2, O[d0], 0, 0, 0); O[d0] = __builtin_amdgcn_mfma_f32_32x32x16_bf16(vf[d0][3], A3, O[d0], 0, 0, 0); } } while (0)
    int vs_prev = 0, vs_cur = 0, vs_next = AT_VB;
    for (int t = 0; t < NT; ++t) {
        if (t + 1 < NT) AT_DMA(t + 1, ((t + 1) & 1) * AT_KB, vs_next);
        if (lag && t >= 1 && t - 1 <= tw) { const LAS unsigned char* vbp = vb0 + vs_prev + vlane; if (MODE == 2) AT_PV(o2, vbp, dpa0, dpa1, dpa2, dpa3); else AT_PV(o1, vbp, dpa0, dpa1, dpa2, dpa3); }
        if (t <= tw) {
            const LAS unsigned char* kb = kb0 + (t & 1) * AT_KB; const LAS unsigned char* vb = vb0 + vs_cur + vlane;
#pragma unroll
            for (int mp = 0; mp < ((MODE == 2) ? 2 : 1); ++mp) {
                f32x16 p0, p1, nmt;
                if (MODE == 2) { const float nv = cbase - (mp == 0 ? m1 : m2);
#pragma unroll
                    for (int r = 0; r < 16; ++r) nmt[r] = nv; }
#pragma unroll
                for (int d0 = 0; d0 < ND0; ++d0) { const int c = 2 * d0 + hi + ((MODE == 2) ? 4 * mp : 0);
                    const LAS unsigned char* ka = kb + c * 1024 + ((r32 ^ (c & 7)) * 16);
                    const bf16x8 k0 = *(const LAS bf16x8*)ka, k1 = *(const LAS bf16x8*)(ka + 512);
                    if (d0 == 0) { p0 = __builtin_amdgcn_mfma_f32_32x32x16_bf16(k0, qf[(MODE == 2) ? 2 * mp + d0 : d0], (MODE == 2) ? nmt : negm1, 0, 0, 0);
                                   p1 = __builtin_amdgcn_mfma_f32_32x32x16_bf16(k1, qf[(MODE == 2) ? 2 * mp + d0 : d0], (MODE == 2) ? nmt : negm1, 0, 0, 0); }
                    else { p0 = __builtin_amdgcn_mfma_f32_32x32x16_bf16(k0, qf[(MODE == 2) ? 2 * mp + d0 : d0], p0, 0, 0, 0);
                           p1 = __builtin_amdgcn_mfma_f32_32x32x16_bf16(k1, qf[(MODE == 2) ? 2 * mp + d0 : d0], p1, 0, 0, 0); } }
                if (MODE == 1) {
#pragma unroll
                    for (int g4 = 0; g4 < 4; ++g4) { const f32x4 a = *(const LAS f32x4*)(tbl + 64 * t + 8 * g4 + 4 * hi), c = *(const LAS f32x4*)(tbl + 64 * t + 32 + 8 * g4 + 4 * hi);
                        p0[4 * g4] += a.x; p0[4 * g4 + 1] += a.y; p0[4 * g4 + 2] += a.z; p0[4 * g4 + 3] += a.w; p1[4 * g4] += c.x; p1[4 * g4 + 1] += c.y; p1[4 * g4 + 2] += c.z; p1[4 * g4 + 3] += c.w; }
                    if (t == tw) {
                        const int ql = 32 * (wid & 1) + r32;
#pragma unroll
                        for (int r = 0; r < 16; ++r) { const int kl = crow(r, hi); if (kl > ql) p0[r] = -1e30f; if (kl + 32 > ql) p1[r] = -1e30f; } }
                }
                if (MODE == 2 && 64 * t + 191 > qw0) {
                    const LAS float* tp = tbl + (64 * t - (qw0 + r32) + 2047 + 4 * hi);
#pragma unroll
                    for (int r = 0; r < 16; ++r) { p0[r] += tp[(r & 3) + 8 * (r >> 2)]; p1[r] += tp[32 + (r & 3) + 8 * (r >> 2)]; }
                }
                if (MODE == 2) { if (mp == 0) softmax_tile(p0, p1, m1, l1, nmt, cbase, o1[0], o1[1], t == 0); else softmax_tile(p0, p1, m2, l2, nmt, cbase, o2[0], o2[1], t == 0); }
                else softmax_tile(p0, p1, m1, l1, negm1, cbase, o1[0], o1[1], t == 0);
                const bf16x8 pa0 = pack8(p0, 0), pa1 = pack8(p0, 8), pa2 = pack8(p1, 0), pa3 = pack8(p1, 8);
                const bool lastmap = (mp == ((MODE == 2) ? 1 : 0));
                if (lastmap && lag) { dpa0 = pa0; dpa1 = pa1; dpa2 = pa2; dpa3 = pa3; }
                else { if (MODE == 2 && mp == 1) AT_PV(o2, vb, pa0, pa1, pa2, pa3); else AT_PV(o1, vb, pa0, pa1, pa2, pa3); }
            }
        }
        VM_WAIT();
        __syncthreads();
        vs_prev = vs_cur; vs_cur = vs_next; vs_next = (vs_next == 2 * AT_VB) ? 0 : vs_next + AT_VB;
    }
    if (lag && NT - 1 <= tw) { const LAS unsigned char* vbp = vb0 + vs_prev + vlane; if (MODE == 2) AT_PV(o2, vbp, dpa0, dpa1, dpa2, dpa3); else AT_PV(o1, vbp, dpa0, dpa1, dpa2, dpa3); }
    __syncthreads();
#undef AT_PV
#undef AT_DMA
    bf16* MIX = WSP(bf16, WS_MIX);
    const float inv1 = 1.f / half_swap_sum(l1);
    bf16* orow = MIX + (rowbase + qw0 + r32) * DM + ((MODE == 0) ? h * 64 : (MODE == 1) ? 256 + h * 64 : 768 + h * 64) + 4 * hi;
    if (MODE != 2) {
#pragma unroll
        for (int d0 = 0; d0 < 2; ++d0)
#pragma unroll
            for (int j = 0; j < 4; ++j) { v2u w; w.x = pg8::cvt_pk_bf16(o1[d0][4 * j] * inv1, o1[d0][4 * j + 1] * inv1); w.y = pg8::cvt_pk_bf16(o1[d0][4 * j + 2] * inv1, o1[d0][4 * j + 3] * inv1);
                *(GAS v2u*)(orow + 32 * d0 + 8 * j) = w; }
    } else {
        const float inv2 = 1.f / half_swap_sum(l2); const float lam = WSP(float, WS_LAM)[l]; const float li = 0.8f - 0.6f * expf(-0.3f * (float)l);
        const float c2 = lam * inv2; float ss = 0.f;
#pragma unroll
        for (int d0 = 0; d0 < 2; ++d0)
#pragma unroll
            for (int r = 0; r < 16; ++r) { const float v = o1[d0][r] * inv1 - o2[d0][r] * c2; o1[d0][r] = v; ss += v * v; }
        const float rsn = (1.f - li) / sqrtf(half_swap_sum(ss) * (1.f / 64.f) + EPS);
        const float* sg = IN_subln + l * 64 + 4 * hi;
#pragma unroll
        for (int d0 = 0; d0 < 2; ++d0)
#pragma unroll
            for (int j = 0; j < 4; ++j) { const f32x4 g4 = *(const GAS f32x4*)(sg + 32 * d0 + 8 * j);
                v2u w; w.x = pg8::cvt_pk_bf16(o1[d0][4 * j] * rsn * g4.x, o1[d0][4 * j + 1] * rsn * g4.y); w.y = pg8::cvt_pk_bf16(o1[d0][4 * j + 2] * rsn * g4.z, o1[d0][4 * j + 3] * rsn * g4.w);
                *(GAS v2u*)(orow + 32 * d0 + 8 * j) = w; }
    }
}

__device__ __forceinline__ void conv_unit(Frame& F, CArgs& A, int l, int tile) {
    const bf16* PROJ = WSP(bf16, WS_PROJ); bf16* MIX = WSP(bf16, WS_MIX);
    const int c8 = (F.tid & 31) * 8, rsub = F.tid >> 5;
    float w0[8], w1[8], w2[8];
#pragma unroll
    for (int i = 0; i < 8; ++i) { w0[i] = IN_conv_w[(l * 3 + 0) * 256 + c8 + i]; w1[i] = IN_conv_w[(l * 3 + 1) * 256 + c8 + i]; w2[i] = IN_conv_w[(l * 3 + 2) * 256 + c8 + i]; }
    for (int j = 0; j < 16; ++j) {
        const size_t row = (size_t)tile * 256 + rsub + 16 * j; const int s = (int)(row & (SEQ - 1));
        const bf16* pr = PROJ + row * PN + PC_CONV + c8;
        const v4u bb = *(const GAS v4u*)pr, c0 = *(const GAS v4u*)(pr + 256), u0 = *(const GAS v4u*)(pr + 512);
        v4u c1 = (v4u){0u, 0u, 0u, 0u}, u1 = c1, c2 = c1, u2 = c1;
        if (s >= 1) { c1 = *(const GAS v4u*)(pr - PN + 256); u1 = *(const GAS v4u*)(pr - PN + 512); }
        if (s >= 2) { c2 = *(const GAS v4u*)(pr - 2 * PN + 256); u2 = *(const GAS v4u*)(pr - 2 * PN + 512); }
        float o[8];
#define CV(i, W, sel) { const float z0 = sel(c0.W) * sel(u0.W), z1 = sel(c1.W) * sel(u1.W), z2 = sel(c2.W) * sel(u2.W); o[i] = sel(bb.W) * (w2[i] * z0 + w1[i] * z1 + w0[i] * z2); }
        CV(0, x, bflo) CV(1, x, bfhi) CV(2, y, bflo) CV(3, y, bfhi) CV(4, z, bflo) CV(5, z, bfhi) CV(6, w, bflo) CV(7, w, bfhi)
#undef CV
        v4u q; q.x = pk2(o[0], o[1]); q.y = pk2(o[2], o[3]); q.z = pk2(o[4], o[5]); q.w = pk2(o[6], o[7]);
        *(GAS v4u*)(MIX + row * DM + 512 + c8) = q;
    }
}

#define ATTN_LOOP(TYPE, MODE_) for (;;) { \
        if (F.tid == 0) F.MISC[0] = __hip_atomic_fetch_add(F.ctl + CW_Q + 64 * l + 16 * (TYPE), 1u, RLX_AGENT); \
        __syncthreads(); const int idx = (int)F.MISC[0]; __syncthreads(); \
        if (idx >= 1024) break; \
        const int qb = 7 - (idx >> 7), bh = idx & 127; attn_unit<MODE_>(F, A, l, bh >> 2, bh & 3, qb); }
__device__ __forceinline__ void attn_phase(Frame& F, CArgs& A, int l) {
    ATTN_LOOP(0, 2)
    ATTN_LOOP(1, 0)
    ATTN_LOOP(2, 1)
    for (int tile = F.c; tile < NTOK / 256; tile += F.G) conv_unit(F, A, l, tile);
}

__device__ __forceinline__ void ffn_router_phase(Frame& F, CArgs& A, int l) {
    const float* MOD = WSP(float, WS_MOD); const bf16* WRT = WSP(bf16, WS_WRT) + (size_t)l * 2 * NLOG * DM; const float* SSp = WSP(float, WS_SS);
    bf16* H = WSP(bf16, WS_H); int* DEST = WSP(int, WS_DEST); float* GATE = WSP(float, WS_GATE); int* LIST = WSP(int, WS_LIST);
    LAS float* G2P = (LAS float*)(F.lds + RING_OFF); LAS float* SHF = G2P + 1024; LAS float* SHWB = G2P + 2048; LAS int* hist = (LAS int*)(G2P + 2176); LAS int* base = hist + 64;
    LAS int* rinfo = (LAS int*)(G2P + 2304);
    LAS unsigned char* WST = F.lds + RING_OFF + 20480;
    LAS float* LG = (LAS float*)WST + F.wave * 2560;
    const int tk = F.lane & 15, kg = F.lane >> 4;
    for (int tile = F.c; tile < NTOK / 256; tile += F.G) {
        const int b = tile >> 3;
#define RT_DMA(st, bufo) do { _Pragma("unroll") for (int q = 0; q < 5; ++q) { const int j = F.wave * 5 + q, sp = j / 10, hl = (j % 10) / 5, nb = j % 5; \
            __builtin_amdgcn_global_load_lds((const GAS unsigned*)(WRT + (size_t)(hl * NLOG + 16 * nb + (F.lane >> 2)) * DM + 128 * (st) + 32 * sp + 8 * (F.lane & 3)), (LAS unsigned*)(WST + (bufo) + j * 1024), 16, 0, 0); } } while (0)
        RT_DMA(0, 0);
        for (int k = F.tid; k < DM; k += 512) { G2P[k] = IN_g_ffn[l * DM + k] * (1.f + MOD[((size_t)l * NB + b) * 6144 + 4 * 1024 + k]); SHF[k] = MOD[((size_t)l * NB + b) * 6144 + 3 * 1024 + k]; }
        if (F.tid < 64) hist[F.tid] = 0;
        __syncthreads();
        for (int n = F.wave; n < NLOG; n += 8) { float s = 0.f;
#pragma unroll
            for (int j = 0; j < 4; ++j) { const int k = 4 * F.lane + 256 * j; const v2u wh = *(const GAS v2u*)(WRT + (size_t)n * DM + k), wl = *(const GAS v2u*)(WRT + (size_t)(NLOG + n) * DM + k);
                s += SHF[k] * (bflo(wh.x) + bflo(wl.x)) + SHF[k + 1] * (bfhi(wh.x) + bfhi(wl.x)) + SHF[k + 2] * (bflo(wh.y) + bflo(wl.y)) + SHF[k + 3] * (bfhi(wh.y) + bfhi(wl.y)); }
            s = wave_sum(s, F.lane);
            if (F.lane == 0) SHWB[n] = s + (n < 8 ? IN_rg_b[l * 8 + n] : (n < 72 ? IN_re_b[l * 64 + n - 8] : 0.f)); }
        const size_t rowA = (size_t)tile * 256 + F.wave * 32 + tk, rowB = rowA + 16;
        float rsA, rsB;
        { const f32x4 a0 = *(const GAS f32x4*)(SSp + rowA * 16), a1 = *(const GAS f32x4*)(SSp + rowA * 16 + 4), a2 = *(const GAS f32x4*)(SSp + rowA * 16 + 8), a3 = *(const GAS f32x4*)(SSp + rowA * 16 + 12);
          const f32x4 b0 = *(const GAS f32x4*)(SSp + rowB * 16), b1 = *(const GAS f32x4*)(SSp + rowB * 16 + 4), b2 = *(const GAS f32x4*)(SSp + rowB * 16 + 8), b3 = *(const GAS f32x4*)(SSp + rowB * 16 + 12);
          const float sa = (((a0.x + a0.y) + (a0.z + a0.w)) + ((a1.x + a1.y) + (a1.z + a1.w))) + (((a2.x + a2.y) + (a2.z + a2.w)) + ((a3.x + a3.y) + (a3.z + a3.w)));
          const float sb = (((b0.x + b0.y) + (b0.z + b0.w)) + ((b1.x + b1.y) + (b1.z + b1.w))) + (((b2.x + b2.y) + (b2.z + b2.w)) + ((b3.x + b3.y) + (b3.z + b3.w)));
          rsA = 1.f / sqrtf(sa * (1.f / DM) + EPS); rsB = 1.f / sqrtf(sb * (1.f / DM) + EPS); }
        f32x4 acc[2][5];
#pragma unroll
        for (int rb = 0; rb < 2; ++rb)
#pragma unroll
            for (int nb = 0; nb < 5; ++nb) acc[rb][nb] = (f32x4){0.f, 0.f, 0.f, 0.f};
        const float* xa = F.out + rowA * DM + 8 * kg; const float* xb = F.out + rowB * DM + 8 * kg;
        f32x4 nxa0 = *(const GAS f32x4*)(xa), nxa1 = *(const GAS f32x4*)(xa + 4), nxb0 = *(const GAS f32x4*)(xb), nxb1 = *(const GAS f32x4*)(xb + 4);
        for (int st = 0; st < 8; ++st) {
            VM_WAIT();
            __syncthreads();
            if (st + 1 < 8) RT_DMA(st + 1, ((st + 1) & 1) * 40960);
            const LAS unsigned char* wb = WST + (st & 1) * 40960 + (tk * 4 + kg) * 16;
#pragma unroll
            for (int sp = 0; sp < 4; ++sp) {
                const int s = 4 * st + sp, k = 32 * s + 8 * kg;
                const f32x4 xa0 = nxa0, xa1 = nxa1, xb0 = nxb0, xb1 = nxb1;
                if (s + 1 < 32) { nxa0 = *(const GAS f32x4*)(xa + 32 * (s + 1)); nxa1 = *(const GAS f32x4*)(xa + 32 * (s + 1) + 4); nxb0 = *(const GAS f32x4*)(xb + 32 * (s + 1)); nxb1 = *(const GAS f32x4*)(xb + 32 * (s + 1) + 4); }
                const f32x4 g0 = *(const LAS f32x4*)(G2P + k), g1 = *(const LAS f32x4*)(G2P + k + 4), h0 = *(const LAS f32x4*)(SHF + k), h1 = *(const LAS f32x4*)(SHF + k + 4);
                const f32x4 ua0 = xa0 * g0, ua1 = xa1 * g1, ub0 = xb0 * g0, ub1 = xb1 * g1;
                { const f32x4 a0 = ua0 * rsA + h0, a1 = ua1 * rsA + h1, b0 = ub0 * rsB + h0, b1 = ub1 * rsB + h1;
                  v4u wa, wbv; wa.x = pk2(a0.x, a0.y); wa.y = pk2(a0.z, a0.w); wa.z = pk2(a1.x, a1.y); wa.w = pk2(a1.z, a1.w); wbv.x = pk2(b0.x, b0.y); wbv.y = pk2(b0.z, b0.w); wbv.z = pk2(b1.x, b1.y); wbv.w = pk2(b1.z, b1.w);
                  *(GAS v4u*)(H + rowA * DM + k) = wa; *(GAS v4u*)(H + rowB * DM + k) = wbv; }
                bf16x8 hA, lA, hB, lB;
#define SPLIT8(H_, L_, U0, U1) { v4u hw, lw; unsigned q0, q1; \
                q0 = f2bf(U0.x); q1 = f2bf(U0.y); hw.x = q0 | (q1 << 16); lw.x = pk2(U0.x - __builtin_bit_cast(float, q0 << 16), U0.y - __builtin_bit_cast(float, q1 << 16)); \
                q0 = f2bf(U0.z); q1 = f2bf(U0.w); hw.y = q0 | (q1 << 16); lw.y = pk2(U0.z - __builtin_bit_cast(float, q0 << 16), U0.w - __builtin_bit_cast(float, q1 << 16)); \
                q0 = f2bf(U1.x); q1 = f2bf(U1.y); hw.z = q0 | (q1 << 16); lw.z = pk2(U1.x - __builtin_bit_cast(float, q0 << 16), U1.y - __builtin_bit_cast(float, q1 << 16)); \
                q0 = f2bf(U1.z); q1 = f2bf(U1.w); hw.w = q0 | (q1 << 16); lw.w = pk2(U1.z - __builtin_bit_cast(float, q0 << 16), U1.w - __builtin_bit_cast(float, q1 << 16)); \
                H_ = __builtin_bit_cast(bf16x8, hw); L_ = __builtin_bit_cast(bf16x8, lw); }
                SPLIT8(hA, lA, ua0, ua1) SPLIT8(hB, lB, ub0, ub1)
#undef SPLIT8
#pragma unroll
                for (int nb = 0; nb < 5; ++nb) {
                    const bf16x8 wh = *(const LAS bf16x8*)(wb + ((sp * 2 + 0) * 5 + nb) * 1024), wl = *(const LAS bf16x8*)(wb + ((sp * 2 + 1) * 5 + nb) * 1024);
                    acc[0][nb] = __builtin_amdgcn_mfma_f32_16x16x32_bf16(wh, hA, acc[0][nb], 0, 0, 0); acc[0][nb] = __builtin_amdgcn_mfma_f32_16x16x32_bf16(wh, lA, acc[0][nb], 0, 0, 0); acc[0][nb] = __builtin_amdgcn_mfma_f32_16x16x32_bf16(wl, hA, acc[0][nb], 0, 0, 0);
                    acc[1][nb] = __builtin_amdgcn_mfma_f32_16x16x32_bf16(wh, hB, acc[1][nb], 0, 0, 0); acc[1][nb] = __builtin_amdgcn_mfma_f32_16x16x32_bf16(wh, lB, acc[1][nb], 0, 0, 0); acc[1][nb] = __builtin_amdgcn_mfma_f32_16x16x32_bf16(wl, hB, acc[1][nb], 0, 0, 0);
                }
            }
        }
#undef RT_DMA
        __syncthreads();
#pragma unroll
        for (int nb = 0; nb < 5; ++nb) { const f32x4 sb = *(const LAS f32x4*)(SHWB + 16 * nb + 4 * kg);
            *(LAS f32x4*)(LG + tk * NLOG + 16 * nb + 4 * kg) = acc[0][nb] * rsA + sb; *(LAS f32x4*)(LG + (16 + tk) * NLOG + 16 * nb + 4 * kg) = acc[1][nb] * rsB + sb; }
        LDS_WAIT(); asm volatile("" ::: "memory");
        if (F.lane < 32) {
            const LAS float* lg = LG + F.lane * NLOG;
            float gl[8];
#pragma unroll
            for (int j = 0; j < 8; ++j) gl[j] = lg[j];
            int g = 0; float mx = gl[0];
#pragma unroll
            for (int j = 1; j < 8; ++j) if (gl[j] > mx) { mx = gl[j]; g = j; }
            float Z = 0.f;
#pragma unroll
            for (int j = 0; j < 8; ++j) Z += expf(gl[j] - mx);
            const float pg = 1.f / Z;
            const LAS float* el = lg + 8 + 8 * g; float ev[8];
#pragma unroll
            for (int j = 0; j < 8; ++j) ev[j] = el[j];
            int i1 = 0; float m1v = ev[0];
#pragma unroll
            for (int j = 1; j < 8; ++j) if (ev[j] > m1v) { m1v = ev[j]; i1 = j; }
            int i2 = -1; float m2v = -3.0e38f;
#pragma unroll
            for (int j = 0; j < 8; ++j) if (j != i1 && ev[j] > m2v) { m2v = ev[j]; i2 = j; }
            const float eb = expf(m2v - m1v), den = 1.f / (1.f + eb);
            const int e0 = 8 * g + i1, e1 = 8 * g + i2;
            const int r0 = __hip_atomic_fetch_add(hist + e0, 1, __ATOMIC_RELAXED, __HIP_MEMORY_SCOPE_WORKGROUP), r1 = __hip_atomic_fetch_add(hist + e1, 1, __ATOMIC_RELAXED, __HIP_MEMORY_SCOPE_WORKGROUP);
            LAS int* ri = rinfo + (F.wave * 32 + F.lane) * 8;
            ri[0] = e0; ri[1] = r0; ri[2] = e1; ri[3] = r1; ri[4] = __float_as_int(pg * den); ri[5] = __float_as_int(pg * eb * den);
        }
        __syncthreads();
        if (F.tid < 64) { const int hc = hist[F.tid]; base[F.tid] = hc ? (int)__hip_atomic_fetch_add(F.ctl + CW_GCNT + (l * 64 + F.tid) * 16, (unsigned)hc, RLX_AGENT) : 0; }
        __syncthreads();
        if (F.tid < 256) { const LAS int* ri = rinfo + F.tid * 8; const size_t row = (size_t)tile * 256 + F.tid;
            const int e0 = ri[0], s0 = base[e0] + ri[1], e1 = ri[2], s1 = base[e1] + ri[3];
            LIST[(size_t)e0 * 65536 + s0] = (int)row; LIST[(size_t)e1 * 65536 + s1] = (int)row;
            *(GAS i32x4*)(DEST + row * 4) = (i32x4){e0, s0, e1, s1}; *(GAS f32x2*)(GATE + row * 2) = (f32x2){__int_as_float(ri[4]), __int_as_float(ri[5])}; }
        __syncthreads();
    }
}

template <bool GATHER_TOK>
__device__ __forceinline__ int moe_build_tables(Frame& F, int l, int chunk) {
    LAS int* ut = (LAS int*)(F.lds + UT_OFF); LAS unsigned* tokt = (LAS unsigned*)(F.lds + TAB_OFF);
    const LAS int* mbs = (const LAS int*)(F.lds + UT_OFF + 256); const LAS int* cnts = mbs + 72;
    const int NU = 4 * mbs[64];
    if (F.tid < 16) { const int U = F.c + (F.tid + 16 * chunk) * F.G; int e = 0, mbid = 0, pnl = 0;
        if (U < NU) { mbid = U >> 2; pnl = U & 3; for (int j = 1; j < 64; ++j) if (mbs[j] <= mbid) e = j; }
        ut[4 * F.tid] = mbid; ut[4 * F.tid + 1] = e * 4 + pnl; ut[4 * F.tid + 2] = F.tid; ut[4 * F.tid + 3] = (U < NU) ? e : -1; }
    __syncthreads();
    int n = 0;
    for (int i = 0; i < 16; ++i) if (ut[4 * i + 3] >= 0) n = i + 1;
    if (GATHER_TOK) {
        const int* LIST = WSP(int, WS_LIST);
        for (int i = F.tid >> 8; i < n; i += 2) { const int e = ut[4 * i + 3], mbid = ut[4 * i], sl = F.tid & 255; const int s = 256 * (mbid - mbs[e]) + sl;
            tokt[i * 256 + sl] = (s < cnts[e]) ? (unsigned)LIST[(size_t)e * 65536 + s] : 0u; }
    }
    __syncthreads();
    return n;
}
__device__ __forceinline__ void moe_gateup_phase(Frame& F, int l) {
    moe_block_starts(F, l);
    const int NU = 4 * ((const LAS int*)(F.lds + UT_OFF + 256))[64];
    for (int chunk = 0; chunk * 16 * F.G < NU; ++chunk) {
        const int n = moe_build_tables<true>(F, l, chunk);
        pg8::Gemm g{WSP(bf16, WS_H), WSP(bf16, WS_WGU) + (size_t)l * NEXP * 1024 * 1024, DM, DM};
        pg8::TableOrder S{(const LAS int*)(F.lds + UT_OFF), (const LAS unsigned*)(F.lds + TAB_OFF), n};
        EpiGateUp E{WSP(bf16, WS_HID)};
        pg8::gemm_phase<EpiGateUp, pg8::TableOrder, true, true>(F.lds + RING_OFF, g, S, E, F.tid);
        __syncthreads();
    }
}
__device__ __forceinline__ void moe_down_phase(Frame& F, int l) {
    moe_block_starts(F, l);
    const int NU = 4 * ((const LAS int*)(F.lds + UT_OFF + 256))[64];
    for (int chunk = 0; chunk * 16 * F.G < NU; ++chunk) {
        const int n = moe_build_tables<false>(F, l, chunk);
        pg8::Gemm g{WSP(bf16, WS_HID), WSP(bf16, WS_WD) + (size_t)l * NEXP * 1024 * DEXP, DEXP, DEXP};
        pg8::TableOrder S{(const LAS int*)(F.lds + UT_OFF), (const LAS unsigned*)(F.lds + TAB_OFF), n};
        EpiStoreBf16 E{WSP(bf16, WS_Y), DM, 3};
        pg8::gemm_phase<EpiStoreBf16, pg8::TableOrder, true, false>(F.lds + RING_OFF, g, S, E, F.tid);
        __syncthreads();
    }
}

template <int PHSEL>
__global__ void __launch_bounds__(512, 2) trunk_fwd(Args args) {
    extern __shared__ __attribute__((aligned(16))) unsigned char lds_raw[];
    Frame F;
    F.lds = (LAS unsigned char*)lds_raw; F.MISC = (volatile LAS unsigned*)(F.lds + MISC_OFF);
    F.tid = threadIdx.x; F.lane = F.tid & 63; F.wave = __builtin_amdgcn_readfirstlane(F.tid >> 6); F.G = gridDim.x; F.c = blockIdx.x;
    const int wave0 = F.wave;
    F.ws = args.ws; F.out = args.out; F.ctl = (gu32*)(args.ws + WS_CTL);
    for (int u = F.tid; u < 32; u += 512) F.MISC[u] = 0u;
    __syncthreads();
    const int lo = args.ph_lo, hi = args.ph_hi;
    if (hi - lo > 1) (void)xcd_barrier_post((unsigned*)(F.ctl + CW_BAR), F.MISC + 8);
#define EN(j) (PHSEL < 0 || PHSEL == (j))
#define PB() CArgs* Ap_ = (CArgs*)__builtin_amdgcn_kernarg_segment_ptr(); asm volatile("" : "+s"(Ap_)); CArgs& A_ = *Ap_; do { { int c_ = (int)blockIdx.x, g_ = (int)gridDim.x, w_ = wave0; asm volatile("" : "+s"(c_), "+s"(g_), "+s"(w_)); F.c = c_; F.G = g_; F.wave = w_; } { int ln_; asm volatile("v_mbcnt_lo_u32_b32 %0, -1, 0\n\tv_mbcnt_hi_u32_b32 %0, -1, %0" : "=v"(ln_)); F.lane = ln_; } F.tid = F.wave * 64 + F.lane; F.ws = A_.ws; F.out = A_.out; F.ctl = (gu32*)(A_.ws + WS_CTL); } while (0)
#define IN(k) (lo <= (k) && (k) < hi)
#define SEAM(k) do { if (IN(k) && IN((k) + 1)) { XcdBarrier b_; b_.bar = (unsigned*)(F.ctl + CW_BAR); b_.x = xb_xcc_id(); b_.st = F.MISC + 8; xcd_barrier(b_); } } while (0)
    if (EN(0) && IN(0)) { PB(); prologue(F, A_); SEAM(0); }
    for (int l = 0; l < DEPTH; ++l) {
        const int p0 = 1 + 8 * l;
        if (EN(1) && IN(p0)) { PB(); int lq = l; asm volatile("" : "+s"(lq)); mix_norm_phase<false>(F, A_, lq); SEAM(p0); }
        if (EN(2) && IN(p0 + 1)) { PB(); int lq = l; asm volatile("" : "+s"(lq));
            pg8::Gemm g{WSP(bf16, WS_H), WSP(bf16, WS_WIN) + (size_t)lq * PN * DM, DM, DM}; pg8::StaticOrder S; S.init(NTOK, PN, F.G, F.c);
            EpiStoreBf16 E{WSP(bf16, WS_PROJ), PN, 0xffff};
            pg8::gemm_phase<EpiStoreBf16, pg8::StaticOrder, true, false>(F.lds + RING_OFF, g, S, E, F.tid);
            SEAM(p0 + 1); }
        if (EN(3) && IN(p0 + 2)) { PB(); int lq = l; asm volatile("" : "+s"(lq)); mla_up_phase(F, A_, lq); SEAM(p0 + 2); }
        if (EN(4) && IN(p0 + 3)) { PB(); int lq = l; asm volatile("" : "+s"(lq)); attn_phase(F, A_, lq); SEAM(p0 + 3); }
        if (EN(5) && IN(p0 + 4)) { PB(); int lq = l; asm volatile("" : "+s"(lq));
            pg8::Gemm g{WSP(bf16, WS_MIX), WSP(bf16, WS_WOUT) + (size_t)lq * DM * DM, DM, DM}; pg8::StaticOrder S; S.init(NTOK, DM, F.G, F.c);
            EpiOut E{lq == 0 ? (const float*)A_.in[0] : F.out, F.out, WSP(float, WS_MOD) + (size_t)lq * NB * 6144 + 2 * 1024, WSP(float, WS_SS)};
            pg8::gemm_phase<EpiOut, pg8::StaticOrder, true, false>(F.lds + RING_OFF, g, S, E, F.tid);
            SEAM(p0 + 4); }
        if (EN(6) && IN(p0 + 5)) { PB(); int lq = l; asm volatile("" : "+s"(lq)); ffn_router_phase(F, A_, lq); SEAM(p0 + 5); }
        if (EN(7) && IN(p0 + 6)) { PB(); int lq = l; asm volatile("" : "+s"(lq)); moe_gateup_phase(F, lq); SEAM(p0 + 6); }
        if (EN(8) && IN(p0 + 7)) { PB(); int lq = l; asm volatile("" : "+s"(lq)); moe_down_phase(F, lq); SEAM(p0 + 7); }
    }
    if (EN(9) && IN(NPHASE - 1)) { PB(); mix_norm_phase<true>(F, A_, DEPTH); }
#undef IN
#undef SEAM
}

extern "C" void kernel_launch(void* const* d_in, const int* in_sizes, int n_in, void* d_out, int out_size, void* d_ws, size_t ws_size, hipStream_t stream) {
    static int grid = 0;
    if (grid == 0) {
        if (n_in != 26 || out_size != NTOK * DM || ws_size < WS_END) { fprintf(stderr, "kernel_launch: unexpected shapes (n_in %d, out %d, ws %zu < %zu); nothing launched\n", n_in, out_size, ws_size, (size_t)WS_END); grid = -1; return; }
        int dev = 0, cus = 0, per_cu = 0;
        if (hipGetDevice(&dev) != hipSuccess || hipDeviceGetAttribute(&cus, hipDeviceAttributeMultiprocessorCount, dev) != hipSuccess) { grid = -1; return; }
#if MK_MULTI
#define SA(T) if (hipFuncSetAttribute((const void*)trunk_fwd<T>, hipFuncAttributeMaxDynamicSharedMemorySize, LDS_BYTES) != hipSuccess) { fprintf(stderr, "kernel_launch: hipFuncSetAttribute failed\n"); grid = -1; return; }
        SA(0) SA(1) SA(2) SA(3) SA(4) SA(5) SA(6) SA(7) SA(8) SA(9)
#undef SA
#else
        if (hipFuncSetAttribute((const void*)trunk_fwd<-1>, hipFuncAttributeMaxDynamicSharedMemorySize, LDS_BYTES) != hipSuccess) { fprintf(stderr, "kernel_launch: hipFuncSetAttribute failed\n"); grid = -1; return; }
        if (hipOccupancyMaxActiveBlocksPerMultiprocessor(&per_cu, (const void*)trunk_fwd<-1>, 512, LDS_BYTES) != hipSuccess || per_cu < 1) { fprintf(stderr, "kernel_launch: occupancy query says %d\n", per_cu); (void)hipGetLastError(); }
#endif
        (void)per_cu;
        grid = cus;
    }
    if (grid < 0) return;
    (void)hipMemsetAsync((char*)d_ws + WS_CTL, 0, CTL_ZERO_BYTES, stream);
    Args a{};
    for (int i = 0; i < 26; ++i) a.in[i] = d_in[i];
    a.out = (float*)d_out; a.ws = (unsigned char*)d_ws;
#if MK_MULTI
    for (int p = 0; p < NPHASE; ++p) { a.ph_lo = p; a.ph_hi = p + 1; const int ty = (p == 0) ? 0 : (p == NPHASE - 1) ? 9 : 1 + (p - 1) % 8;
        switch (ty) {
#define LK(T) case T: hipLaunchKernelGGL(trunk_fwd<T>, dim3(grid), dim3(512), LDS_BYTES, stream, a); break;
            LK(0) LK(1) LK(2) LK(3) LK(4) LK(5) LK(6) LK(7) LK(8) LK(9)
#undef LK
        } }
#else
    a.ph_lo = 0; a.ph_hi = NPHASE;
    hipLaunchKernelGGL(trunk_fwd<-1>, dim3(grid), dim3(512), LDS_BYTES, stream, a);
#endif
    const hipError_t le = hipPeekAtLastError();
    if (le != hipSuccess) fprintf(stderr, "kernel_launch: launch failed: %s\n", hipGetErrorName(le));
}
```

```cpp
#include <hip/hip_runtime.h>
#include <cstdio>
#include <cstdint>

#ifndef MK_MULTI
#define MK_MULTI 0
#endif

#define GAS __attribute__((address_space(1)))
#define LAS __attribute__((address_space(3)))
typedef unsigned short bf16;
typedef unsigned v4u __attribute__((ext_vector_type(4)));
typedef unsigned v2u __attribute__((ext_vector_type(2)));
typedef float f32x4 __attribute__((ext_vector_type(4)));
typedef float f32x2 __attribute__((ext_vector_type(2)));
typedef float f32x16 __attribute__((ext_vector_type(16)));
typedef short bf16x8 __attribute__((ext_vector_type(8)));
typedef short s16x4 __attribute__((ext_vector_type(4)));
typedef int i32x4 __attribute__((ext_vector_type(4)));
typedef int i32x8 __attribute__((ext_vector_type(8)));
typedef GAS unsigned gu32;
typedef _Float16 f16;
typedef _Float16 f16x4 __attribute__((ext_vector_type(4)));
typedef _Float16 f16x8 __attribute__((ext_vector_type(8)));

constexpr int NB = 32, SEQ = 2048, DM = 1024, NTOK = NB * SEQ, DEPTH = 4;
constexpr int P_IN = 2660, PN = 2816;
constexpr int PC_CKV = 256, PC_KROPE = 384, PC_FOX = 512, PC_CONV = 1280, PC_DIFF = 2048;
constexpr int SRC_CKV = 192, SRC_KROPE = 320, SRC_FOX = 352, SRC_FLOG = 1120, SRC_CONV = 1124, SRC_DIFF = 1892;
constexpr int KUP = 384, NUP = 1024;
constexpr int NEXP = 64, DEXP = 512, NLOG = 80;
constexpr int MAXMB = 576, MAXSLOT = MAXMB * 256;
constexpr float EPS = 1e-6f, LOG2E = 1.4426950408889634f;
constexpr float W8_SCALE = 256.f, A8_SCALE = 16.f;
constexpr int W8_E8M0 = 0x77777777, A8_E8M0 = 0x7b7b7b7b;
constexpr float Y8_SCALE = 16.f;
constexpr float MIX8_SCALE = 4.f; constexpr int MIX8_E8M0 = 0x7d7d7d7d;
constexpr float HID8_SCALE = 8.f; constexpr int HID8_E8M0 = 0x7c7c7c7c;
constexpr int NPHASE = 2 + 8 * DEPTH;

constexpr size_t MiB = 1u << 20;
constexpr size_t WS_CTL = 0, CTL_ZERO_BYTES = 128 * 1024;
constexpr size_t WS_MOD = 1 * MiB;
constexpr size_t WS_T5 = 4 * MiB;
constexpr size_t WS_LAM = 4 * MiB + 64 * 1024;
constexpr size_t WS_WF = 4 * MiB + 128 * 1024;
constexpr size_t WS_WRT = 4 * MiB + 256 * 1024;
constexpr size_t WS_FLOG = 5 * MiB + 512 * 1024;
constexpr size_t WS_SS = 1563 * MiB;
constexpr size_t WS_SHWB = 4 * MiB + 192 * 1024;
constexpr size_t WS_FB = 7 * MiB;
constexpr size_t WS_DEST = 8 * MiB;
constexpr size_t WS_GATE = 9 * MiB;
constexpr size_t WS_LIST = 10 * MiB;
constexpr size_t WS_WIN = 26 * MiB;
constexpr size_t WS_WUP = 48 * MiB;
constexpr size_t WS_WOUT = 51 * MiB;
constexpr size_t WS_WGU = 59 * MiB;
constexpr size_t WS_WD = 571 * MiB;
constexpr size_t WS_H = 827 * MiB;
constexpr size_t WS_PROJ = 955 * MiB;
constexpr size_t WS_MLA = 1307 * MiB;
constexpr size_t WS_MIX = 1435 * MiB;
constexpr size_t WS_XR = 1567 * MiB;
constexpr size_t WS_H8 = 1695 * MiB;
constexpr size_t WS_END = 1759 * MiB;
constexpr size_t WS_Y = WS_PROJ, WS_HID = WS_MLA;
static_assert((size_t)MAXSLOT * 1024 * 2 <= WS_MLA - WS_PROJ && (size_t)MAXSLOT * 512 * 2 <= WS_SS - WS_MLA, "overlays fit");
constexpr int CW_TMO = 0, CW_CODE = 1, CW_BAR = 4096, CW_Q = 8192  , CW_GCNT = 12288  , CW_QX = 20480  ;

constexpr int RING_OFF = 0, RING_BYTES = 131072;
constexpr int TAB_OFF = RING_BYTES, TAB_BYTES = 16384;
constexpr int UT_OFF = TAB_OFF + TAB_BYTES;
constexpr int MISC_OFF = UT_OFF + 1024;
constexpr int LDS_BYTES = MISC_OFF + 128;
static_assert(LDS_BYTES <= 160 * 1024, "LDS");

#define RLX_AGENT __ATOMIC_RELAXED, __HIP_MEMORY_SCOPE_AGENT
#define LDS_WAIT() asm volatile("s_waitcnt lgkmcnt(0)" ::: "memory")
#define VM_WAIT() asm volatile("s_waitcnt vmcnt(0)" ::: "memory")
__device__ __forceinline__ unsigned f2bf(float f) { unsigned u = __builtin_bit_cast(unsigned, f); return (u + 0x7fffu + ((u >> 16) & 1u)) >> 16; }
__device__ __forceinline__ unsigned pk2(float lo, float hi) { return f2bf(lo) | (f2bf(hi) << 16); }
__device__ __forceinline__ float bflo(unsigned w) { return __builtin_bit_cast(float, w << 16); }
__device__ __forceinline__ float bfhi(unsigned w) { return __builtin_bit_cast(float, w & 0xffff0000u); }
__device__ __forceinline__ float bf2f(bf16 h) { return __builtin_bit_cast(float, (unsigned)h << 16); }
__device__ __forceinline__ float shx(float v, int o, int lane) { return __builtin_bit_cast(float, __builtin_amdgcn_ds_bpermute((lane ^ o) << 2, __builtin_bit_cast(int, v))); }
__device__ __forceinline__ float wave_sum(float v, int lane) {
#pragma unroll
    for (int o = 1; o < 64; o <<= 1) v += shx(v, o, lane);
    return v;
}
__device__ __forceinline__ int opq(int v) { asm volatile("" : "+v"(v)); return v; }
__device__ __forceinline__ float clamp8(float v) { return __builtin_fminf(__builtin_fmaxf(v, -448.f), 448.f); }
__device__ __forceinline__ v2u pack_fp8x8(float a0, float a1, float a2, float a3, float a4, float a5, float a6, float a7) {
    int lo = __builtin_amdgcn_cvt_pk_fp8_f32(clamp8(a0), clamp8(a1), 0, false); lo = __builtin_amdgcn_cvt_pk_fp8_f32(clamp8(a2), clamp8(a3), lo, true);
    int hi = __builtin_amdgcn_cvt_pk_fp8_f32(clamp8(a4), clamp8(a5), 0, false); hi = __builtin_amdgcn_cvt_pk_fp8_f32(clamp8(a6), clamp8(a7), hi, true);
    v2u r; r.x = (unsigned)lo; r.y = (unsigned)hi; return r;
}
__device__ __forceinline__ float fast_exp2(float x) { return __builtin_amdgcn_exp2f(x); }
__device__ __forceinline__ float fast_rcp(float x) { return __builtin_amdgcn_rcpf(x); }
__device__ __forceinline__ float fast_rsq(float x) { return __builtin_amdgcn_rsqf(x); }
__device__ __forceinline__ float silu_f(float x) { return x * fast_rcp(1.f + fast_exp2(-x * LOG2E)); }

__device__ __forceinline__ void stagger_start(int c, unsigned ticks) {
    const unsigned long long t0 = __builtin_amdgcn_s_memrealtime(); const unsigned long long d = (unsigned long long)((unsigned)(c & 3) * ticks);
    while (__builtin_amdgcn_s_memrealtime() - t0 < d) __builtin_amdgcn_s_sleep(8);
}
#define XB_TMO      128
#define XB_XCNT(j)  (256  + 64 * (j))
#define XB_XSUB(j)  (1280 + 64 * (j))
#define XB_XGEN(j)  (2304 + 64 * (j))
#define XB_TOP      3328
#define XB_TOPGEN   3392
#define XCD_BAR_WORDS 3456
#define XB_SPIN_CAP (1u << 22)
__device__ __forceinline__ unsigned xb_ld(unsigned* p)              { return __hip_atomic_load(p, __ATOMIC_RELAXED, __HIP_MEMORY_SCOPE_AGENT); }
__device__ __forceinline__ unsigned xb_add(unsigned* p, unsigned v) { return __hip_atomic_fetch_add(p, v, __ATOMIC_RELAXED, __HIP_MEMORY_SCOPE_AGENT); }
__device__ __forceinline__ unsigned xb_xcc_id() { return (unsigned)__builtin_amdgcn_s_getreg((3 << 11) | 20) & 0xFu; }
#define XB_SPIN(cond, bar) do { unsigned _sp = 0; while (cond) { __builtin_amdgcn_s_sleep(1); \
    if ((++_sp & 255u) == 0u) { if (xb_ld(&(bar)[XB_TMO])) break; if (_sp > XB_SPIN_CAP) { atomicAdd(&(bar)[XB_TMO], 1u); break; } } } } while (0)
struct XcdBarrier { unsigned* bar; unsigned x; volatile LAS unsigned* st; };
__device__ __forceinline__ XcdBarrier xcd_barrier_post(unsigned* bar, volatile LAS unsigned* st) {
    XcdBarrier b; b.bar = bar; b.x = xb_xcc_id(); b.st = st;
    if (threadIdx.x == 0) (void)xb_add(&bar[XB_XCNT(b.x)], 1u);
    return b;
}
__device__ __forceinline__ void xcd_barrier_complete(unsigned* bar, unsigned x, unsigned& nloc, unsigned& nx) {
    const unsigned G = gridDim.x * gridDim.y * gridDim.z;
    unsigned sum, cnt, mine, sp = 0u;
    for (;;) {
        sum = 0u; cnt = 0u; mine = 0u;
#pragma nounroll
        for (unsigned j = 0; j < 16; ++j) { const unsigned c = xb_ld(&bar[XB_XCNT(j)]); sum += c; cnt += (c > 0u) ? 1u : 0u; mine = (j == x) ? c : mine; }
        if (sum == G) break;
        __builtin_amdgcn_s_sleep(1);
        if ((++sp & 255u) == 0u) { if (xb_ld(&bar[XB_TMO])) break; if (sp > XB_SPIN_CAP) { atomicAdd(&bar[XB_TMO], 1u); break; } }
    }
    nloc = mine > 0u ? mine : 1u; nx = cnt > 0u ? cnt : 1u;
}
__device__ __forceinline__ void xcd_barrier(const XcdBarrier& b) {
    asm volatile("s_waitcnt vmcnt(0)" ::: "memory");
    __syncthreads();
    if (threadIdx.x == 0) {
        unsigned* bar = b.bar;
        __builtin_amdgcn_s_waitcnt(0);
        unsigned nloc = b.st[0], nx = b.st[1];
        if (nloc == 0u) { xcd_barrier_complete(bar, b.x, nloc, nx); b.st[0] = nloc; b.st[1] = nx; }
        const unsigned old = xb_add(&bar[XB_XSUB(b.x)], 1u);
        const unsigned gen = old / nloc;
        if (old + 1u == (gen + 1u) * nloc) {
            __builtin_amdgcn_fence(__ATOMIC_RELEASE, "agent");
            asm volatile("s_waitcnt vmcnt(0)" ::: "memory");
            const unsigned og = xb_add(&bar[XB_TOP], 1u);
            const unsigned tg = og / nx;
            if (og + 1u == (tg + 1u) * nx) xb_add(&bar[XB_TOPGEN], 1u);
            else XB_SPIN(xb_ld(&bar[XB_TOPGEN]) == tg, bar);
            __builtin_amdgcn_fence(__ATOMIC_ACQUIRE, "agent");
            xb_add(&bar[XB_XGEN(b.x)], 1u);
            asm volatile("s_waitcnt vmcnt(0)" ::: "memory");
        } else {
            XB_SPIN(xb_ld(&bar[XB_XGEN(b.x)]) == gen, bar);
            __builtin_amdgcn_fence(__ATOMIC_ACQUIRE, "agent");
            asm volatile("s_waitcnt vmcnt(0)" ::: "memory");
        }
    }
    __syncthreads();
}

namespace pg8 {
constexpr int BM = 256, BK = 64, HALF = 128, HTB = HALF * BK * 2, NXCD = 8, WGM = 8;
__host__ __device__ __forceinline__ int lds_byte(int r, int c) { const int st = (r >> 4) * 2 + (c >> 5), rr = r & 15, cc = c & 31, ob = rr * 64 + cc * 2; return st * 1024 + (ob ^ (((ob >> 9) & 1) << 5)); }
__host__ __device__ __forceinline__ void stage_rc(int b, int& R, int& C) { const int st = b / 1024, sb = b % 1024, swz = sb ^ (((sb >> 9) & 1) << 5); R = (st >> 1) * 16 + swz / 64; C = (st & 1) * 32 + (swz % 64) / 2; }
__host__ __device__ __forceinline__ int perm32(int rho) { const int n = rho >> 4, i = rho & 15; return 8 * (i >> 2) + 4 * n + (i & 3); }
__host__ __device__ __forceinline__ int perm32w(int rho) { const int n = rho >> 4, i = rho & 15, fq = i >> 2, g = ((fq & 1) << 1) | (fq >> 1); return 8 * g + 4 * n + (i & 3); }
struct Unit { int pm, pn, aux; };
struct Gemm { const bf16* A; const bf16* Bt; int K; int lda; int sa8 = 0; int ldb = 0; };

struct StaticOrder {
    int nM, nN, nwg, G, c;
    __device__ void init(int M, int N, int G_, int c_) { nM = M / BM; nN = N / BM; nwg = nM * nN; G = G_; c = c_; }
    __device__ __forceinline__ bool next(int i, Unit& u) const {
        const long L = (long)i * G + c; if (L >= nwg) return false;
        int wgid = (int)L; { const int q = nwg / NXCD, r = nwg % NXCD, xcd = wgid % NXCD, off = wgid / NXCD; wgid = (xcd < r ? xcd * (q + 1) : r * (q + 1) + (xcd - r) * q) + off; }
        const int nig = WGM * nN, gid = wgid / nig, fm = gid * WGM, gsz = (nM - fm) < WGM ? (nM - fm) : WGM;
        u.pm = fm + ((wgid % nig) % gsz); u.pn = (wgid % nig) / gsz; u.aux = 0; return true;
    }
    __device__ __forceinline__ unsigned tok(const Unit&, int) const { return 0u; }
};
struct PanelOrder {
    int pm, nN;
    __device__ __forceinline__ bool next(int i, Unit& u) const { if (i >= nN) return false; int p_ = pm; asm volatile("" : "+s"(p_)); u.pm = p_; u.pn = i; u.aux = 0; return true; }
    __device__ __forceinline__ unsigned tok(const Unit&, int) const { return 0u; }
};
struct TableOrder {
    const LAS int* ut; const LAS unsigned* tokt; int n;
    __device__ __forceinline__ bool next(int i, Unit& u) const { if (i >= n) return false; const i32x4 d = *(const LAS i32x4*)(ut + 4 * i); u.pm = __builtin_amdgcn_readfirstlane(d.x); u.pn = __builtin_amdgcn_readfirstlane(d.y); u.aux = __builtin_amdgcn_readfirstlane(d.z); return true; }
    __device__ __forceinline__ unsigned tok(const Unit& u, int slot) const { return tokt[u.aux * 256 + slot]; }
};

__device__ __forceinline__ unsigned cvt_pk_bf16(float lo, float hi) { unsigned r; asm volatile("v_cvt_pk_bf16_f32 %0, %1, %2" : "=v"(r) : "v"(lo), "v"(hi)); return r; }

template <class Epi, class Sched, bool ALIGN_EPI, bool GATHER, bool FP8 = false>
__device__ __forceinline__ void gemm_phase(LAS unsigned char* lds, const Gemm g, const Sched& S, const Epi& E, const int tid_in) {
    const int tid = opq(tid_in), wid = __builtin_amdgcn_readfirstlane(tid >> 6), lane = tid & 63, wr = wid >> 2, wc = wid & 3, fr = lane & 15, fq = lane >> 4;
    const int K = g.K, nt = K / BK, lda = g.lda, ldb = g.ldb ? g.ldb : K;
    unsigned voffA[2], voffB[2]; int RA[2]; unsigned CA[2];
    const size_t kstep = (size_t)(BK * 2);
    const size_t hstepA = (size_t)HALF * lda * 2, hstepB = (size_t)HALF * ldb * 2;
    const size_t tstepA = 2 * hstepA, tstepB = 2 * hstepB;
#pragma unroll
    for (int i = 0; i < 2; ++i) { int R, C; stage_rc(tid * 16 + i * 8192, R, C); const int Rb = Epi::PERM ? ((R & ~31) + (Epi::PERMW ? perm32w(R & 31) : perm32(R & 31))) : R;
        RA[i] = R; CA[i] = (unsigned)C * 2u; voffB[i] = (unsigned)(Rb * ldb + C) * 2u; voffA[i] = (unsigned)(R * lda + C) * 2u; }
    const unsigned ldsw = (unsigned)wid * 1024u;
    const int aoff = lds_byte(wr * 64 + fr, fq * 8), boff = lds_byte(wc * 32 + fr, fq * 8);
#define PG8_SA(b, h) (((b) * 2 + (h)) * HTB)
#define PG8_SB(b, h) ((4 + (b) * 2 + (h)) * HTB)
#define PG8_GLDS(gp, bufoff, _i) __builtin_amdgcn_global_load_lds((const unsigned*)(gp), (LAS unsigned*)(lds + (bufoff) + ldsw + (_i) * 8192), 16, 0, 0)
#define PG8_STAGE_B(bufoff, gbase) do { _Pragma("unroll") for (int _i = 0; _i < 2; ++_i) PG8_GLDS((const char*)(gbase) + voffB[_i], bufoff, _i); } while (0)
#define PG8_STAGE_A(bufoff, gbase, OA, h) do { _Pragma("unroll") for (int _i = 0; _i < 2; ++_i) { if constexpr (GATHER) PG8_GLDS((const char*)(gbase) + OA[h][_i], bufoff, _i); else PG8_GLDS((const char*)(gbase) + (size_t)(h) * hstepA + voffA[_i], bufoff, _i); } } while (0)
#define PG8_LD8(P) __builtin_shufflevector(*(const LAS i32x4*)(P), *(const LAS i32x4*)((P) + 1024), 0, 1, 2, 3, 4, 5, 6, 7)
#define PG8_LDA(dst, b, h) do { _Pragma("unroll") for (int m = 0; m < 4; ++m) { if constexpr (FP8) dst##8[m] = PG8_LD8(lds + PG8_SA(b, h) + aoff + m * 2048); else { _Pragma("unroll") for (int k = 0; k < 2; ++k) dst[m][k] = *(const LAS bf16x8*)(lds + PG8_SA(b, h) + aoff + m * 2048 + k * 1024); } } } while (0)
#define PG8_LDB(dst, b, h) do { _Pragma("unroll") for (int n = 0; n < 2; ++n) { if constexpr (FP8) dst##8[n] = PG8_LD8(lds + PG8_SB(b, h) + boff + n * 2048); else { _Pragma("unroll") for (int k = 0; k < 2; ++k) dst[n][k] = *(const LAS bf16x8*)(lds + PG8_SB(b, h) + boff + n * 2048 + k * 1024); } } } while (0)
#define PG8_CAT(X0, X1) __builtin_shufflevector(__builtin_bit_cast(i32x4, X0), __builtin_bit_cast(i32x4, X1), 0, 1, 2, 3, 4, 5, 6, 7)
#define PG8_MMA(ai, bj, At, Bt) do { __builtin_amdgcn_s_setprio(1); _Pragma("unroll") for (int m = 0; m < 4; ++m) _Pragma("unroll") for (int n = 0; n < 2; ++n) { \
        if constexpr (FP8) asm("v_mfma_scale_f32_16x16x128_f8f6f4 %0, %1, %2, %0, %3, %4 op_sel_hi:[0,0,0]" : "+v"(acc[ai][bj][m][n]) : "v"(Bt##8[n]), "v"(At##8[m]), "v"(sc8w), "v"(sc8a)); \
        else { _Pragma("unroll") for (int k = 0; k < 2; ++k) acc[ai][bj][m][n] = __builtin_amdgcn_mfma_f32_16x16x32_bf16(Bt[n][k], At[m][k], acc[ai][bj][m][n], 0, 0, 0); } } __builtin_amdgcn_s_setprio(0); } while (0)
#define PG8_WAIT_V(n) asm volatile("s_waitcnt vmcnt(" #n ")" ::: "memory")
#define PG8_WAIT_L(n) asm volatile("s_waitcnt lgkmcnt(" #n ")" ::: "memory")
#define PG8_BAR __builtin_amdgcn_s_barrier()
#define PG8_SCHED __builtin_amdgcn_sched_barrier(0)
#define PG8_SETOA(OA, U) do { _Pragma("unroll") for (int _h = 0; _h < 2; ++_h) _Pragma("unroll") for (int _i = 0; _i < 2; ++_i) \
        OA[_h][_i] = GATHER ? (S.tok(U, _h * HALF + RA[_i]) * (unsigned)lda * 2u + CA[_i]) : 0u; } while (0)
    Unit cur, nxt; int ui = 0;
    if (!S.next(0, cur)) return;
    f32x4 acc[2][2][4][2];
#pragma unroll
    for (int a = 0; a < 2; ++a)
#pragma unroll
        for (int b = 0; b < 2; ++b)
#pragma unroll
            for (int m = 0; m < 4; ++m)
#pragma unroll
                for (int n = 0; n < 2; ++n) acc[a][b][m][n] = (f32x4){0.f, 0.f, 0.f, 0.f};
    bf16x8 At[4][2], B0[2][2], B1[2][2]; i32x8 At8[4], B08[2], B18[2];
    const int sc8w = W8_E8M0, sc8a = g.sa8;
    unsigned oc[2][2], on[2][2];
    PG8_SETOA(oc, cur);
    const char* cA = (const char*)g.A + (GATHER ? (size_t)0 : (size_t)cur.pm * tstepA); const char* cB = (const char*)g.Bt + (size_t)cur.pn * tstepB;
    PG8_STAGE_B(PG8_SB(0, 0), cB); PG8_STAGE_B(PG8_SB(0, 1), cB + hstepB); PG8_STAGE_A(PG8_SA(0, 0), cA, oc, 0); PG8_STAGE_A(PG8_SA(0, 1), cA, oc, 1);
    if (wr == 1) PG8_BAR;
    PG8_WAIT_V(2); PG8_BAR;
    PG8_STAGE_B(PG8_SB(1, 0), cB + kstep); PG8_STAGE_A(PG8_SA(1, 0), cA + kstep, oc, 0); PG8_STAGE_B(PG8_SB(1, 1), cB + hstepB + kstep);
    PG8_WAIT_V(6); PG8_BAR;
    for (;;) {
        const bool has_next = S.next(ui + 1, nxt);
        const char* nA = has_next ? (const char*)g.A + (GATHER ? (size_t)0 : (size_t)nxt.pm * tstepA) : cA; const char* nB = has_next ? (const char*)g.Bt + (size_t)nxt.pn * tstepB : cB;
        if (has_next) { PG8_SETOA(on, nxt); } else {
#pragma unroll
            for (int _h = 0; _h < 2; ++_h)
#pragma unroll
                for (int _i = 0; _i < 2; ++_i) on[_h][_i] = oc[_h][_i]; }
#pragma nounroll
        for (int t = 0; t < nt; t += 2) {
            const bool last = (t == nt - 2);
            const char* a1 = cA + (size_t)(t + 1) * kstep;
            const char* a2 = last ? nA : cA + (size_t)(t + 2) * kstep; const char* b2 = last ? nB : cB + (size_t)(t + 2) * kstep;
            const char* a3 = a2 + kstep; const char* b3 = b2 + kstep;
            unsigned o2[2][2];
#pragma unroll
            for (int _h = 0; _h < 2; ++_h)
#pragma unroll
                for (int _i = 0; _i < 2; ++_i) o2[_h][_i] = last ? on[_h][_i] : oc[_h][_i];
            PG8_LDB(B0, 0, 0); PG8_LDB(B1, 0, 1); PG8_SCHED; PG8_LDA(At, 0, 0); PG8_STAGE_A(PG8_SA(1, 1), a1, oc, 1);
            PG8_WAIT_V(8); PG8_WAIT_L(0); PG8_BAR; PG8_MMA(0, 0, At, B0); PG8_MMA(0, 1, At, B1); PG8_BAR; PG8_SCHED;
            PG8_LDA(At, 0, 1); PG8_STAGE_B(PG8_SB(0, 0), b2); PG8_STAGE_B(PG8_SB(0, 1), b2 + hstepB); PG8_STAGE_A(PG8_SA(0, 0), a2, o2, 0);
            PG8_WAIT_V(8); PG8_WAIT_L(0); PG8_BAR; PG8_MMA(1, 0, At, B0); PG8_MMA(1, 1, At, B1); PG8_BAR; PG8_SCHED;
            PG8_LDB(B0, 1, 0); PG8_LDB(B1, 1, 1); PG8_SCHED; PG8_LDA(At, 1, 0); PG8_STAGE_A(PG8_SA(0, 1), a2, o2, 1);
            PG8_WAIT_V(8); PG8_WAIT_L(0); PG8_BAR; PG8_MMA(0, 0, At, B0); PG8_MMA(0, 1, At, B1); PG8_BAR; PG8_SCHED;
            PG8_LDA(At, 1, 1); PG8_STAGE_B(PG8_SB(1, 0), b3); PG8_STAGE_B(PG8_SB(1, 1), b3 + hstepB); PG8_STAGE_A(PG8_SA(1, 0), a3, o2, 0);
            PG8_WAIT_V(8); PG8_WAIT_L(0); PG8_BAR; PG8_MMA(1, 0, At, B0); PG8_MMA(1, 1, At, B1); PG8_BAR; PG8_SCHED;
        }
        if constexpr (ALIGN_EPI) { if (wr == 0) PG8_BAR; }
        if constexpr (FP8) asm volatile("s_nop 15\n\ts_nop 15" ::: "memory");
        E(acc, cur, wr, wc, fr, fq);
        if (!has_next) break;
#pragma unroll
        for (int a = 0; a < 2; ++a)
#pragma unroll
            for (int b = 0; b < 2; ++b)
#pragma unroll
                for (int m = 0; m < 4; ++m)
#pragma unroll
                    for (int n = 0; n < 2; ++n) acc[a][b][m][n] = (f32x4){0.f, 0.f, 0.f, 0.f};
        cur = nxt; cA = nA; cB = nB; ++ui;
#pragma unroll
        for (int _h = 0; _h < 2; ++_h)
#pragma unroll
            for (int _i = 0; _i < 2; ++_i) oc[_h][_i] = on[_h][_i];
        if constexpr (ALIGN_EPI) { if (wr == 1) PG8_BAR; }
    }
    PG8_WAIT_V(0);
    if constexpr (!ALIGN_EPI) { if (wr == 0) PG8_BAR; }
    PG8_BAR;
#undef PG8_SA
#undef PG8_SB
#undef PG8_GLDS
#undef PG8_STAGE_A
#undef PG8_STAGE_B
#undef PG8_LDA
#undef PG8_LD8
#undef PG8_LDB
#undef PG8_MMA
#undef PG8_CAT
#undef PG8_WAIT_V
#undef PG8_WAIT_L
#undef PG8_BAR
#undef PG8_SCHED
#undef PG8_SETOA
}
}

struct Args { const void* in[26]; float* out; unsigned char* ws; int ph_lo, ph_hi; };
typedef const __attribute__((address_space(4))) Args CArgs;
struct Frame {
    LAS unsigned char* lds;
    volatile LAS unsigned* MISC;
    gu32* ctl;
    int tid, lane, wave, G, c;
    unsigned char* ws; float* out;
};
#define IN_x ((const float*)A.in[0])
#define IN_cnd ((const float*)A.in[1])
#define IN_pos ((const int*)A.in[2])
#define IN_t5 ((const float*)A.in[3])
#define IN_ada_w ((const float*)A.in[4])
#define IN_ada_b ((const float*)A.in[5])
#define IN_g_mix ((const float*)A.in[6])
#define IN_g_ffn ((const float*)A.in[7])
#define IN_w_in ((const float*)A.in[8])
#define IN_gq ((const float*)A.in[9])
#define IN_w_uq ((const float*)A.in[10])
#define IN_gkv ((const float*)A.in[11])
#define IN_w_ukv ((const float*)A.in[12])
#define IN_fb ((const float*)A.in[13])
#define IN_conv_w ((const float*)A.in[14])
#define IN_dlam ((const float*)A.in[15])
#define IN_subln ((const float*)A.in[16])
#define IN_w_out ((const float*)A.in[17])
#define IN_rg_w ((const float*)A.in[18])
#define IN_rg_b ((const float*)A.in[19])
#define IN_re_w ((const float*)A.in[20])
#define IN_re_b ((const float*)A.in[21])
#define IN_wg ((const float*)A.in[22])
#define IN_wu ((const float*)A.in[23])
#define IN_wd ((const float*)A.in[24])
#define IN_g_fin ((const float*)A.in[25])
#define WSP(T, off) ((T*)(F.ws + (off)))

template <class Fn, bool OUT8 = false>
__device__ __forceinline__ void transpose_item(const Fn& f, bf16* dst, int ldd, int k0, int n0, LAS float* scr, int lane) {
    const int nq = lane & 15, kr = lane >> 4;
    f32x4 v[16];
#pragma unroll
    for (int i = 0; i < 16; ++i) v[i] = f(k0 + 4 * i + kr, n0 + 4 * nq);
#pragma unroll
    for (int i = 0; i < 16; ++i) { const int k = 4 * i + kr;
        scr[(4 * nq + 0) * 65 + k] = v[i].x; scr[(4 * nq + 1) * 65 + k] = v[i].y; scr[(4 * nq + 2) * 65 + k] = v[i].z; scr[(4 * nq + 3) * 65 + k] = v[i].w; }
    LDS_WAIT(); asm volatile("" ::: "memory");
    const int kc = lane & 7, nr = lane >> 3;
#pragma unroll
    for (int j = 0; j < 8; ++j) { const int n = nr + 8 * j; const LAS float* s = scr + n * 65 + 8 * kc;
        if (OUT8) { *(GAS v2u*)((unsigned char*)dst + (size_t)(n0 + n) * ldd + k0 + 8 * kc) = pack_fp8x8(s[0], s[1], s[2], s[3], s[4], s[5], s[6], s[7]); }
        else { v4u o; o.x = pk2(s[0], s[1]); o.y = pk2(s[2], s[3]); o.z = pk2(s[4], s[5]); o.w = pk2(s[6], s[7]);
            *(GAS v4u*)(dst + (size_t)(n0 + n) * ldd + k0 + 8 * kc) = o; } }
    LDS_WAIT(); asm volatile("" ::: "memory");
}
struct SrcPlain {
    const float* W; int ld; int coff; float scale;
    __device__ __forceinline__ f32x4 operator()(int k, int n) const { const f32x4 v = *(const GAS f32x4*)(W + (size_t)k * ld + n + coff); return v * scale; }
};
struct SrcZero { __device__ __forceinline__ f32x4 operator()(int, int) const { return (f32x4){0.f, 0.f, 0.f, 0.f}; } };
struct SrcKrope {
    const float* W;
    __device__ __forceinline__ f32x4 operator()(int k, int n) const { if (n >= PC_KROPE + 32) return (f32x4){0.f, 0.f, 0.f, 0.f}; return *(const GAS f32x4*)(W + (size_t)k * P_IN + SRC_KROPE + (n - PC_KROPE)); }
};
__device__ __forceinline__ int rope_dim_of_pos(int p) { return (p & 4) ? 16 + 4 * (p >> 3) + (p & 3) : 4 * (p >> 3) + (p & 3); }
struct SrcUp {
    const float* wuq; const float* gq; const float* wukv; const float* gkv; float c2a;
    __device__ __forceinline__ float one(int k, int n) const {
        if (n < 384) { if (k >= 192) return 0.f; const int h = n / 96, j = n % 96; const int col = h * 96 + (j < 64 ? j : 64 + rope_dim_of_pos(j - 64)); return gq[k] * wuq[(size_t)k * 384 + col] * c2a; }
        if (n < 512) return 0.f;
        if (k < 256) return 0.f;
        return gkv[k - 256] * wukv[(size_t)(k - 256) * 512 + (n - 512)];
    }
    __device__ __forceinline__ f32x4 operator()(int k, int n) const { return (f32x4){one(k, n), one(k, n + 1), one(k, n + 2), one(k, n + 3)}; }
};

constexpr float C2A = 0.10206207261596577f * LOG2E;
constexpr float C2B = 0.125f * LOG2E;
constexpr float C2D = 0.17677669529663687f * LOG2E;

__device__ __forceinline__ int t5_bucket(int rel) {
    const int n = rel < 0 ? -rel : rel; const int base = rel > 0 ? 16 : 0;
    if (n < 8) return base + n;
    const int fl = 31 - __builtin_clz((unsigned)(n * n));
    int large = 8 + fl - 6; if (large > 15) large = 15;
    return base + large;
}

constexpr int CV_IN = 16 * 44, CV_UP = 6 * 16, CV_OUT = 16 * 16, CV_GU = 16 * 16 * NEXP, CV_D = 8 * 16 * NEXP, CV_LAYER = CV_IN + CV_UP + CV_OUT + CV_GU + CV_D;
constexpr int CV_DENSE = CV_IN + CV_UP + CV_OUT, CV_MOE = CV_GU + CV_D;
__device__ __forceinline__ void convert_item(Frame& F, CArgs& A, int l, int r, LAS float* scr) {
    if (r < CV_IN) {
        const int nb = r / 16, kb = r % 16, n0 = nb * 64, k0 = kb * 64; bf16* dst = WSP(bf16, WS_WIN) + (size_t)l * PN * DM; const float* W = IN_w_in + (size_t)l * DM * P_IN;
        if (n0 < 192) transpose_item(SrcPlain{W, P_IN, 0, 1.f}, dst, DM, k0, n0, scr, F.lane);
        else if (n0 < 256) transpose_item(SrcZero{}, dst, DM, k0, n0, scr, F.lane);
        else if (n0 < 384) transpose_item(SrcPlain{W, P_IN, SRC_CKV - PC_CKV, 1.f}, dst, DM, k0, n0, scr, F.lane);
        else if (n0 < 448) transpose_item(SrcKrope{W}, dst, DM, k0, n0, scr, F.lane);
        else if (n0 < 512) transpose_item(SrcZero{}, dst, DM, k0, n0, scr, F.lane);
        else if (n0 < PC_CONV) transpose_item(SrcPlain{W, P_IN, SRC_FOX - PC_FOX, n0 < PC_FOX + 256 ? C2B : 1.f}, dst, DM, k0, n0, scr, F.lane);
        else if (n0 < PC_DIFF) transpose_item(SrcPlain{W, P_IN, SRC_CONV - PC_CONV, 1.f}, dst, DM, k0, n0, scr, F.lane);
        else transpose_item(SrcPlain{W, P_IN, SRC_DIFF - PC_DIFF, n0 < PC_DIFF + 256 ? C2D : 1.f}, dst, DM, k0, n0, scr, F.lane);
        return; }
    r -= CV_IN;
    if (r < CV_UP) { const int nb = r / 6, kb = r % 6;
        transpose_item(SrcUp{IN_w_uq + (size_t)l * 192 * 384, IN_gq + l * 192, IN_w_ukv + (size_t)l * 128 * 512, IN_gkv + l * 128, C2A}, WSP(bf16, WS_WUP) + (size_t)l * NUP * KUP, KUP, kb * 64, nb * 64, scr, F.lane);
        return; }
    r -= CV_UP;
    if (r < CV_OUT) { const int nb = r / 16, kb = r % 16;
        transpose_item<SrcPlain, true>(SrcPlain{IN_w_out + (size_t)l * DM * DM, DM, 0, W8_SCALE}, (bf16*)(WSP(unsigned char, WS_WOUT) + (size_t)l * DM * DM), DM, kb * 64, nb * 64, scr, F.lane);
        return; }
    r -= CV_OUT;
    if (r < CV_GU) { const int e = r / 256, q = r % 256, nb = q / 16, kb = q % 16, n0 = nb * 64;
        const int pn = n0 >> 8, half = (n0 >> 7) & 1, j0 = n0 & 127;
        const float* W = (half ? IN_wu : IN_wg) + ((size_t)l * NEXP + e) * DM * DEXP;
        transpose_item<SrcPlain, true>(SrcPlain{W, DEXP, 128 * pn + j0 - n0, W8_SCALE}, (bf16*)(WSP(unsigned char, WS_WGU) + ((size_t)l * NEXP + e) * 1024 * 1024), DM, kb * 64, n0, scr, F.lane);
        return; }
    r -= CV_GU;
    { const int e = r / 128, q = r % 128, nb = q / 8, kb = q % 8;
      transpose_item<SrcPlain, true>(SrcPlain{IN_wd + ((size_t)l * NEXP + e) * DEXP * DM, DM, 0, W8_SCALE}, (bf16*)(WSP(unsigned char, WS_WD) + ((size_t)l * NEXP + e) * 1024 * DEXP), DEXP, kb * 64, nb * 64, scr, F.lane); }
}

__device__ __forceinline__ void prologue(Frame& F, CArgs& A) {
    const int gw = F.c * 8 + F.wave, NGW = F.G * 8;
    const int gt = F.c * 512 + F.tid, NGT = F.G * 512;
    {
        LAS float* cs = (LAS float*)(F.lds + RING_OFF);
        bool loaded = false;
        float* MOD = WSP(float, WS_MOD);
        for (int it = F.c; it < DEPTH * 64; it += F.G) {
            if (!loaded) { for (int e = F.tid; e < NB * DM; e += 512) { const int b = e >> 10, k = e & 1023; cs[k * 32 + b] = silu_f(IN_cnd[e]); } loaded = true; __syncthreads(); }
            const int l = it >> 6, n0 = (it & 63) * 96;
            const int col = F.tid >> 2, ks = F.tid & 3;
            if (F.tid < 384) {
                const float* W = IN_ada_w + (size_t)l * DM * 6144 + n0 + col;
                float acc[32];
#pragma unroll
                for (int b = 0; b < 32; ++b) acc[b] = 0.f;
                for (int kk0 = 0; kk0 < 256; kk0 += 16) { float w[16];
#pragma unroll
                    for (int u = 0; u < 16; ++u) w[u] = W[(size_t)(4 * (kk0 + u) + ks) * 6144];
#pragma unroll
                    for (int u = 0; u < 16; ++u) { const int k = 4 * (kk0 + u) + ks;
#pragma unroll
                        for (int b4 = 0; b4 < 8; ++b4) { const f32x4 c4 = *(const LAS f32x4*)(cs + k * 32 + 4 * b4); acc[4 * b4] += c4.x * w[u]; acc[4 * b4 + 1] += c4.y * w[u]; acc[4 * b4 + 2] += c4.z * w[u]; acc[4 * b4 + 3] += c4.w * w[u]; } } }
#pragma unroll
                for (int b = 0; b < 32; ++b) { float v = acc[b]; v += shx(v, 1, F.lane); v += shx(v, 2, F.lane); acc[b] = v; }
                if (ks == 0) { const float bias = IN_ada_b[l * 6144 + n0 + col];
#pragma unroll
                    for (int b = 0; b < 32; ++b) MOD[((size_t)l * NB + b) * 6144 + n0 + col] = acc[b] + bias; }
            }
        }
        __syncthreads();
    }
    { float* T5 = WSP(float, WS_T5);
      for (int i = gt; i < 4 * 2112; i += NGT) { const int h = i / 2112, r = i % 2112; T5[i] = IN_t5[t5_bucket(r - 2047) * 4 + h] * LOG2E; }
      float* LAM = WSP(float, WS_LAM);
      if (gt < DEPTH) { const int l = gt; const float* p = IN_dlam + l * 128; float s0 = 0.f, s1 = 0.f;
          for (int i = 0; i < 32; ++i) { s0 += p[i] * p[32 + i]; s1 += p[64 + i] * p[96 + i]; }
          LAM[l] = expf(s0) - expf(s1) + (0.8f - 0.6f * expf(-0.3f * (float)l)); }
      float* WF = WSP(float, WS_WF);
      for (int i = gt; i < DEPTH * 4 * DM; i += NGT) { const int l = i >> 12, j = (i >> 10) & 3, k = i & 1023; WF[i] = IN_w_in[((size_t)l * DM + k) * P_IN + SRC_FLOG + j]; }
      bf16* WRT = WSP(bf16, WS_WRT);
      for (int i = gt; i < DEPTH * NLOG * DM; i += NGT) { const int l = i / (NLOG * DM), r = i % (NLOG * DM), n = r >> 10, k = r & 1023;
          const float v = n < 8 ? IN_rg_w[((size_t)l * DM + k) * 8 + n] : (n < 72 ? IN_re_w[((size_t)l * DM + k) * 64 + (n - 8)] : 0.f);
          const unsigned hi = f2bf(v); const float lo = v - __builtin_bit_cast(float, hi << 16);
          WRT[((size_t)l * 2 + 0) * NLOG * DM + r] = (bf16)hi; WRT[((size_t)l * 2 + 1) * NLOG * DM + r] = (bf16)f2bf(lo); }
    }
    {
        LAS float* scr = (LAS float*)(F.lds + RING_OFF) + F.wave * (64 * 65);
        for (int it = gw; it < CV_DENSE; it += NGW) convert_item(F, A, 0, it, scr);
    }
}
__device__ __forceinline__ float rope_rev(int i) {
    constexpr float T[16] = {1.591549431e-01f, 8.949940161e-02f, 5.032921210e-02f, 2.830219583e-02f, 1.591549431e-02f, 8.949940161e-03f, 5.032921210e-03f, 2.830219583e-03f,
                             1.591549431e-03f, 8.949940161e-04f, 5.032921210e-04f, 2.830219583e-04f, 1.591549431e-04f, 8.949940161e-05f, 5.032921210e-05f, 2.830219583e-05f};
    return T[i];
}
__device__ __forceinline__ void rope_cs(float posf, float rev, float& c, float& s) { float a = posf * rev; a -= rintf(a); c = __builtin_amdgcn_cosf(a); s = __builtin_amdgcn_sinf(a); }

__device__ __forceinline__ void moe_block_starts(Frame& F, int lm) {
    LAS int* mbs = (LAS int*)(F.lds + UT_OFF + 256); LAS int* cnts = mbs + 72;
    if (F.tid < 64) cnts[F.tid] = (int)__hip_atomic_load(F.ctl + CW_GCNT + (lm * 64 + F.tid) * 16, RLX_AGENT);
    __syncthreads();
    if (F.tid == 0) { int a = 0; for (int e = 0; e < 64; ++e) { mbs[e] = a; a += (cnts[e] + 255) >> 8; } mbs[64] = a; }
    __syncthreads();
}

template <bool FINAL, bool COMB>
__device__ __forceinline__ void mix_norm_phase(Frame& F, CArgs& A, int l) {
    if (COMB) moe_block_starts(F, l - 1);
    const LAS int* mbs = (const LAS int*)(F.lds + UT_OFF + 256);
    const float* MOD = WSP(float, WS_MOD);
    const unsigned char* Y = WSP(unsigned char, WS_Y); const int* DEST = WSP(int, WS_DEST); const float* GATE = WSP(float, WS_GATE);
    bf16* H = WSP(bf16, WS_H); float* FLOG = WSP(float, WS_FLOG);
    f16* XR = WSP(f16, WS_XR);
    LAS float* G1 = (LAS float*)(F.lds + RING_OFF); LAS float* SH = G1 + 1024; LAS float* GF = G1 + 2048; LAS float* wfl = G1 + 3072;
    if (!FINAL) {
        const bf16* WRT = WSP(bf16, WS_WRT) + (size_t)l * 2 * NLOG * DM;
        for (int bb = F.c; bb < NB; bb += F.G) { const float* shf = MOD + ((size_t)l * NB + bb) * 6144 + 3 * 1024;
            for (int n = F.wave; n < NLOG; n += 8) { float sacc = 0.f;
#pragma unroll
                for (int j = 0; j < 4; ++j) { const int k = 4 * F.lane + 256 * j; const v2u wh = *(const GAS v2u*)(WRT + (size_t)n * DM + k), wl = *(const GAS v2u*)(WRT + (size_t)(NLOG + n) * DM + k); const f32x4 sf = *(const GAS f32x4*)(shf + k);
                    sacc += sf.x * (bflo(wh.x) + bflo(wl.x)) + sf.y * (bfhi(wh.x) + bfhi(wl.x)) + sf.z * (bflo(wh.y) + bflo(wl.y)) + sf.w * (bfhi(wh.y) + bfhi(wl.y)); }
                sacc = wave_sum(sacc, F.lane);
                if (F.lane == 0) WSP(float, WS_SHWB)[((size_t)l * NB + bb) * NLOG + n] = sacc + (n < 8 ? IN_rg_b[l * 8 + n] : (n < 72 ? IN_re_b[l * 64 + n - 8] : 0.f)); } }
    }
    for (int tile = F.c; tile < NTOK / 256; tile += F.G) {
        const int b = tile >> 3;
        __syncthreads();
        for (int k = F.tid; k < DM; k += 512) {
            if (FINAL) G1[k] = IN_g_fin[k];
            else { G1[k] = IN_g_mix[l * DM + k] * (1.f + MOD[((size_t)l * NB + b) * 6144 + 1024 + k]); SH[k] = MOD[((size_t)l * NB + b) * 6144 + k]; }
            if (COMB) GF[k] = MOD[((size_t)(l - 1) * NB + b) * 6144 + 5 * 1024 + k]; }
        if (!FINAL) for (int i = F.tid; i < 1024; i += 512) *(LAS f32x4*)(wfl + 4 * i) = *(const GAS f32x4*)(WSP(float, WS_WF) + (size_t)l * 4 * DM + 4 * i);
        __syncthreads();
        const size_t rowbase = (size_t)tile * 256 + F.wave * 32;
        unsigned r0v = 0u, r1v = 0u; float g0v = 0.f, g1v = 0.f;
        if (COMB && F.lane < 32) { const i32x4 d = *(const GAS i32x4*)(DEST + (rowbase + F.lane) * 4); const f32x2 gt = *(const GAS f32x2*)(GATE + (rowbase + F.lane) * 2);
            r0v = 256u * (unsigned)mbs[d.x] + (unsigned)d.y; r1v = 256u * (unsigned)mbs[d.z] + (unsigned)d.w; g0v = gt.x; g1v = gt.y; }
        struct RowBuf { f32x4 v[COMB ? 1 : 4]; f16x4 hx[COMB ? 4 : 1]; unsigned y0[COMB ? 4 : 1], y1[COMB ? 4 : 1]; float g0, g1; };
#define MN_LOAD(S, JR) do { const size_t row_ = rowbase + (JR); \
            if (COMB) { const size_t q0_ = (size_t)__builtin_amdgcn_readlane(r0v, (JR)), q1_ = (size_t)__builtin_amdgcn_readlane(r1v, (JR)); \
                S.g0 = __uint_as_float(__builtin_amdgcn_readlane(__float_as_uint(g0v), (JR))); S.g1 = __uint_as_float(__builtin_amdgcn_readlane(__float_as_uint(g1v), (JR))); \
                _Pragma("unroll") for (int j = 0; j < (COMB ? 4 : 0); ++j) { S.hx[j] = *(const GAS f16x4*)(XR + row_ * DM + 4 * F.lane + 256 * j); \
                    S.y0[j] = *(const GAS unsigned*)(Y + q0_ * DM + 4 * F.lane + 256 * j); S.y1[j] = *(const GAS unsigned*)(Y + q1_ * DM + 4 * F.lane + 256 * j); } } \
            else { _Pragma("unroll") for (int j = 0; j < (COMB ? 0 : 4); ++j) S.v[j] = *(const GAS f32x4*)(IN_x + row_ * DM + 4 * F.lane + 256 * j); } } while (0)
#define MN_COMPUTE(S, JR) do { const size_t row = rowbase + (JR); f32x4 v[4]; \
            if (COMB) { \
                _Pragma("unroll") for (int j = 0; j < (COMB ? 4 : 0); ++j) { const f32x4 gf4 = *(const LAS f32x4*)(GF + 4 * F.lane + 256 * j); \
                    const f32x2 a01 = __builtin_amdgcn_cvt_pk_f32_fp8((int)S.y0[j], false), a23 = __builtin_amdgcn_cvt_pk_f32_fp8((int)S.y0[j], true), b01 = __builtin_amdgcn_cvt_pk_f32_fp8((int)S.y1[j], false), b23 = __builtin_amdgcn_cvt_pk_f32_fp8((int)S.y1[j], true); \
                    f32x4 m; m.x = S.g0 * a01.x + S.g1 * b01.x; m.y = S.g0 * a01.y + S.g1 * b01.y; m.z = S.g0 * a23.x + S.g1 * b23.x; m.w = S.g0 * a23.y + S.g1 * b23.y; m = m * (1.f / Y8_SCALE); \
                    v[j] = (f32x4){(float)S.hx[j].x, (float)S.hx[j].y, (float)S.hx[j].z, (float)S.hx[j].w} + gf4 * m; } \
                if (!FINAL) { \
                    _Pragma("unroll") for (int j = 0; j < 4; ++j) { const f16x4 hx = (f16x4){(f16)v[j].x, (f16)v[j].y, (f16)v[j].z, (f16)v[j].w}; *(GAS f16x4*)(XR + row * DM + 4 * F.lane + 256 * j) = hx; v[j] = (f32x4){(float)hx.x, (float)hx.y, (float)hx.z, (float)hx.w}; } } \
            } else { _Pragma("unroll") for (int j = 0; j < (COMB ? 0 : 4); ++j) v[j] = S.v[j]; } \
            float ss = 0.f; \
            _Pragma("unroll") for (int j = 0; j < 4; ++j) ss += (v[j].x * v[j].x + v[j].y * v[j].y) + (v[j].z * v[j].z + v[j].w * v[j].w); \
            const float rs = 1.f / sqrtf(wave_sum(ss, F.lane) * (1.f / DM) + EPS); \
            if (FINAL) { \
                _Pragma("unroll") for (int j = 0; j < 4; ++j) __builtin_nontemporal_store(v[j] * rs * *(const LAS f32x4*)(G1 + 4 * F.lane + 256 * j), (GAS f32x4*)(F.out + row * DM + 4 * F.lane + 256 * j));     \
            } else { \
                float fl[4] = {0.f, 0.f, 0.f, 0.f}; \
                _Pragma("unroll") for (int j = 0; j < 4; ++j) { const f32x4 hh = (v[j] * rs) * *(const LAS f32x4*)(G1 + 4 * F.lane + 256 * j) + *(const LAS f32x4*)(SH + 4 * F.lane + 256 * j); \
                    v2u o; o.x = pk2(hh.x, hh.y); o.y = pk2(hh.z, hh.w); \
                    *(GAS v2u*)(H + row * DM + 4 * F.lane + 256 * j) = o; \
                    _Pragma("unroll") for (int q = 0; q < 4; ++q) { const f32x4 w4 = *(const LAS f32x4*)(wfl + q * DM + 4 * F.lane + 256 * j); fl[q] += (hh.x * w4.x + hh.y * w4.y) + (hh.z * w4.z + hh.w * w4.w); } } \
                _Pragma("unroll") for (int q = 0; q < 4; ++q) fl[q] = wave_sum(fl[q], F.lane); \
                if (F.lane == 0) *(GAS f32x4*)(FLOG + row * 4) = (f32x4){fl[0], fl[1], fl[2], fl[3]}; \
            } } while (0)
        RowBuf RA, RB, RC;
        MN_LOAD(RA, 0); MN_LOAD(RB, 1);
        for (int jr = 0; jr < 30; jr += 3) {
            MN_LOAD(RC, jr + 2);
            MN_COMPUTE(RA, jr);
            MN_LOAD(RA, jr + 3);
            MN_COMPUTE(RB, jr + 1);
            MN_LOAD(RB, jr + 4);
            MN_COMPUTE(RC, jr + 2);
        }
        MN_COMPUTE(RA, 30); MN_COMPUTE(RB, 31);
#undef MN_LOAD
#undef MN_COMPUTE
    }
}

__device__ __forceinline__ v4u widen_pair(const v2u x, const v2u y) {
    auto r0 = __builtin_amdgcn_permlane32_swap(x.x, y.x, false, false); auto r1 = __builtin_amdgcn_permlane32_swap(x.y, y.y, false, false);
    v4u o; o.x = r0[0]; o.y = r1[0]; o.z = r0[1]; o.w = r1[1]; return o;
}
struct EpiStoreBf16 {
    static constexpr bool PERM = true, PERMW = false;
    bf16* O; int ldc; int pn_mask;
    __device__ __forceinline__ void operator()(const f32x4 (&acc)[2][2][4][2], const pg8::Unit& u, int wr, int wc, int fr, int fq) const {
        const size_t row0 = (size_t)u.pm * 256 + wr * 64 + fr; const int col0 = (u.pn & pn_mask) * 256 + wc * 32 + 8 * fq;
#pragma unroll
        for (int ai = 0; ai < 2; ++ai)
#pragma unroll
            for (int m = 0; m < 4; ++m) { bf16* rowp = O + (row0 + ai * 128 + m * 16) * ldc + col0;
#pragma unroll
                for (int bj = 0; bj < 2; ++bj) { const f32x4 v0 = acc[ai][bj][m][0], v1 = acc[ai][bj][m][1]; v4u w;
                    w.x = pg8::cvt_pk_bf16(v0[0], v0[1]); w.y = pg8::cvt_pk_bf16(v0[2], v0[3]); w.z = pg8::cvt_pk_bf16(v1[0], v1[1]); w.w = pg8::cvt_pk_bf16(v1[2], v1[3]);
                    *(GAS v4u*)(rowp + bj * 128) = w; } }
    }
};
struct EpiStoreFp8 {
    static constexpr bool PERM = true, PERMW = true;
    unsigned char* O; int ldc; int pn_mask; float scale;
    __device__ __forceinline__ void operator()(const f32x4 (&acc)[2][2][4][2], const pg8::Unit& u, int wr, int wc, int fr, int fq) const {
        const int hi32 = fq >> 1, g0 = (fq & 1) << 1;
        const size_t row0 = (size_t)u.pm * 256 + wr * 64 + fr + 16 * hi32; const int col0 = (u.pn & pn_mask) * 256 + wc * 32 + 8 * g0;
#pragma unroll
        for (int ai = 0; ai < 2; ++ai)
#pragma unroll
            for (int mp = 0; mp < 2; ++mp) { unsigned char* rowp = O + (row0 + ai * 128 + mp * 32) * ldc + col0;
#pragma unroll
                for (int bj = 0; bj < 2; ++bj) { const f32x4 a0 = acc[ai][bj][2 * mp][0] * scale, a1 = acc[ai][bj][2 * mp][1] * scale, b0 = acc[ai][bj][2 * mp + 1][0] * scale, b1 = acc[ai][bj][2 * mp + 1][1] * scale;
                    *(GAS v4u*)(rowp + bj * 128) = widen_pair(pack_fp8x8(a0[0], a0[1], a0[2], a0[3], a1[0], a1[1], a1[2], a1[3]), pack_fp8x8(b0[0], b0[1], b0[2], b0[3], b1[0], b1[1], b1[2], b1[3])); } }
    }
};
struct EpiOut {
    static constexpr bool PERM = true, PERMW = false;
    const float* xin32; const f16* xin16; f16* xout; const float* gm; float* SS;
    __device__ __forceinline__ void operator()(const f32x4 (&acc)[2][2][4][2], const pg8::Unit& u, int wr, int wc, int fr, int fq) const {
        const size_t row0 = (size_t)u.pm * 256 + wr * 64 + fr; const int col0 = u.pn * 256 + wc * 32 + 8 * fq; const int b = u.pm >> 3; const int lane = fq * 16 + fr;
        f32x4 gvv[2][2];
#pragma unroll
        for (int bj = 0; bj < 2; ++bj)
#pragma unroll
            for (int n = 0; n < 2; ++n) gvv[bj][n] = *(const GAS f32x4*)(gm + (size_t)b * 6144 + col0 + bj * 128 + n * 4);
#pragma unroll
        for (int ai = 0; ai < 2; ++ai)
#pragma unroll
            for (int m = 0; m < 4; ++m) { const size_t ro = (row0 + ai * 128 + m * 16) * DM + col0; float ss = 0.f;
#pragma unroll
                for (int bj = 0; bj < 2; ++bj) { f32x4 x0, x1;
                    if (xin32) { x0 = *(const GAS f32x4*)(xin32 + ro + bj * 128); x1 = *(const GAS f32x4*)(xin32 + ro + bj * 128 + 4); }
                    else { const f16x8 hx = *(const GAS f16x8*)(xin16 + ro + bj * 128); x0 = (f32x4){(float)hx[0], (float)hx[1], (float)hx[2], (float)hx[3]}; x1 = (f32x4){(float)hx[4], (float)hx[5], (float)hx[6], (float)hx[7]}; }
                    x0 = x0 + gvv[bj][0] * acc[ai][bj][m][0]; x1 = x1 + gvv[bj][1] * acc[ai][bj][m][1];
                    const f16x8 ho = (f16x8){(f16)x0.x, (f16)x0.y, (f16)x0.z, (f16)x0.w, (f16)x1.x, (f16)x1.y, (f16)x1.z, (f16)x1.w};
                    *(GAS f16x8*)(xout + ro + bj * 128) = ho;
#pragma unroll
                    for (int i = 0; i < 8; ++i) { const float q = (float)ho[i]; ss += q * q; } }
                ss += shx(ss, 16, lane); ss += shx(ss, 32, lane);
                if (fq == 0) SS[(row0 + ai * 128 + m * 16) * 16 + u.pn * 4 + wc] = ss; }
    }
};
struct EpiGateUp {
    static constexpr bool PERM = true, PERMW = true;
    unsigned char* O;
    __device__ __forceinline__ void operator()(const f32x4 (&acc)[2][2][4][2], const pg8::Unit& u, int wr, int wc, int fr, int fq) const {
        const int hi32 = fq >> 1, g0 = (fq & 1) << 1;
        const size_t row0 = (size_t)u.pm * 256 + wr * 64 + fr + 16 * hi32; const int col0 = (u.pn & 3) * 128 + wc * 32 + 8 * g0;
#pragma unroll
        for (int ai = 0; ai < 2; ++ai)
#pragma unroll
            for (int mp = 0; mp < 2; ++mp) { float ha[8], hb[8];
#pragma unroll
                for (int n = 0; n < 2; ++n)
#pragma unroll
                    for (int i = 0; i < 4; ++i) { ha[4 * n + i] = silu_f(acc[ai][0][2 * mp][n][i]) * acc[ai][1][2 * mp][n][i] * HID8_SCALE; hb[4 * n + i] = silu_f(acc[ai][0][2 * mp + 1][n][i]) * acc[ai][1][2 * mp + 1][n][i] * HID8_SCALE; }
                *(GAS v4u*)(O + (row0 + ai * 128 + mp * 32) * DEXP + col0) = widen_pair(pack_fp8x8(ha[0], ha[1], ha[2], ha[3], ha[4], ha[5], ha[6], ha[7]), pack_fp8x8(hb[0], hb[1], hb[2], hb[3], hb[4], hb[5], hb[6], hb[7])); }
    }
};

__device__ __forceinline__ void mla_up_phase(Frame& F, CArgs& A, int l) {
    bf16* PROJ = WSP(bf16, WS_PROJ);
    {
        for (int tok = F.c * 512 + F.tid; tok < NTOK; tok += F.G * 512) {
            GAS v4u* p = (GAS v4u*)(PROJ + (size_t)tok * PN + PC_KROPE);
            v4u w[4]; float t[32], o[32];
#pragma unroll
            for (int i = 0; i < 4; ++i) w[i] = p[i];
#pragma unroll
            for (int i = 0; i < 4; ++i) { t[8 * i] = bflo(w[i].x); t[8 * i + 1] = bfhi(w[i].x); t[8 * i + 2] = bflo(w[i].y); t[8 * i + 3] = bfhi(w[i].y); t[8 * i + 4] = bflo(w[i].z); t[8 * i + 5] = bfhi(w[i].z); t[8 * i + 6] = bflo(w[i].w); t[8 * i + 7] = bfhi(w[i].w); }
            const float posf = (float)IN_pos[tok];
#pragma unroll
            for (int i = 0; i < 16; ++i) { float c, s; rope_cs(posf, rope_rev(i), c, s);
                const int p1 = 8 * (i >> 2) + (i & 3), p2 = p1 + 4;
                o[p1] = t[i] * c - t[i + 16] * s; o[p2] = t[i + 16] * c + t[i] * s; }
#pragma unroll
            for (int i = 0; i < 4; ++i) { v4u q; q.x = pk2(o[8 * i], o[8 * i + 1]); q.y = pk2(o[8 * i + 2], o[8 * i + 3]); q.z = pk2(o[8 * i + 4], o[8 * i + 5]); q.w = pk2(o[8 * i + 6], o[8 * i + 7]); p[i] = q; }
        }
    }
    {
        const float* FLOG = WSP(float, WS_FLOG); float* FB = WSP(float, WS_FB);
        LAS float* wt = (LAS float*)(F.lds + RING_OFF);
        for (int bh = F.c; bh < NB * 4; bh += F.G) {
            const int b = bh >> 2, h = bh & 3; const float fb = IN_fb[l * 4 + h];
            float v[4]; float run = 0.f;
#pragma unroll
            for (int j = 0; j < 4; ++j) { const float xx = FLOG[((size_t)b * SEQ + 4 * F.tid + j) * 4 + h] + fb; const float ls = fminf(xx, 0.f) - log1pf(expf(-fabsf(xx))); run += ls; v[j] = run; }
            float inc = run;
#pragma unroll
            for (int o = 1; o < 64; o <<= 1) { const float n = __builtin_bit_cast(float, __builtin_amdgcn_ds_bpermute((F.lane - o) << 2, __builtin_bit_cast(int, inc))); if (F.lane >= o) inc += n; }
            if (F.lane == 63) wt[F.wave] = inc;
            __syncthreads();
            float base = inc - run;
            for (int w = 0; w < F.wave; ++w) base += wt[w];
#pragma unroll
            for (int j = 0; j < 4; ++j) FB[((size_t)b * 4 + h) * SEQ + 4 * F.tid + j] = -LOG2E * (base + v[j]);
            __syncthreads();
        }
    }
    for (int pm = F.c; pm < NTOK / 256; pm += F.G) {
        {
            const bool isq = F.lane < 24, iskv = (F.lane >= 32 && F.lane < 48), act = isq || iskv;
            const size_t coff = isq ? 8 * F.lane : PC_CKV + 8 * (F.lane & 15);
            GAS v4u* p0 = (GAS v4u*)(PROJ + ((size_t)pm * 256 + F.wave * 32) * PN + coff);
            v4u w[32];
#pragma unroll
            for (int jr = 0; jr < 32; ++jr) w[jr] = act ? *(p0 + (size_t)jr * (PN / 8)) : (v4u){0u, 0u, 0u, 0u};
#pragma unroll
            for (int jr = 0; jr < 32; ++jr) {
                const float a0 = bflo(w[jr].x), a1 = bfhi(w[jr].x), a2 = bflo(w[jr].y), a3 = bfhi(w[jr].y), a4 = bflo(w[jr].z), a5 = bfhi(w[jr].z), a6 = bflo(w[jr].w), a7 = bfhi(w[jr].w);
                float ss = (a0 * a0 + a1 * a1) + (a2 * a2 + a3 * a3) + (a4 * a4 + a5 * a5) + (a6 * a6 + a7 * a7);
                ss += shx(ss, 1, F.lane); ss += shx(ss, 2, F.lane); ss += shx(ss, 4, F.lane); ss += shx(ss, 8, F.lane); ss += shx(ss, 16, F.lane);
                const float rs = isq ? 1.f / sqrtf(ss * (1.f / 192.f) + EPS) : 1.f / sqrtf(ss * (1.f / 128.f) + EPS);
                if (act) { v4u o; o.x = pk2(a0 * rs, a1 * rs); o.y = pk2(a2 * rs, a3 * rs); o.z = pk2(a4 * rs, a5 * rs); o.w = pk2(a6 * rs, a7 * rs); *(p0 + (size_t)jr * (PN / 8)) = o; } }
        }
        VM_WAIT();
        __syncthreads();
        for (int part = 0; part < 2; ++part) {
            int po = part; asm volatile("" : "+s"(po));
            const int kof = po * 256, nof = po * 512;
            pg8::Gemm g{PROJ + kof, WSP(bf16, WS_WUP) + (size_t)l * NUP * KUP + (size_t)nof * KUP + kof, 256 - 128 * po, PN, 0, KUP};
            int nn2 = 2; asm volatile("" : "+s"(nn2));
            pg8::PanelOrder S{pm, nn2};
            EpiStoreBf16 E{WSP(bf16, WS_MLA) + nof, 1024, 0xffff};
            pg8::gemm_phase<EpiStoreBf16, pg8::PanelOrder, true, false>(F.lds + RING_OFF, g, S, E, F.tid);
            __syncthreads();
        }
    }
}

__device__ __forceinline__ int crow(int r, int hi) { return (r & 3) + 8 * (r >> 2) + 4 * hi; }
typedef short v4i16_t __attribute__((ext_vector_type(4)));
__device__ __forceinline__ s16x4 vtr(const LAS unsigned char* p) { return __builtin_bit_cast(s16x4, __builtin_amdgcn_ds_read_tr16_b64_v4i16((LAS v4i16_t*)p)); }
__device__ __forceinline__ float half_swap_max(float m) { auto rr = __builtin_amdgcn_permlane32_swap(__float_as_uint(m), __float_as_uint(m), false, false); return fmaxf(__uint_as_float(rr[0]), __uint_as_float(rr[1])); }
__device__ __forceinline__ float half_swap_sum(float m) { auto rr = __builtin_amdgcn_permlane32_swap(__float_as_uint(m), __float_as_uint(m), false, false); return __uint_as_float(rr[0]) + __uint_as_float(rr[1]); }
__device__ __forceinline__ bf16x8 pack8(const f32x16& p, int b0) {
    v4u w; w.x = pg8::cvt_pk_bf16(p[b0], p[b0 + 1]); w.y = pg8::cvt_pk_bf16(p[b0 + 2], p[b0 + 3]); w.z = pg8::cvt_pk_bf16(p[b0 + 4], p[b0 + 5]); w.w = pg8::cvt_pk_bf16(p[b0 + 6], p[b0 + 7]);
    return __builtin_bit_cast(bf16x8, w);
}
__device__ __forceinline__ void softmax_tile(f32x16& p0, f32x16& p1, float& m, float& lsum, f32x16& negm, const float cbase, f32x16& o0, f32x16& o1, const bool first) {
    float a = fmaxf(fmaxf(p0[0], p0[1]), p1[0]), b = fmaxf(fmaxf(p0[2], p0[3]), p1[1]); a = fmaxf(fmaxf(a, p1[2]), p1[3]);
#pragma unroll
    for (int r = 4; r < 16; r += 4) { a = fmaxf(fmaxf(a, p0[r]), p0[r + 1]); b = fmaxf(fmaxf(b, p0[r + 2]), p0[r + 3]); a = fmaxf(fmaxf(a, p1[r]), p1[r + 1]); b = fmaxf(fmaxf(b, p1[r + 2]), p1[r + 3]); }
    const float rm = half_swap_max(fmaxf(a, b));
    if (first || __any(rm > 8.f)) {
        const float dl = first ? rm : fmaxf(rm, 0.f); m += dl;
#pragma unroll
        for (int r = 0; r < 16; ++r) { p0[r] -= dl; p1[r] -= dl; negm[r] = cbase - m; }
        if (!first) { const float f = fast_exp2(-dl); lsum *= f;
#pragma unroll
            for (int r = 0; r < 16; ++r) { o0[r] *= f; o1[r] *= f; } }
    }
    float s0 = 0.f, s1 = 0.f;
#pragma unroll
    for (int r = 0; r < 16; ++r) { p0[r] = fast_exp2(p0[r]); p1[r] = fast_exp2(p1[r]); s0 += p0[r]; s1 += p1[r]; }
    lsum += s0 + s1;
}

constexpr int AT_KB = 16384, AT_VB = 8192, AT_TBL = 2 * AT_KB + 3 * AT_VB;

template <int MODE>
__device__ __forceinline__ void attn_unit(Frame& F, CArgs& A, int l, int b, int h, int qb) {
    const int tid = F.tid, lane = F.lane, wid = F.wave, r32 = lane & 31, hi = lane >> 5;
    constexpr int ND0 = (MODE == 0) ? 6 : (MODE == 1 ? 4 : 2);
    LAS unsigned char* kb0 = F.lds + RING_OFF; LAS unsigned char* vb0 = F.lds + RING_OFF + 2 * AT_KB; LAS float* tbl = (LAS float*)(F.lds + RING_OFF + AT_TBL);
    const size_t rowbase = (size_t)b * SEQ; const int q0 = qb * 256, NT = 4 * qb + 4, tw = 4 * qb + (wid >> 1), qw0 = q0 + 32 * wid;
    const bf16* PROJ = WSP(bf16, WS_PROJ); const bf16* MLA = WSP(bf16, WS_MLA);
    const bf16* Qp; const bf16* Kp; const bf16* Vp; int pitch;
    if (MODE == 0) { Qp = MLA + h * 96; Kp = MLA + 512 + h * 128; Vp = Kp + 64; pitch = 1024; }
    else if (MODE == 1) { Qp = PROJ + PC_FOX + h * 64; Kp = Qp + 256; Vp = Qp + 512; pitch = PN; }
    else { Qp = PROJ + PC_DIFF + h * 64; Kp = Qp + 256; Vp = Qp + 512; pitch = PN; }
    const int kkey = 8 * wid + (lane >> 3);
    const GAS bf16* ksrc = (const GAS bf16*)(Kp + (rowbase + kkey) * pitch + (((lane & 7) ^ ((kkey >> 1) & 7)) * 8));
    const int vkey = 8 * wid + (lane >> 3);
    const GAS bf16* vsrc = (const GAS bf16*)(Vp + (rowbase + vkey) * pitch + ((((lane & 7) >> 2) ^ ((vkey >> 1) & 1)) * 32) + (lane & 3) * 8);
    const int rkey = 16 * (wid & 3) + (lane >> 2);
    const GAS bf16* ksrc2 = (const GAS bf16*)(PROJ + (rowbase + rkey) * PN + PC_KROPE + (((lane & 3) ^ ((rkey >> 2) & 3)) * 8));
#define AT_DMA(t, kbo, vso) do { \
        __builtin_amdgcn_global_load_lds((const GAS unsigned*)(ksrc + (size_t)(t) * 64 * pitch), (LAS unsigned*)(kb0 + (kbo) + wid * 1024), 16, 0, 0); \
        __builtin_amdgcn_global_load_lds((const GAS unsigned*)(vsrc + (size_t)(t) * 64 * pitch), (LAS unsigned*)(vb0 + (vso) + wid * 1024), 16, 0, 0); \
        if (MODE == 0 && wid < 4) __builtin_amdgcn_global_load_lds((const GAS unsigned*)(ksrc2 + (size_t)(t) * 64 * PN), (LAS unsigned*)(kb0 + (kbo) + (8 + wid) * 1024), 16, 0, 0); } while (0)
    AT_DMA(0, 0, 0);
    if (MODE == 1) { const float* FBp = WSP(float, WS_FB) + ((size_t)b * 4 + h) * SEQ; if (4 * tid < NT * 64) *(LAS f32x4*)(tbl + 4 * tid) = *(const GAS f32x4*)(FBp + 4 * tid); }
    if (MODE == 2) { const float* T5p = WSP(float, WS_T5) + h * 2112; const float c0 = T5p[0]; for (int i = tid; i < 528; i += 512) *(LAS f32x4*)(tbl + 4 * i) = *(const GAS f32x4*)(T5p + 4 * i) - c0; }
    bf16x8 qf[(MODE == 2) ? 4 : ND0];
    { const bf16* Qw = Qp + (rowbase + qw0 + r32) * pitch + hi * 8;
#pragma unroll
      for (int d = 0; d < ((MODE == 2) ? 4 : ND0); ++d) qf[d] = *(const GAS bf16x8*)(Qw + d * 16); }
    if (MODE == 0) {
        const float posf = (float)IN_pos[rowbase + qw0 + r32];
#pragma unroll
        for (int j = 0; j < 2; ++j) { const v4u w = __builtin_bit_cast(v4u, qf[(MODE == 0) ? 4 + j : 0]);
            float t1[4] = {bflo(w.x), bfhi(w.x), bflo(w.y), bfhi(w.y)}, t2[4] = {bflo(w.z), bfhi(w.z), bflo(w.w), bfhi(w.w)};
#pragma unroll
            for (int i = 0; i < 4; ++i) { float c, s; rope_cs(posf, hi ? rope_rev(4 * (2 * j + 1) + i) : rope_rev(4 * (2 * j) + i), c, s); const float a = t1[i], bb = t2[i]; t1[i] = a * c - bb * s; t2[i] = bb * c + a * s; }
            v4u o; o.x = pk2(t1[0], t1[1]); o.y = pk2(t1[2], t1[3]); o.z = pk2(t2[0], t2[1]); o.w = pk2(t2[2], t2[3]);
            qf[(MODE == 0) ? 4 + j : 0] = __builtin_bit_cast(bf16x8, o); }
    }
    float m1 = 0.f, l1 = 0.f, m2 = 0.f, l2 = 0.f; f32x16 o1[2], o2[2], negm1;
    const float cbase = (MODE == 2) ? WSP(float, WS_T5)[h * 2112] : 0.f;
#pragma unroll
    for (int r = 0; r < 16; ++r) { o1[0][r] = 0.f; o1[1][r] = 0.f; o2[0][r] = 0.f; o2[1][r] = 0.f; negm1[r] = cbase; }
    const int vlane = ((lane >> 4) & 1) * 32 + (lane & 3) * 8 + (4 * hi + ((lane & 15) >> 2)) * 128 + ((lane >> 3) & 1) * 64;
    VM_WAIT();
    __syncthreads();
    const bool lag = false;
    bf16x8 dpa0, dpa1, dpa2, dpa3;
    dpa0 = dpa1 = dpa2 = dpa3 = (bf16x8){0, 0, 0, 0, 0, 0, 0, 0};
    const int vx64 = (vlane ^ 64) - vlane;
#define AT_PV(O, VB, A0, A1, A2, A3) do { bf16x8 vf[2][4]; \
        _Pragma("unroll") for (int d0 = 0; d0 < 2; ++d0) _Pragma("unroll") for (int ks = 0; ks < 4; ++ks) { const LAS unsigned char* vp_ = (VB) + (d0 ? vx64 : 0) + ks * 2048; const s16x4 lo = vtr(vp_), hh = vtr(vp_ + 1024); \
            vf[d0][ks] = (bf16x8){lo[0], lo[1], lo[2], lo[3], hh[0], hh[1], hh[2], hh[3]}; } \
        _Pragma("unroll") for (int d0 = 0; d0 < 2; ++d0) { O[d0] = __builtin_amdgcn_mfma_f32_32x32x16_bf16(vf[d0][0], A0, O[d0], 0, 0, 0); O[d0] = __builtin_amdgcn_mfma_f32_32x32x16_bf16(vf[d0][1], A1, O[d0], 0, 0, 0); \
            O[d0] = __builtin_amdgcn_mfma_f32_32x32x16_bf16(vf[d0][2], A2, O[d0], 0, 0, 0); O[d0] = __builtin_amdgcn_mfma_f32_32x32x16_bf16(vf[d0][3], A3, O[d0], 0, 0, 0); } } while (0)
    int vs_prev = 0, vs_cur = 0, vs_next = AT_VB;
    for (int t = 0; t < NT; ++t) {
        if (t + 1 < NT) AT_DMA(t + 1, ((t + 1) & 1) * AT_KB, vs_next);
        if (lag && t >= 1 && t - 1 <= tw) { const LAS unsigned char* vbp = vb0 + vs_prev + vlane; if (MODE == 2) AT_PV(o2, vbp, dpa0, dpa1, dpa2, dpa3); else AT_PV(o1, vbp, dpa0, dpa1, dpa2, dpa3); }
        if (t <= tw) {
            const LAS unsigned char* kb = kb0 + (t & 1) * AT_KB; const LAS unsigned char* vb = vb0 + vs_cur + vlane;
#pragma unroll
            for (int mp = 0; mp < ((MODE == 2) ? 2 : 1); ++mp) {
                f32x16 p0, p1, nmt;
                if (MODE == 2) { const float nv = cbase - (mp == 0 ? m1 : m2);
#pragma unroll
                    for (int r = 0; r < 16; ++r) nmt[r] = nv; }
#pragma unroll
                for (int d0 = 0; d0 < ND0; ++d0) { const int c = 2 * d0 + hi + ((MODE == 2) ? 4 * mp : 0);
                    const bool rope_ = (MODE == 0) && d0 >= 4;
                    const LAS unsigned char* ka = rope_ ? kb + 8192 + r32 * 64 + ((((c - 8) & 3) ^ ((r32 >> 2) & 3)) * 16) : kb + r32 * 128 + ((c ^ ((r32 >> 1) & 7)) * 16);
                    const bf16x8 k0 = *(const LAS bf16x8*)ka, k1 = *(const LAS bf16x8*)(ka + (rope_ ? 2048 : 4096));
                    if (d0 == 0) { p0 = __builtin_amdgcn_mfma_f32_32x32x16_bf16(k0, qf[(MODE == 2) ? 2 * mp + d0 : d0], (MODE == 2) ? nmt : negm1, 0, 0, 0);
                                   p1 = __builtin_amdgcn_mfma_f32_32x32x16_bf16(k1, qf[(MODE == 2) ? 2 * mp + d0 : d0], (MODE == 2) ? nmt : negm1, 0, 0, 0); }
                    else { p0 = __builtin_amdgcn_mfma_f32_32x32x16_bf16(k0, qf[(MODE == 2) ? 2 * mp + d0 : d0], p0, 0, 0, 0);
                           p1 = __builtin_amdgcn_mfma_f32_32x32x16_bf16(k1, qf[(MODE == 2) ? 2 * mp + d0 : d0], p1, 0, 0, 0); } }
                if (MODE == 1) {
#pragma unroll
                    for (int g4 = 0; g4 < 4; ++g4) { const f32x4 a = *(const LAS f32x4*)(tbl + 64 * t + 8 * g4 + 4 * hi), c = *(const LAS f32x4*)(tbl + 64 * t + 32 + 8 * g4 + 4 * hi);
                        p0[4 * g4] += a.x; p0[4 * g4 + 1] += a.y; p0[4 * g4 + 2] += a.z; p0[4 * g4 + 3] += a.w; p1[4 * g4] += c.x; p1[4 * g4 + 1] += c.y; p1[4 * g4 + 2] += c.z; p1[4 * g4 + 3] += c.w; }
                    if (t == tw) {
                        const int ql = 32 * (wid & 1) + r32;
#pragma unroll
                        for (int r = 0; r < 16; ++r) { const int kl = crow(r, hi); if (kl > ql) p0[r] = -1e30f; if (kl + 32 > ql) p1[r] = -1e30f; } }
                }
                if (MODE == 2 && 64 * t + 191 > qw0) {
                    const LAS float* tp = tbl + (64 * t - (qw0 + r32) + 2047 + 4 * hi);
#pragma unroll
                    for (int r = 0; r < 16; ++r) { p0[r] += tp[(r & 3) + 8 * (r >> 2)]; p1[r] += tp[32 + (r & 3) + 8 * (r >> 2)]; }
                }
                if (MODE == 2) { if (mp == 0) softmax_tile(p0, p1, m1, l1, nmt, cbase, o1[0], o1[1], t == 0); else softmax_tile(p0, p1, m2, l2, nmt, cbase, o2[0], o2[1], t == 0); }
                else softmax_tile(p0, p1, m1, l1, negm1, cbase, o1[0], o1[1], t == 0);
                const bf16x8 pa0 = pack8(p0, 0), pa1 = pack8(p0, 8), pa2 = pack8(p1, 0), pa3 = pack8(p1, 8);
                const bool lastmap = (mp == ((MODE == 2) ? 1 : 0));
                if (lastmap && lag) { dpa0 = pa0; dpa1 = pa1; dpa2 = pa2; dpa3 = pa3; }
                else { if (MODE == 2 && mp == 1) AT_PV(o2, vb, pa0, pa1, pa2, pa3); else AT_PV(o1, vb, pa0, pa1, pa2, pa3); }
            }
        }
        VM_WAIT();
        __syncthreads();
        vs_prev = vs_cur; vs_cur = vs_next; vs_next = (vs_next == 2 * AT_VB) ? 0 : vs_next + AT_VB;
    }
    if (lag && NT - 1 <= tw) { const LAS unsigned char* vbp = vb0 + vs_prev + vlane; if (MODE == 2) AT_PV(o2, vbp, dpa0, dpa1, dpa2, dpa3); else AT_PV(o1, vbp, dpa0, dpa1, dpa2, dpa3); }
    __syncthreads();
#undef AT_PV
#undef AT_DMA
    unsigned char* MIX = WSP(unsigned char, WS_MIX);
    const float inv1 = 1.f / half_swap_sum(l1);
    unsigned char* orow = MIX + (rowbase + qw0 + r32) * DM + ((MODE == 0) ? h * 64 : (MODE == 1) ? 256 + h * 64 : 768 + h * 64) + 8 * hi;
#define AT_ST8(V0, V1, V2, V3, V4, V5, V6, V7, DST) do { int wa_ = __builtin_amdgcn_cvt_pk_fp8_f32(clamp8(V0), clamp8(V1), 0, false); wa_ = __builtin_amdgcn_cvt_pk_fp8_f32(clamp8(V2), clamp8(V3), wa_, true); \
        int wb_ = __builtin_amdgcn_cvt_pk_fp8_f32(clamp8(V4), clamp8(V5), 0, false); wb_ = __builtin_amdgcn_cvt_pk_fp8_f32(clamp8(V6), clamp8(V7), wb_, true); \
        auto rr_ = __builtin_amdgcn_permlane32_swap((unsigned)wa_, (unsigned)wb_, false, false); v2u st_; st_.x = rr_[0]; st_.y = rr_[1]; *(GAS v2u*)(DST) = st_; } while (0)
    if (MODE != 2) {
        const float sc = inv1 * MIX8_SCALE;
#pragma unroll
        for (int d0 = 0; d0 < 2; ++d0)
#pragma unroll
            for (int j = 0; j < 4; j += 2)
                AT_ST8(o1[d0][4 * j] * sc, o1[d0][4 * j + 1] * sc, o1[d0][4 * j + 2] * sc, o1[d0][4 * j + 3] * sc, o1[d0][4 * j + 4] * sc, o1[d0][4 * j + 5] * sc, o1[d0][4 * j + 6] * sc, o1[d0][4 * j + 7] * sc, orow + 32 * d0 + 8 * j);
    } else {
        const float inv2 = 1.f / half_swap_sum(l2); const float lam = WSP(float, WS_LAM)[l]; const float li = 0.8f - 0.6f * expf(-0.3f * (float)l);
        const float c2 = lam * inv2; float ss = 0.f;
#pragma unroll
        for (int d0 = 0; d0 < 2; ++d0)
#pragma unroll
            for (int r = 0; r < 16; ++r) { const float v = o1[d0][r] * inv1 - o2[d0][r] * c2; o1[d0][r] = v; ss += v * v; }
        const float rsn = (1.f - li) / sqrtf(half_swap_sum(ss) * (1.f / 64.f) + EPS) * MIX8_SCALE;
        const float* sg = IN_subln + l * 64 + 4 * hi;
#pragma unroll
        for (int d0 = 0; d0 < 2; ++d0)
#pragma unroll
            for (int j = 0; j < 4; j += 2) { const f32x4 g4 = *(const GAS f32x4*)(sg + 32 * d0 + 8 * j), h4 = *(const GAS f32x4*)(sg + 32 * d0 + 8 * j + 8);
                AT_ST8(o1[d0][4 * j] * rsn * g4.x, o1[d0][4 * j + 1] * rsn * g4.y, o1[d0][4 * j + 2] * rsn * g4.z, o1[d0][4 * j + 3] * rsn * g4.w,
                       o1[d0][4 * j + 4] * rsn * h4.x, o1[d0][4 * j + 5] * rsn * h4.y, o1[d0][4 * j + 6] * rsn * h4.z, o1[d0][4 * j + 7] * rsn * h4.w, orow + 32 * d0 + 8 * j); }
    }
#undef AT_ST8
}

__device__ __forceinline__ void conv_unit(Frame& F, CArgs& A, int l, int tile) {
    const bf16* PROJ = WSP(bf16, WS_PROJ); unsigned char* MIX = WSP(unsigned char, WS_MIX);
    const int c8 = (F.tid & 31) * 8, rsub = F.tid >> 5;
    float w0[8], w1[8], w2[8];
#pragma unroll
    for (int i = 0; i < 8; ++i) { w0[i] = IN_conv_w[(l * 3 + 0) * 256 + c8 + i]; w1[i] = IN_conv_w[(l * 3 + 1) * 256 + c8 + i]; w2[i] = IN_conv_w[(l * 3 + 2) * 256 + c8 + i]; }
    for (int j = 0; j < 16; ++j) {
        const size_t row = (size_t)tile * 256 + rsub + 16 * j; const int s = (int)(row & (SEQ - 1));
        const bf16* pr = PROJ + row * PN + PC_CONV + c8;
        const v4u bb = *(const GAS v4u*)pr, c0 = *(const GAS v4u*)(pr + 256), u0 = *(const GAS v4u*)(pr + 512);
        v4u c1 = (v4u){0u, 0u, 0u, 0u}, u1 = c1, c2 = c1, u2 = c1;
        if (s >= 1) { c1 = *(const GAS v4u*)(pr - PN + 256); u1 = *(const GAS v4u*)(pr - PN + 512); }
        if (s >= 2) { c2 = *(const GAS v4u*)(pr - 2 * PN + 256); u2 = *(const GAS v4u*)(pr - 2 * PN + 512); }
        float o[8];
#define CV(i, W, sel) { const float z0 = sel(c0.W) * sel(u0.W), z1 = sel(c1.W) * sel(u1.W), z2 = sel(c2.W) * sel(u2.W); o[i] = sel(bb.W) * (w2[i] * z0 + w1[i] * z1 + w0[i] * z2); }
        CV(0, x, bflo) CV(1, x, bfhi) CV(2, y, bflo) CV(3, y, bfhi) CV(4, z, bflo) CV(5, z, bfhi) CV(6, w, bflo) CV(7, w, bfhi)
#undef CV
        *(GAS v2u*)(MIX + row * DM + 512 + c8) = pack_fp8x8(o[0] * MIX8_SCALE, o[1] * MIX8_SCALE, o[2] * MIX8_SCALE, o[3] * MIX8_SCALE, o[4] * MIX8_SCALE, o[5] * MIX8_SCALE, o[6] * MIX8_SCALE, o[7] * MIX8_SCALE);
    }
}

#define CONV_ROUND() do { { if (F.tid == 0) F.MISC[1] = __hip_atomic_fetch_add(F.ctl + CW_Q + 64 * l + 48, 8u, RLX_AGENT); __syncthreads(); const int it_ = (int)F.MISC[1] + F.wave; __syncthreads(); \
        if (it_ < cvn) { Frame F2 = F; F2.lane = opq(F.lane); int w2_ = F.wave; asm volatile("" : "+s"(w2_)); const bool moe_ = it_ < CV_MOE; convert_item(F2, A, moe_ ? l : l + 1, moe_ ? CV_DENSE + it_ : it_ - CV_MOE, (LAS float*)(F.lds + RING_OFF) + w2_ * (64 * 65)); } __syncthreads(); } } while (0)
#define ATTN_LOOP(TYPE, MODE_, EXTRA) for (int qx_ = 0; qx_ < 8; ) { const int xq_ = (myx + qx_) & 7; \
        if (F.tid == 0) F.MISC[0] = __hip_atomic_fetch_add(F.ctl + CW_QX + (((l * 3 + (TYPE)) * 8 + xq_) << 4), 1u, RLX_AGENT); \
        __syncthreads(); const int idx = __builtin_amdgcn_readfirstlane((int)F.MISC[0]); __syncthreads(); \
        if (idx >= 128) { ++qx_; continue; } \
        int id2_ = (idx & 7) | ((idx >> 3) & 8) | ((idx & 56) << 1); asm volatile("" : "+s"(id2_)); const int qb = 7 - (id2_ >> 4), bh = xq_ * 16 + (id2_ & 15); attn_unit<MODE_>(F, A, l, bh >> 2, bh & 3, qb); EXTRA }
__device__ __forceinline__ void attn_phase(Frame& F, CArgs& A, int l) {
    const int cvn = (l + 1 < DEPTH) ? CV_LAYER : CV_MOE; const int myx = (int)xb_xcc_id() & 7;
    int nd = 0;
    ATTN_LOOP(0, 2, if (nd == (F.c & 3)) { for (int rr = 0; rr < 13; ++rr) CONV_ROUND(); } ++nd;)
    ATTN_LOOP(1, 0, )
    ATTN_LOOP(2, 1, )
    for (int tile = F.c; tile < NTOK / 256; tile += F.G) conv_unit(F, A, l, tile);
    for (;;) {
        if (F.tid == 0) F.MISC[1] = __hip_atomic_fetch_add(F.ctl + CW_Q + 64 * l + 48, 8u, RLX_AGENT);
        __syncthreads(); const int it0 = (int)F.MISC[1]; __syncthreads();
        if (it0 >= cvn) break;
        const int it1 = it0 + F.wave; const bool moe1 = it1 < CV_MOE;
        if (it1 < cvn) convert_item(F, A, moe1 ? l : l + 1, moe1 ? CV_DENSE + it1 : it1 - CV_MOE, (LAS float*)(F.lds + RING_OFF) + F.wave * (64 * 65));
        __syncthreads(); }
}

__device__ __forceinline__ void ffn_router_phase(Frame& F, CArgs& A, int l) {
    const float* MOD = WSP(float, WS_MOD); const bf16* WRT = WSP(bf16, WS_WRT) + (size_t)l * 2 * NLOG * DM; const float* SSp = WSP(float, WS_SS);
    bf16* H = WSP(bf16, WS_H); int* DEST = WSP(int, WS_DEST); float* GATE = WSP(float, WS_GATE); int* LIST = WSP(int, WS_LIST);
    LAS float* G2P = (LAS float*)(F.lds + RING_OFF); LAS float* SHF = G2P + 1024; LAS float* SHWB = G2P + 2048; LAS int* hist = (LAS int*)(G2P + 2176); LAS int* base = hist + 64;
    LAS int* rinfo = (LAS int*)(G2P + 2304);
    LAS unsigned char* WST = F.lds + RING_OFF + 20480;
    LAS float* LG = (LAS float*)WST + F.wave * 2560;
    const int tk = F.lane & 15, kg = F.lane >> 4;
    for (int tile = F.c; tile < NTOK / 256; tile += F.G) {
        const int b = tile >> 3;
#define RT_DMA(st, bufo) do { _Pragma("unroll") for (int q = 0; q < 5; ++q) { const int j = F.wave * 5 + q, sp = j / 10, hl = (j % 10) / 5, nb = j % 5; \
            __builtin_amdgcn_global_load_lds((const GAS unsigned*)(WRT + (size_t)(hl * NLOG + 16 * nb + (F.lane >> 2)) * DM + 128 * (st) + 32 * sp + 8 * (F.lane & 3)), (LAS unsigned*)(WST + (bufo) + j * 1024), 16, 0, 0); } } while (0)
        RT_DMA(0, 0);
        for (int k = F.tid; k < DM; k += 512) { G2P[k] = IN_g_ffn[l * DM + k] * (1.f + MOD[((size_t)l * NB + b) * 6144 + 4 * 1024 + k]); SHF[k] = MOD[((size_t)l * NB + b) * 6144 + 3 * 1024 + k]; }
        if (F.tid < 64) hist[F.tid] = 0;
        __syncthreads();
        if (F.tid < NLOG) SHWB[F.tid] = WSP(float, WS_SHWB)[((size_t)l * NB + b) * NLOG + F.tid];
        const size_t rowA = (size_t)tile * 256 + F.wave * 32 + tk, rowB = rowA + 16;
        float rsA, rsB;
        { const f32x4 a0 = *(const GAS f32x4*)(SSp + rowA * 16), a1 = *(const GAS f32x4*)(SSp + rowA * 16 + 4), a2 = *(const GAS f32x4*)(SSp + rowA * 16 + 8), a3 = *(const GAS f32x4*)(SSp + rowA * 16 + 12);
          const f32x4 b0 = *(const GAS f32x4*)(SSp + rowB * 16), b1 = *(const GAS f32x4*)(SSp + rowB * 16 + 4), b2 = *(const GAS f32x4*)(SSp + rowB * 16 + 8), b3 = *(const GAS f32x4*)(SSp + rowB * 16 + 12);
          const float sa = (((a0.x + a0.y) + (a0.z + a0.w)) + ((a1.x + a1.y) + (a1.z + a1.w))) + (((a2.x + a2.y) + (a2.z + a2.w)) + ((a3.x + a3.y) + (a3.z + a3.w)));
          const float sb = (((b0.x + b0.y) + (b0.z + b0.w)) + ((b1.x + b1.y) + (b1.z + b1.w))) + (((b2.x + b2.y) + (b2.z + b2.w)) + ((b3.x + b3.y) + (b3.z + b3.w)));
          rsA = 1.f / sqrtf(sa * (1.f / DM) + EPS); rsB = 1.f / sqrtf(sb * (1.f / DM) + EPS); }
        f32x4 acc[2][5];
#pragma unroll
        for (int rb = 0; rb < 2; ++rb)
#pragma unroll
            for (int nb = 0; nb < 5; ++nb) acc[rb][nb] = (f32x4){0.f, 0.f, 0.f, 0.f};
        const f16* xa = WSP(f16, WS_XR) + rowA * DM + 8 * kg; const f16* xb = WSP(f16, WS_XR) + rowB * DM + 8 * kg;
        f16x8 nxa = *(const GAS f16x8*)(xa), nxb = *(const GAS f16x8*)(xb);
        for (int st = 0; st < 8; ++st) {
            if (st == 0) VM_WAIT(); else asm volatile("s_waitcnt vmcnt(16)" ::: "memory");
            __syncthreads();
            if (st + 1 < 8) RT_DMA(st + 1, ((st + 1) & 1) * 40960);
            const LAS unsigned char* wb = WST + (st & 1) * 40960 + (tk * 4 + kg) * 16;
#pragma unroll
            for (int sp = 0; sp < 4; ++sp) {
                const int s = 4 * st + sp, k = 32 * s + 8 * kg;
                const f32x4 xa0 = (f32x4){(float)nxa[0], (float)nxa[1], (float)nxa[2], (float)nxa[3]}, xa1 = (f32x4){(float)nxa[4], (float)nxa[5], (float)nxa[6], (float)nxa[7]}, xb0 = (f32x4){(float)nxb[0], (float)nxb[1], (float)nxb[2], (float)nxb[3]}, xb1 = (f32x4){(float)nxb[4], (float)nxb[5], (float)nxb[6], (float)nxb[7]};
                if (s + 1 < 32) { nxa = *(const GAS f16x8*)(xa + 32 * (s + 1)); nxb = *(const GAS f16x8*)(xb + 32 * (s + 1)); }
                const f32x4 g0 = *(const LAS f32x4*)(G2P + k), g1 = *(const LAS f32x4*)(G2P + k + 4), h0 = *(const LAS f32x4*)(SHF + k), h1 = *(const LAS f32x4*)(SHF + k + 4);
                const f32x4 ua0 = xa0 * g0, ua1 = xa1 * g1, ub0 = xb0 * g0, ub1 = xb1 * g1;
                { const f32x4 a0 = ua0 * rsA + h0, a1 = ua1 * rsA + h1, b0 = ub0 * rsB + h0, b1 = ub1 * rsB + h1;
                  unsigned char* H8 = WSP(unsigned char, WS_H8);
                  *(GAS v2u*)(H8 + rowA * DM + k) = pack_fp8x8(a0.x * A8_SCALE, a0.y * A8_SCALE, a0.z * A8_SCALE, a0.w * A8_SCALE, a1.x * A8_SCALE, a1.y * A8_SCALE, a1.z * A8_SCALE, a1.w * A8_SCALE);
                  *(GAS v2u*)(H8 + rowB * DM + k) = pack_fp8x8(b0.x * A8_SCALE, b0.y * A8_SCALE, b0.z * A8_SCALE, b0.w * A8_SCALE, b1.x * A8_SCALE, b1.y * A8_SCALE, b1.z * A8_SCALE, b1.w * A8_SCALE); }
                bf16x8 hA, lA, hB, lB;
#define SPLIT2(HW, LW, X, Y) { HW = pg8::cvt_pk_bf16(X, Y); LW = pg8::cvt_pk_bf16(X - __builtin_bit_cast(float, HW << 16), Y - __builtin_bit_cast(float, HW & 0xffff0000u)); }
#define SPLIT8(H_, L_, U0, U1) { v4u hw, lw; SPLIT2(hw.x, lw.x, U0.x, U0.y) SPLIT2(hw.y, lw.y, U0.z, U0.w) SPLIT2(hw.z, lw.z, U1.x, U1.y) SPLIT2(hw.w, lw.w, U1.z, U1.w) \
                H_ = __builtin_bit_cast(bf16x8, hw); L_ = __builtin_bit_cast(bf16x8, lw); }
                SPLIT8(hA, lA, ua0, ua1) SPLIT8(hB, lB, ub0, ub1)
#undef SPLIT8
#undef SPLIT2
#pragma unroll
                for (int nb = 0; nb < 5; ++nb) {
                    const bf16x8 wh = *(const LAS bf16x8*)(wb + ((sp * 2 + 0) * 5 + nb) * 1024), wl = *(const LAS bf16x8*)(wb + ((sp * 2 + 1) * 5 + nb) * 1024);
                    acc[0][nb] = __builtin_amdgcn_mfma_f32_16x16x32_bf16(wh, hA, acc[0][nb], 0, 0, 0); acc[0][nb] = __builtin_amdgcn_mfma_f32_16x16x32_bf16(wh, lA, acc[0][nb], 0, 0, 0); acc[0][nb] = __builtin_amdgcn_mfma_f32_16x16x32_bf16(wl, hA, acc[0][nb], 0, 0, 0);
                    acc[1][nb] = __builtin_amdgcn_mfma_f32_16x16x32_bf16(wh, hB, acc[1][nb], 0, 0, 0); acc[1][nb] = __builtin_amdgcn_mfma_f32_16x16x32_bf16(wh, lB, acc[1][nb], 0, 0, 0); acc[1][nb] = __builtin_amdgcn_mfma_f32_16x16x32_bf16(wl, hB, acc[1][nb], 0, 0, 0);
                }
            }
        }
#undef RT_DMA
        __syncthreads();
#pragma unroll
        for (int nb = 0; nb < 5; ++nb) { const f32x4 sb = *(const LAS f32x4*)(SHWB + 16 * nb + 4 * kg);
            *(LAS f32x4*)(LG + tk * NLOG + 16 * nb + 4 * kg) = acc[0][nb] * rsA + sb; *(LAS f32x4*)(LG + (16 + tk) * NLOG + 16 * nb + 4 * kg) = acc[1][nb] * rsB + sb; }
        LDS_WAIT(); asm volatile("" ::: "memory");
        if (F.lane < 32) {
            const LAS float* lg = LG + F.lane * NLOG;
            float gl[8];
#pragma unroll
            for (int j = 0; j < 8; ++j) gl[j] = lg[j];
            int g = 0; float mx = gl[0];
#pragma unroll
            for (int j = 1; j < 8; ++j) if (gl[j] > mx) { mx = gl[j]; g = j; }
            float Z = 0.f;
#pragma unroll
            for (int j = 0; j < 8; ++j) Z += expf(gl[j] - mx);
            const float pg = 1.f / Z;
            const LAS float* el = lg + 8 + 8 * g; float ev[8];
#pragma unroll
            for (int j = 0; j < 8; ++j) ev[j] = el[j];
            int i1 = 0; float m1v = ev[0];
#pragma unroll
            for (int j = 1; j < 8; ++j) if (ev[j] > m1v) { m1v = ev[j]; i1 = j; }
            int i2 = -1; float m2v = -3.0e38f;
#pragma unroll
            for (int j = 0; j < 8; ++j) if (j != i1 && ev[j] > m2v) { m2v = ev[j]; i2 = j; }
            float one_ = 1.f; asm("" : "+s"(one_));
            const float eb = expf(m2v - m1v), den = 1.f / __builtin_fmaf(eb, one_, 1.f);
            const int e0 = 8 * g + i1, e1 = 8 * g + i2;
            const int r0 = __hip_atomic_fetch_add(hist + e0, 1, __ATOMIC_RELAXED, __HIP_MEMORY_SCOPE_WORKGROUP), r1 = __hip_atomic_fetch_add(hist + e1, 1, __ATOMIC_RELAXED, __HIP_MEMORY_SCOPE_WORKGROUP);
            LAS int* ri = rinfo + (F.wave * 32 + F.lane) * 8;
            ri[0] = e0; ri[1] = r0; ri[2] = e1; ri[3] = r1; ri[4] = __float_as_int(pg * den); ri[5] = __float_as_int(pg * eb * den);
        }
        __syncthreads();
        if (F.tid < 64) { const int hc = hist[F.tid]; base[F.tid] = hc ? (int)__hip_atomic_fetch_add(F.ctl + CW_GCNT + (l * 64 + F.tid) * 16, (unsigned)hc, RLX_AGENT) : 0; }
        __syncthreads();
        if (F.tid < 256) { const LAS int* ri = rinfo + F.tid * 8; const size_t row = (size_t)tile * 256 + F.tid;
            const int e0 = ri[0], s0 = base[e0] + ri[1], e1 = ri[2], s1 = base[e1] + ri[3];
            LIST[(size_t)e0 * 65536 + s0] = (int)row; LIST[(size_t)e1 * 65536 + s1] = (int)row;
            *(GAS i32x4*)(DEST + row * 4) = (i32x4){e0, s0, e1, s1}; *(GAS f32x2*)(GATE + row * 2) = (f32x2){__int_as_float(ri[4]), __int_as_float(ri[5])}; }
        __syncthreads();
    }
}

template <bool GATHER_TOK>
__device__ __forceinline__ int moe_build_tables(Frame& F, int l, int chunk) {
    LAS int* ut = (LAS int*)(F.lds + UT_OFF); LAS unsigned* tokt = (LAS unsigned*)(F.lds + TAB_OFF);
    const LAS int* mbs = (const LAS int*)(F.lds + UT_OFF + 256); const LAS int* cnts = mbs + 72;
    const int NU = 4 * mbs[64];
    if (F.tid < 16) {
        const int i = F.tid + 16 * chunk; int e = 0, mbid = 0, pnl = 0; bool ok;
        if ((F.G & 31) == 0) { const int q = F.G >> 5; mbid = i * (F.G >> 2) + (F.c & 7) * q + ((F.c >> 3) % q); pnl = (F.c >> 3) / q; ok = mbid < (NU >> 2); }
        else { const int U = F.c + i * F.G; mbid = U >> 2; pnl = U & 3; ok = U < NU; }
        if (ok) { for (int j = 1; j < 64; ++j) if (mbs[j] <= mbid) e = j; }
        ut[4 * F.tid] = mbid; ut[4 * F.tid + 1] = e * 4 + pnl; ut[4 * F.tid + 2] = F.tid; ut[4 * F.tid + 3] = ok ? e : -1; }
    __syncthreads();
    int n = 0;
    for (int i = 0; i < 16; ++i) if (ut[4 * i + 3] >= 0) n = i + 1;
    if (GATHER_TOK) {
        const int* LIST = WSP(int, WS_LIST);
        for (int i = F.tid >> 8; i < n; i += 2) { const int e = ut[4 * i + 3], mbid = ut[4 * i], sl = F.tid & 255; const int s = 256 * (mbid - mbs[e]) + sl;
            tokt[i * 256 + sl] = (s < cnts[e]) ? (unsigned)LIST[(size_t)e * 65536 + s] : 0u; }
    }
    __syncthreads();
    return n;
}
__device__ __forceinline__ void moe_gateup_phase(Frame& F, int l) {
    moe_block_starts(F, l);
    const int NU = 4 * ((const LAS int*)(F.lds + UT_OFF + 256))[64];
    for (int chunk = 0; chunk * 16 * F.G < NU; ++chunk) {
        const int n = moe_build_tables<true>(F, l, chunk);
        pg8::Gemm g{WSP(bf16, WS_H8), (const bf16*)(WSP(unsigned char, WS_WGU) + (size_t)l * NEXP * 1024 * 1024), DM / 2, DM / 2, A8_E8M0};
        pg8::TableOrder S{(const LAS int*)(F.lds + UT_OFF), (const LAS unsigned*)(F.lds + TAB_OFF), n};
        EpiGateUp E{WSP(unsigned char, WS_HID)};
        pg8::gemm_phase<EpiGateUp, pg8::TableOrder, true, true, true>(F.lds + RING_OFF, g, S, E, F.tid);
        __syncthreads();
    }
}
__device__ __forceinline__ void moe_down_phase(Frame& F, int l) {
    moe_block_starts(F, l);
    const int NU = 4 * ((const LAS int*)(F.lds + UT_OFF + 256))[64];
    for (int chunk = 0; chunk * 16 * F.G < NU; ++chunk) {
        const int n = moe_build_tables<false>(F, l, chunk);
        pg8::Gemm g{WSP(bf16, WS_HID), (const bf16*)(WSP(unsigned char, WS_WD) + (size_t)l * NEXP * 1024 * DEXP), DEXP / 2, DEXP / 2, HID8_E8M0};
        pg8::TableOrder S{(const LAS int*)(F.lds + UT_OFF), (const LAS unsigned*)(F.lds + TAB_OFF), n};
        EpiStoreFp8 E{WSP(unsigned char, WS_Y), DM, 3, Y8_SCALE};
        pg8::gemm_phase<EpiStoreFp8, pg8::TableOrder, true, false, true>(F.lds + RING_OFF, g, S, E, F.tid);
        __syncthreads();
    }
}

template <int PHSEL>
__global__ void __launch_bounds__(512, 2) trunk_fwd(Args args) {
    extern __shared__ __attribute__((aligned(16))) unsigned char lds_raw[];
    Frame F;
    F.lds = (LAS unsigned char*)lds_raw; F.MISC = (volatile LAS unsigned*)(F.lds + MISC_OFF);
    F.tid = threadIdx.x; F.lane = F.tid & 63; F.wave = __builtin_amdgcn_readfirstlane(F.tid >> 6); F.G = gridDim.x; F.c = blockIdx.x;
    const int wave0 = F.wave;
    F.ws = args.ws; F.out = args.out; F.ctl = (gu32*)(args.ws + WS_CTL);
    for (int u = F.tid; u < 32; u += 512) F.MISC[u] = 0u;
    __syncthreads();
    const int lo = args.ph_lo, hi = args.ph_hi;
    if (hi - lo > 1) (void)xcd_barrier_post((unsigned*)(F.ctl + CW_BAR), F.MISC + 8);
#define EN(j) (PHSEL < 0 || PHSEL == (j))
#define PB() CArgs* Ap_ = (CArgs*)__builtin_amdgcn_kernarg_segment_ptr(); asm volatile("" : "+s"(Ap_)); CArgs& A_ = *Ap_; do { { int c_ = (int)blockIdx.x, g_ = (int)gridDim.x, w_ = wave0; asm volatile("" : "+s"(c_), "+s"(g_), "+s"(w_)); F.c = c_; F.G = g_; F.wave = w_; } { int ln_; asm volatile("v_mbcnt_lo_u32_b32 %0, -1, 0\n\tv_mbcnt_hi_u32_b32 %0, -1, %0" : "=v"(ln_)); F.lane = ln_; } F.tid = F.wave * 64 + F.lane; F.ws = A_.ws; F.out = A_.out; F.ctl = (gu32*)(A_.ws + WS_CTL); } while (0)
#define IN(k) (lo <= (k) && (k) < hi)
#ifdef PROBE_MASK
    unsigned long long pt_acc = 0ull, pt_t0 = 0ull;
#define PT0() do { pt_t0 = __builtin_amdgcn_s_memrealtime(); } while (0)
#define PT1(j) do { if ((PROBE_MASK >> (j)) & 1) pt_acc += __builtin_amdgcn_s_memrealtime() - pt_t0; } while (0)
#else
#define PT0() do {} while (0)
#define PT1(j) do {} while (0)
#endif
#define SEAM(k) do { if (IN(k) && IN((k) + 1)) { XcdBarrier b_; b_.bar = (unsigned*)(F.ctl + CW_BAR); b_.x = xb_xcc_id(); b_.st = F.MISC + 8; xcd_barrier(b_); } } while (0)
    if (EN(0) && IN(0)) { PB(); PT0(); prologue(F, A_); SEAM(0); PT1(0); }
    for (int l = 0; l < DEPTH; ++l) {
        const int p0 = 1 + 8 * l;
        if (EN(1) && IN(p0)) { PB(); PT0(); int lq = l; asm volatile("" : "+s"(lq)); if (lq == 0) mix_norm_phase<false, false>(F, A_, lq); else mix_norm_phase<false, true>(F, A_, lq); SEAM(p0); PT1(1); }
        if (EN(2) && IN(p0 + 1)) { PB(); PT0(); int lq = l; asm volatile("" : "+s"(lq));
            pg8::Gemm g{WSP(bf16, WS_H), WSP(bf16, WS_WIN) + (size_t)lq * PN * DM, DM, DM}; pg8::StaticOrder S; S.init(NTOK, PN, F.G, F.c);
            EpiStoreBf16 E{WSP(bf16, WS_PROJ), PN, 0xffff};
            pg8::gemm_phase<EpiStoreBf16, pg8::StaticOrder, true, false>(F.lds + RING_OFF, g, S, E, F.tid);
            SEAM(p0 + 1); PT1(2); }
        if (EN(3) && IN(p0 + 2)) { PB(); PT0(); int lq = l; asm volatile("" : "+s"(lq)); mla_up_phase(F, A_, lq); SEAM(p0 + 2); PT1(3); }
        if (EN(4) && IN(p0 + 3)) { PB(); PT0(); int lq = l; asm volatile("" : "+s"(lq)); attn_phase(F, A_, lq); SEAM(p0 + 3); PT1(4); }
        if (EN(5) && IN(p0 + 4)) { PB(); PT0(); int lq = l; asm volatile("" : "+s"(lq));
            pg8::Gemm g{WSP(bf16, WS_MIX), (const bf16*)(WSP(unsigned char, WS_WOUT) + (size_t)lq * DM * DM), DM / 2, DM / 2, MIX8_E8M0}; pg8::StaticOrder S; S.init(NTOK, DM, F.G, F.c);
            EpiOut E{lq == 0 ? (const float*)A_.in[0] : nullptr, WSP(f16, WS_XR), WSP(f16, WS_XR), WSP(float, WS_MOD) + (size_t)lq * NB * 6144 + 2 * 1024, WSP(float, WS_SS)};
            pg8::gemm_phase<EpiOut, pg8::StaticOrder, true, false, true>(F.lds + RING_OFF, g, S, E, F.tid);
            SEAM(p0 + 4); PT1(5); }
        if (EN(6) && IN(p0 + 5)) { PB(); PT0(); int lq = l; asm volatile("" : "+s"(lq)); ffn_router_phase(F, A_, lq); SEAM(p0 + 5); PT1(6); }
        if (EN(7) && IN(p0 + 6)) { PB(); PT0(); int lq = l; asm volatile("" : "+s"(lq)); moe_gateup_phase(F, lq); SEAM(p0 + 6); PT1(7); }
        if (EN(8) && IN(p0 + 7)) { PB(); PT0(); int lq = l; asm volatile("" : "+s"(lq)); moe_down_phase(F, lq); SEAM(p0 + 7); PT1(8); }
    }
    if (EN(9) && IN(NPHASE - 1)) { PB(); PT0(); mix_norm_phase<true, true>(F, A_, DEPTH); PT1(9);
#ifdef PROBE_MASK
        __syncthreads(); VM_WAIT(); if (blockIdx.x == 0 && F.tid == 0) F.out[0] += (float)pt_acc * (0.01f / 20.f);
#endif
    }
#undef IN
#undef SEAM
}

extern "C" void kernel_launch(void* const* d_in, const int* in_sizes, int n_in, void* d_out, int out_size, void* d_ws, size_t ws_size, hipStream_t stream) {
    static int grid = 0;
    if (grid == 0) {
        if (n_in != 26 || out_size != NTOK * DM || ws_size < WS_END) { fprintf(stderr, "kernel_launch: unexpected shapes (n_in %d, out %d, ws %zu < %zu); nothing launched\n", n_in, out_size, ws_size, (size_t)WS_END); grid = -1; return; }
        int dev = 0, cus = 0, per_cu = 0;
        if (hipGetDevice(&dev) != hipSuccess || hipDeviceGetAttribute(&cus, hipDeviceAttributeMultiprocessorCount, dev) != hipSuccess) { grid = -1; return; }
#if MK_MULTI
#define SA(T) if (hipFuncSetAttribute((const void*)trunk_fwd<T>, hipFuncAttributeMaxDynamicSharedMemorySize, LDS_BYTES) != hipSuccess) { fprintf(stderr, "kernel_launch: hipFuncSetAttribute failed\n"); grid = -1; return; }
        SA(0) SA(1) SA(2) SA(3) SA(4) SA(5) SA(6) SA(7) SA(8) SA(9)
#undef SA
#else
        if (hipFuncSetAttribute((const void*)trunk_fwd<-1>, hipFuncAttributeMaxDynamicSharedMemorySize, LDS_BYTES) != hipSuccess) { fprintf(stderr, "kernel_launch: hipFuncSetAttribute failed\n"); grid = -1; return; }
        if (hipOccupancyMaxActiveBlocksPerMultiprocessor(&per_cu, (const void*)trunk_fwd<-1>, 512, LDS_BYTES) != hipSuccess || per_cu < 1) { fprintf(stderr, "kernel_launch: occupancy query says %d\n", per_cu); (void)hipGetLastError(); }
#endif
        (void)per_cu;
        grid = cus;
    }
    if (grid < 0) return;
    (void)hipMemsetAsync((char*)d_ws + WS_CTL, 0, CTL_ZERO_BYTES, stream);
    Args a{};
    for (int i = 0; i < 26; ++i) a.in[i] = d_in[i];
    a.out = (float*)d_out; a.ws = (unsigned char*)d_ws;
#if MK_MULTI
    for (int p = 0; p < NPHASE; ++p) { a.ph_lo = p; a.ph_hi = p + 1; const int ty = (p == 0) ? 0 : (p == NPHASE - 1) ? 9 : 1 + (p - 1) % 8;
        switch (ty) {
#define LK(T) case T: hipLaunchKernelGGL(trunk_fwd<T>, dim3(grid), dim3(512), LDS_BYTES, stream, a); break;
            LK(0) LK(1) LK(2) LK(3) LK(4) LK(5) LK(6) LK(7) LK(8) LK(9)
#undef LK
        } }
#else
    a.ph_lo = 0; a.ph_hi = NPHASE;
    hipLaunchKernelGGL(trunk_fwd<-1>, dim3(grid), dim3(512), LDS_BYTES, stream, a);
#endif
    const hipError_t le = hipPeekAtLastError();
    if (le != hipSuccess) fprintf(stderr, "kernel_launch: launch failed: %s\n", hipGetErrorName(le));
}
```

```cpp
#include <hip/hip_runtime.h>
#include <cstdio>
#include <cstdint>

#ifndef MK_MULTI
#define MK_MULTI 0
#endif

#define GAS __attribute__((address_space(1)))
#define LAS __attribute__((address_space(3)))
typedef unsigned short bf16;
typedef unsigned v4u __attribute__((ext_vector_type(4)));
typedef unsigned v2u __attribute__((ext_vector_type(2)));
typedef float f32x4 __attribute__((ext_vector_type(4)));
typedef float f32x2 __attribute__((ext_vector_type(2)));
typedef float f32x16 __attribute__((ext_vector_type(16)));
typedef short bf16x8 __attribute__((ext_vector_type(8)));
typedef short s16x4 __attribute__((ext_vector_type(4)));
typedef int i32x4 __attribute__((ext_vector_type(4)));
typedef int i32x8 __attribute__((ext_vector_type(8)));
typedef GAS unsigned gu32;
typedef _Float16 f16;
typedef _Float16 f16x4 __attribute__((ext_vector_type(4)));
typedef _Float16 f16x8 __attribute__((ext_vector_type(8)));

constexpr int NB = 32, SEQ = 2048, DM = 1024, NTOK = NB * SEQ, DEPTH = 4;
constexpr int P_IN = 2660, PN = 2816;
constexpr int PC_CKV = 256, PC_KROPE = 384, PC_FOX = 512, PC_CONV = 1280, PC_DIFF = 2048;
constexpr int SRC_CKV = 192, SRC_KROPE = 320, SRC_FOX = 352, SRC_FLOG = 1120, SRC_CONV = 1124, SRC_DIFF = 1892;
constexpr int KUP = 384, NUP = 1024;
constexpr int NEXP = 64, DEXP = 512, NLOG = 80;
constexpr int MAXMB = 576, MAXSLOT = MAXMB * 256;
constexpr float EPS = 1e-6f, LOG2E = 1.4426950408889634f;
constexpr float W8_SCALE = 256.f, A8_SCALE = 16.f;
constexpr int W8_E8M0 = 0x77777777, A8_E8M0 = 0x7b7b7b7b;
constexpr float Y8_SCALE = 16.f;
constexpr float MIX8_SCALE = 4.f; constexpr int MIX8_E8M0 = 0x7d7d7d7d;
constexpr float HID8_SCALE = 8.f; constexpr int HID8_E8M0 = 0x7c7c7c7c;
constexpr int NPHASE = 2 + 8 * DEPTH;

constexpr size_t MiB = 1u << 20;
constexpr size_t WS_CTL = 0, CTL_ZERO_BYTES = 1 * MiB;
constexpr size_t WS_MOD = 1 * MiB;
constexpr size_t WS_T5 = 4 * MiB;
constexpr size_t WS_LAM = 4 * MiB + 64 * 1024;
constexpr size_t WS_WF = 4 * MiB + 128 * 1024;
constexpr size_t WS_WRT = 4 * MiB + 256 * 1024;
constexpr size_t WS_FLOG = 5 * MiB + 512 * 1024;
constexpr size_t WS_SS = 1563 * MiB;
constexpr size_t WS_SHWB = 4 * MiB + 192 * 1024;
constexpr size_t WS_FB = 7 * MiB;
constexpr size_t WS_DEST = 8 * MiB;
constexpr size_t WS_GATE = 9 * MiB;
constexpr size_t WS_LIST = 10 * MiB;
constexpr size_t WS_WIN = 26 * MiB;
constexpr size_t WS_WUP = 48 * MiB;
constexpr size_t WS_WOUT = 51 * MiB;
constexpr size_t WS_WGU = 59 * MiB;
constexpr size_t WS_WD = 571 * MiB;
constexpr size_t WS_H = 827 * MiB;
constexpr size_t WS_PROJ = 955 * MiB;
constexpr size_t WS_MLA = 1307 * MiB;
constexpr size_t WS_MIX = 1435 * MiB;
constexpr size_t WS_XR = 1567 * MiB;
constexpr size_t WS_H8 = 1695 * MiB;
constexpr size_t WS_END = 1759 * MiB;
constexpr size_t WS_Y = WS_PROJ, WS_HID = WS_MLA;
static_assert((size_t)MAXSLOT * 1024 * 2 <= WS_MLA - WS_PROJ && (size_t)MAXSLOT * 512 * 2 <= WS_SS - WS_MLA, "overlays fit");
constexpr int CW_TMO = 0, CW_CODE = 1, CW_BAR = 4096, CW_Q = 8192  , CW_GCNT = 12288  , CW_QX = 20480  ;

constexpr int RING_OFF = 0, RING_BYTES = 131072;
constexpr int TAB_OFF = RING_BYTES, TAB_BYTES = 16384;
constexpr int UT_OFF = TAB_OFF + TAB_BYTES;
constexpr int MISC_OFF = UT_OFF + 1024;
constexpr int LDS_BYTES = MISC_OFF + 128;
static_assert(LDS_BYTES <= 160 * 1024, "LDS");

#define RLX_AGENT __ATOMIC_RELAXED, __HIP_MEMORY_SCOPE_AGENT
#define LDS_WAIT() asm volatile("s_waitcnt lgkmcnt(0)" ::: "memory")
#define VM_WAIT() asm volatile("s_waitcnt vmcnt(0)" ::: "memory")
__device__ __forceinline__ unsigned f2bf(float f) { unsigned u = __builtin_bit_cast(unsigned, f); return (u + 0x7fffu + ((u >> 16) & 1u)) >> 16; }
__device__ __forceinline__ unsigned pk2(float lo, float hi) { return f2bf(lo) | (f2bf(hi) << 16); }
__device__ __forceinline__ float bflo(unsigned w) { return __builtin_bit_cast(float, w << 16); }
__device__ __forceinline__ float bfhi(unsigned w) { return __builtin_bit_cast(float, w & 0xffff0000u); }
__device__ __forceinline__ float bf2f(bf16 h) { return __builtin_bit_cast(float, (unsigned)h << 16); }
__device__ __forceinline__ float shx(float v, int o, int lane) { return __builtin_bit_cast(float, __builtin_amdgcn_ds_bpermute((lane ^ o) << 2, __builtin_bit_cast(int, v))); }
__device__ __forceinline__ float wave_sum(float v, int lane) {
#pragma unroll
    for (int o = 1; o < 64; o <<= 1) v += shx(v, o, lane);
    return v;
}
__device__ __forceinline__ int opq(int v) { asm volatile("" : "+v"(v)); return v; }
__device__ __forceinline__ float clamp8(float v) { return __builtin_fminf(__builtin_fmaxf(v, -448.f), 448.f); }
__device__ __forceinline__ v2u pack_fp8x8(float a0, float a1, float a2, float a3, float a4, float a5, float a6, float a7) {
    int lo = __builtin_amdgcn_cvt_pk_fp8_f32(clamp8(a0), clamp8(a1), 0, false); lo = __builtin_amdgcn_cvt_pk_fp8_f32(clamp8(a2), clamp8(a3), lo, true);
    int hi = __builtin_amdgcn_cvt_pk_fp8_f32(clamp8(a4), clamp8(a5), 0, false); hi = __builtin_amdgcn_cvt_pk_fp8_f32(clamp8(a6), clamp8(a7), hi, true);
    v2u r; r.x = (unsigned)lo; r.y = (unsigned)hi; return r;
}
__device__ __forceinline__ float fast_exp2(float x) { return __builtin_amdgcn_exp2f(x); }
__device__ __forceinline__ float fast_rcp(float x) { return __builtin_amdgcn_rcpf(x); }
__device__ __forceinline__ float fast_rsq(float x) { return __builtin_amdgcn_rsqf(x); }
__device__ __forceinline__ float silu_f(float x) { return x * fast_rcp(1.f + fast_exp2(-x * LOG2E)); }

__device__ __forceinline__ void stagger_start(int c, unsigned ticks) {
    const unsigned long long t0 = __builtin_amdgcn_s_memrealtime(); const unsigned long long d = (unsigned long long)((unsigned)(c & 3) * ticks);
    while (__builtin_amdgcn_s_memrealtime() - t0 < d) __builtin_amdgcn_s_sleep(8);
}
#define XB_TMO      128
#define XB_XCNT(j)  (256  + 64 * (j))
#define XB_XSUB(j)  (1280 + 64 * (j))
#define XB_XGEN(j)  (2304 + 64 * (j))
#define XB_TOP      3328
#define XB_TOPGEN   3392
#define XCD_BAR_WORDS 3456
#define XB_SPIN_CAP (1u << 22)
__device__ __forceinline__ unsigned xb_ld(unsigned* p)              { return __hip_atomic_load(p, __ATOMIC_RELAXED, __HIP_MEMORY_SCOPE_AGENT); }
__device__ __forceinline__ unsigned xb_add(unsigned* p, unsigned v) { return __hip_atomic_fetch_add(p, v, __ATOMIC_RELAXED, __HIP_MEMORY_SCOPE_AGENT); }
__device__ __forceinline__ unsigned xb_xcc_id() { return (unsigned)__builtin_amdgcn_s_getreg((3 << 11) | 20) & 0xFu; }
#define XB_SPIN(cond, bar) do { unsigned _sp = 0; while (cond) { __builtin_amdgcn_s_sleep(1); \
    if ((++_sp & 255u) == 0u) { if (xb_ld(&(bar)[XB_TMO])) break; if (_sp > XB_SPIN_CAP) { atomicAdd(&(bar)[XB_TMO], 1u); break; } } } } while (0)
struct XcdBarrier { unsigned* bar; unsigned x; volatile LAS unsigned* st; };
__device__ __forceinline__ XcdBarrier xcd_barrier_post(unsigned* bar, volatile LAS unsigned* st) {
    XcdBarrier b; b.bar = bar; b.x = xb_xcc_id(); b.st = st;
    if (threadIdx.x == 0) (void)xb_add(&bar[XB_XCNT(b.x)], 1u);
    return b;
}
__device__ __forceinline__ void xcd_barrier_complete(unsigned* bar, unsigned x, unsigned& nloc, unsigned& nx) {
    const unsigned G = gridDim.x * gridDim.y * gridDim.z;
    unsigned sum, cnt, mine, sp = 0u;
    for (;;) {
        sum = 0u; cnt = 0u; mine = 0u;
#pragma nounroll
        for (unsigned j = 0; j < 16; ++j) { const unsigned c = xb_ld(&bar[XB_XCNT(j)]); sum += c; cnt += (c > 0u) ? 1u : 0u; mine = (j == x) ? c : mine; }
        if (sum == G) break;
        __builtin_amdgcn_s_sleep(1);
        if ((++sp & 255u) == 0u) { if (xb_ld(&bar[XB_TMO])) break; if (sp > XB_SPIN_CAP) { atomicAdd(&bar[XB_TMO], 1u); break; } }
    }
    nloc = mine > 0u ? mine : 1u; nx = cnt > 0u ? cnt : 1u;
}
__device__ __forceinline__ void xcd_barrier(const XcdBarrier& b) {
    asm volatile("s_waitcnt vmcnt(0)" ::: "memory");
    __syncthreads();
    if (threadIdx.x == 0) {
        unsigned* bar = b.bar;
        __builtin_amdgcn_s_waitcnt(0);
        unsigned nloc = b.st[0], nx = b.st[1];
        if (nloc == 0u) { xcd_barrier_complete(bar, b.x, nloc, nx); b.st[0] = nloc; b.st[1] = nx; }
        const unsigned old = xb_add(&bar[XB_XSUB(b.x)], 1u);
        const unsigned gen = old / nloc;
        if (old + 1u == (gen + 1u) * nloc) {
            __builtin_amdgcn_fence(__ATOMIC_RELEASE, "agent");
            asm volatile("s_waitcnt vmcnt(0)" ::: "memory");
            const unsigned og = xb_add(&bar[XB_TOP], 1u);
            const unsigned tg = og / nx;
            if (og + 1u == (tg + 1u) * nx) xb_add(&bar[XB_TOPGEN], 1u);
            else XB_SPIN(xb_ld(&bar[XB_TOPGEN]) == tg, bar);
            __builtin_amdgcn_fence(__ATOMIC_ACQUIRE, "agent");
            xb_add(&bar[XB_XGEN(b.x)], 1u);
            asm volatile("s_waitcnt vmcnt(0)" ::: "memory");
        } else {
            XB_SPIN(xb_ld(&bar[XB_XGEN(b.x)]) == gen, bar);
            __builtin_amdgcn_fence(__ATOMIC_ACQUIRE, "agent");
            asm volatile("s_waitcnt vmcnt(0)" ::: "memory");
        }
    }
    __syncthreads();
}

namespace pg8 {
constexpr int BM = 256, BK = 64, HALF = 128, HTB = HALF * BK * 2, NXCD = 8, WGM = 8;
__host__ __device__ __forceinline__ int lds_byte(int r, int c) { return r * 128 + (((c >> 3) ^ ((r >> 1) & 7)) * 16) + (c & 7) * 2; }
__host__ __device__ __forceinline__ void stage_rc(int b, int& R, int& C) { R = b / 128; C = ((((b % 128) / 16) ^ ((R >> 1) & 7)) * 8) + (b % 16) / 2; }
__host__ __device__ __forceinline__ int perm32(int rho) { const int n = rho >> 4, i = rho & 15; return 8 * (i >> 2) + 4 * n + (i & 3); }
__host__ __device__ __forceinline__ int perm32w(int rho) { const int n = rho >> 4, i = rho & 15, fq = i >> 2, g = ((fq & 1) << 1) | (fq >> 1); return 8 * g + 4 * n + (i & 3); }
struct Unit { int pm, pn, aux; };
struct Gemm { const bf16* A; const bf16* Bt; int K; int lda; int sa8 = 0; int ldb = 0; };

struct StaticOrder {
    int nM, nN, nwg, G, c;
    __device__ void init(int M, int N, int G_, int c_) { nM = M / BM; nN = N / BM; nwg = nM * nN; G = G_; c = c_; }
    __device__ __forceinline__ bool next(int i, Unit& u) const {
        const long L = (long)i * G + c; if (L >= nwg) return false;
        int wgid = (int)L; { const int q = nwg / NXCD, r = nwg % NXCD, xcd = wgid % NXCD, off = wgid / NXCD; wgid = (xcd < r ? xcd * (q + 1) : r * (q + 1) + (xcd - r) * q) + off; }
        const int nig = WGM * nN, gid = wgid / nig, fm = gid * WGM, gsz = (nM - fm) < WGM ? (nM - fm) : WGM;
        u.pm = fm + ((wgid % nig) % gsz); u.pn = (wgid % nig) / gsz; u.aux = 0; return true;
    }
    __device__ __forceinline__ unsigned tok(const Unit&, int) const { return 0u; }
};
struct PanelOrder {
    int pm, nN;
    __device__ __forceinline__ bool next(int i, Unit& u) const { if (i >= nN) return false; int p_ = pm; asm volatile("" : "+s"(p_)); u.pm = p_; u.pn = i; u.aux = 0; return true; }
    __device__ __forceinline__ unsigned tok(const Unit&, int) const { return 0u; }
};
struct TableOrder {
    const LAS int* ut; const LAS unsigned* tokt; int n;
    __device__ __forceinline__ bool next(int i, Unit& u) const { if (i >= n) return false; const i32x4 d = *(const LAS i32x4*)(ut + 4 * i); u.pm = __builtin_amdgcn_readfirstlane(d.x); u.pn = __builtin_amdgcn_readfirstlane(d.y); u.aux = __builtin_amdgcn_readfirstlane(d.z); return true; }
    __device__ __forceinline__ unsigned tok(const Unit& u, int slot) const { return tokt[u.aux * 256 + slot]; }
};

__device__ __forceinline__ unsigned cvt_pk_bf16(float lo, float hi) { unsigned r; asm volatile("v_cvt_pk_bf16_f32 %0, %1, %2" : "=v"(r) : "v"(lo), "v"(hi)); return r; }

template <class Epi, class Sched, bool ALIGN_EPI, bool GATHER, bool FP8 = false>
__device__ __forceinline__ void gemm_phase(LAS unsigned char* lds, const Gemm g, const Sched& S, const Epi& E, const int tid_in) {
    const int tid = opq(tid_in), wid = __builtin_amdgcn_readfirstlane(tid >> 6), lane = tid & 63, wr = wid >> 2, wc = wid & 3, fr = lane & 15, fq = lane >> 4;
    const int K = g.K, nt = K / BK, lda = g.lda, ldb = g.ldb ? g.ldb : K;
    unsigned voffA[2], voffB[2]; int RA[2]; unsigned CA[2];
    const size_t kstep = (size_t)(BK * 2);
    const size_t hstepA = (size_t)HALF * lda * 2, hstepB = (size_t)HALF * ldb * 2;
    const size_t tstepA = 2 * hstepA, tstepB = 2 * hstepB;
#pragma unroll
    for (int i = 0; i < 2; ++i) { int R, C; stage_rc(tid * 16 + i * 8192, R, C); const int Rb = Epi::PERM ? ((R & ~31) + (Epi::PERMW ? perm32w(R & 31) : perm32(R & 31))) : R;
        RA[i] = R; CA[i] = (unsigned)C * 2u; voffB[i] = (unsigned)(Rb * ldb + C) * 2u; voffA[i] = (unsigned)(R * lda + C) * 2u; }
    const unsigned ldsw = (unsigned)wid * 1024u;
    const int aoff = lds_byte(wr * 64 + fr, fq * 8), boff = lds_byte(wc * 32 + fr, fq * 8), x64 = (fr & 8) ? -64 : 64;
#define PG8_SA(b, h) (((b) * 2 + (h)) * HTB)
#define PG8_SB(b, h) ((4 + (b) * 2 + (h)) * HTB)
#define PG8_GLDS(gp, bufoff, _i) __builtin_amdgcn_global_load_lds((const unsigned*)(gp), (LAS unsigned*)(lds + (bufoff) + ldsw + (_i) * 8192), 16, 0, 0)
#define PG8_STAGE_B(bufoff, gbase) do { _Pragma("unroll") for (int _i = 0; _i < 2; ++_i) PG8_GLDS((const char*)(gbase) + voffB[_i], bufoff, _i); } while (0)
#define PG8_STAGE_A(bufoff, gbase, OA, h) do { _Pragma("unroll") for (int _i = 0; _i < 2; ++_i) { if constexpr (GATHER) PG8_GLDS((const char*)(gbase) + OA[h][_i], bufoff, _i); else PG8_GLDS((const char*)(gbase) + (size_t)(h) * hstepA + voffA[_i], bufoff, _i); } } while (0)
#define PG8_LD8(P, X) __builtin_shufflevector(*(const LAS i32x4*)(P), *(const LAS i32x4*)((P) + (X)), 0, 1, 2, 3, 4, 5, 6, 7)
#define PG8_LDA(dst, b, h) do { _Pragma("unroll") for (int m = 0; m < 4; ++m) { if constexpr (FP8) dst##8[m] = PG8_LD8(lds + PG8_SA(b, h) + aoff + m * 2048, x64); else { _Pragma("unroll") for (int k = 0; k < 2; ++k) dst[m][k] = *(const LAS bf16x8*)(lds + PG8_SA(b, h) + aoff + m * 2048 + (k ? x64 : 0)); } } } while (0)
#define PG8_LDB(dst, b, h) do { _Pragma("unroll") for (int n = 0; n < 2; ++n) { if constexpr (FP8) dst##8[n] = PG8_LD8(lds + PG8_SB(b, h) + boff + n * 2048, x64); else { _Pragma("unroll") for (int k = 0; k < 2; ++k) dst[n][k] = *(const LAS bf16x8*)(lds + PG8_SB(b, h) + boff + n * 2048 + (k ? x64 : 0)); } } } while (0)
#define PG8_CAT(X0, X1) __builtin_shufflevector(__builtin_bit_cast(i32x4, X0), __builtin_bit_cast(i32x4, X1), 0, 1, 2, 3, 4, 5, 6, 7)
#define PG8_MMA(ai, bj, At, Bt) do { __builtin_amdgcn_s_setprio(1); _Pragma("unroll") for (int m = 0; m < 4; ++m) _Pragma("unroll") for (int n = 0; n < 2; ++n) { \
        if constexpr (FP8) asm("v_mfma_scale_f32_16x16x128_f8f6f4 %0, %1, %2, %0, %3, %4 op_sel_hi:[0,0,0]" : "+v"(acc[ai][bj][m][n]) : "v"(Bt##8[n]), "v"(At##8[m]), "v"(sc8w), "v"(sc8a)); \
        else { _Pragma("unroll") for (int k = 0; k < 2; ++k) acc[ai][bj][m][n] = __builtin_amdgcn_mfma_f32_16x16x32_bf16(Bt[n][k], At[m][k], acc[ai][bj][m][n], 0, 0, 0); } } __builtin_amdgcn_s_setprio(0); } while (0)
#define PG8_WAIT_V(n) asm volatile("s_waitcnt vmcnt(" #n ")" ::: "memory")
#define PG8_WAIT_L(n) asm volatile("s_waitcnt lgkmcnt(" #n ")" ::: "memory")
#define PG8_BAR __builtin_amdgcn_s_barrier()
#define PG8_SCHED __builtin_amdgcn_sched_barrier(0)
#define PG8_SETOA(OA, U) do { _Pragma("unroll") for (int _h = 0; _h < 2; ++_h) _Pragma("unroll") for (int _i = 0; _i < 2; ++_i) \
        OA[_h][_i] = GATHER ? (S.tok(U, _h * HALF + RA[_i]) * (unsigned)lda * 2u + CA[_i]) : 0u; } while (0)
    Unit cur, nxt; int ui = 0;
    if (!S.next(0, cur)) return;
    f32x4 acc[2][2][4][2];
#pragma unroll
    for (int a = 0; a < 2; ++a)
#pragma unroll
        for (int b = 0; b < 2; ++b)
#pragma unroll
            for (int m = 0; m < 4; ++m)
#pragma unroll
                for (int n = 0; n < 2; ++n) acc[a][b][m][n] = (f32x4){0.f, 0.f, 0.f, 0.f};
    bf16x8 At[4][2], B0[2][2], B1[2][2]; i32x8 At8[4], B08[2], B18[2];
    const int sc8w = W8_E8M0, sc8a = g.sa8;
    unsigned oc[2][2], on[2][2];
    PG8_SETOA(oc, cur);
    const char* cA = (const char*)g.A + (GATHER ? (size_t)0 : (size_t)cur.pm * tstepA); const char* cB = (const char*)g.Bt + (size_t)cur.pn * tstepB;
    PG8_STAGE_B(PG8_SB(0, 0), cB); PG8_STAGE_B(PG8_SB(0, 1), cB + hstepB); PG8_STAGE_A(PG8_SA(0, 0), cA, oc, 0); PG8_STAGE_A(PG8_SA(0, 1), cA, oc, 1);
    if (wr == 1) PG8_BAR;
    PG8_WAIT_V(2); PG8_BAR;
    PG8_STAGE_B(PG8_SB(1, 0), cB + kstep); PG8_STAGE_A(PG8_SA(1, 0), cA + kstep, oc, 0); PG8_STAGE_B(PG8_SB(1, 1), cB + hstepB + kstep);
    PG8_WAIT_V(6); PG8_BAR;
    for (;;) {
        const bool has_next = S.next(ui + 1, nxt);
        const char* nA = has_next ? (const char*)g.A + (GATHER ? (size_t)0 : (size_t)nxt.pm * tstepA) : cA; const char* nB = has_next ? (const char*)g.Bt + (size_t)nxt.pn * tstepB : cB;
        if (has_next) { PG8_SETOA(on, nxt); } else {
#pragma unroll
            for (int _h = 0; _h < 2; ++_h)
#pragma unroll
                for (int _i = 0; _i < 2; ++_i) on[_h][_i] = oc[_h][_i]; }
#pragma nounroll
        for (int t = 0; t < nt; t += 2) {
            const bool last = (t == nt - 2);
            const char* a1 = cA + (size_t)(t + 1) * kstep;
            const char* a2 = last ? nA : cA + (size_t)(t + 2) * kstep; const char* b2 = last ? nB : cB + (size_t)(t + 2) * kstep;
            const char* a3 = a2 + kstep; const char* b3 = b2 + kstep;
            unsigned o2[2][2];
#pragma unroll
            for (int _h = 0; _h < 2; ++_h)
#pragma unroll
                for (int _i = 0; _i < 2; ++_i) o2[_h][_i] = last ? on[_h][_i] : oc[_h][_i];
            PG8_LDB(B0, 0, 0); PG8_LDB(B1, 0, 1); PG8_SCHED; PG8_LDA(At, 0, 0); PG8_STAGE_A(PG8_SA(1, 1), a1, oc, 1);
            PG8_WAIT_V(8); PG8_WAIT_L(0); PG8_BAR; PG8_MMA(0, 0, At, B0); PG8_MMA(0, 1, At, B1); PG8_BAR; PG8_SCHED;
            PG8_LDA(At, 0, 1); PG8_STAGE_B(PG8_SB(0, 0), b2); PG8_STAGE_B(PG8_SB(0, 1), b2 + hstepB); PG8_STAGE_A(PG8_SA(0, 0), a2, o2, 0);
            PG8_WAIT_V(8); PG8_WAIT_L(0); PG8_BAR; PG8_MMA(1, 0, At, B0); PG8_MMA(1, 1, At, B1); PG8_BAR; PG8_SCHED;
            PG8_LDB(B0, 1, 0); PG8_LDB(B1, 1, 1); PG8_SCHED; PG8_LDA(At, 1, 0); PG8_STAGE_A(PG8_SA(0, 1), a2, o2, 1);
            PG8_WAIT_V(8); PG8_WAIT_L(0); PG8_BAR; PG8_MMA(0, 0, At, B0); PG8_MMA(0, 1, At, B1); PG8_BAR; PG8_SCHED;
            PG8_LDA(At, 1, 1); PG8_STAGE_B(PG8_SB(1, 0), b3); PG8_STAGE_B(PG8_SB(1, 1), b3 + hstepB); PG8_STAGE_A(PG8_SA(1, 0), a3, o2, 0);
            PG8_WAIT_V(8); PG8_WAIT_L(0); PG8_BAR; PG8_MMA(1, 0, At, B0); PG8_MMA(1, 1, At, B1); PG8_BAR; PG8_SCHED;
        }
        if constexpr (ALIGN_EPI) { if (wr == 0) PG8_BAR; }
        if constexpr (FP8) asm volatile("s_nop 15\n\ts_nop 15" ::: "memory");
        E(acc, cur, wr, wc, fr, fq);
        if (!has_next) break;
#pragma unroll
        for (int a = 0; a < 2; ++a)
#pragma unroll
            for (int b = 0; b < 2; ++b)
#pragma unroll
                for (int m = 0; m < 4; ++m)
#pragma unroll
                    for (int n = 0; n < 2; ++n) acc[a][b][m][n] = (f32x4){0.f, 0.f, 0.f, 0.f};
        cur = nxt; cA = nA; cB = nB; ++ui;
#pragma unroll
        for (int _h = 0; _h < 2; ++_h)
#pragma unroll
            for (int _i = 0; _i < 2; ++_i) oc[_h][_i] = on[_h][_i];
        if constexpr (ALIGN_EPI) { if (wr == 1) PG8_BAR; }
    }
    PG8_WAIT_V(0);
    if constexpr (!ALIGN_EPI) { if (wr == 0) PG8_BAR; }
    PG8_BAR;
#undef PG8_SA
#undef PG8_SB
#undef PG8_GLDS
#undef PG8_STAGE_A
#undef PG8_STAGE_B
#undef PG8_LDA
#undef PG8_LD8
#undef PG8_LDB
#undef PG8_MMA
#undef PG8_CAT
#undef PG8_WAIT_V
#undef PG8_WAIT_L
#undef PG8_BAR
#undef PG8_SCHED
#undef PG8_SETOA
}
}

struct Args { const void* in[26]; float* out; unsigned char* ws; int ph_lo, ph_hi; };
typedef const __attribute__((address_space(4))) Args CArgs;
struct Frame {
    LAS unsigned char* lds;
    volatile LAS unsigned* MISC;
    gu32* ctl;
    int tid, lane, wave, G, c;
    unsigned char* ws; float* out;
};
#define IN_x ((const float*)A.in[0])
#define IN_cnd ((const float*)A.in[1])
#define IN_pos ((const int*)A.in[2])
#define IN_t5 ((const float*)A.in[3])
#define IN_ada_w ((const float*)A.in[4])
#define IN_ada_b ((const float*)A.in[5])
#define IN_g_mix ((const float*)A.in[6])
#define IN_g_ffn ((const float*)A.in[7])
#define IN_w_in ((const float*)A.in[8])
#define IN_gq ((const float*)A.in[9])
#define IN_w_uq ((const float*)A.in[10])
#define IN_gkv ((const float*)A.in[11])
#define IN_w_ukv ((const float*)A.in[12])
#define IN_fb ((const float*)A.in[13])
#define IN_conv_w ((const float*)A.in[14])
#define IN_dlam ((const float*)A.in[15])
#define IN_subln ((const float*)A.in[16])
#define IN_w_out ((const float*)A.in[17])
#define IN_rg_w ((const float*)A.in[18])
#define IN_rg_b ((const float*)A.in[19])
#define IN_re_w ((const float*)A.in[20])
#define IN_re_b ((const float*)A.in[21])
#define IN_wg ((const float*)A.in[22])
#define IN_wu ((const float*)A.in[23])
#define IN_wd ((const float*)A.in[24])
#define IN_g_fin ((const float*)A.in[25])
#define WSP(T, off) ((T*)(F.ws + (off)))

template <class Fn, bool OUT8 = false>
__device__ __forceinline__ void transpose_item(const Fn& f, bf16* dst, int ldd, int k0, int n0, LAS float* scr, int lane) {
    const int nq = lane & 15, kr = lane >> 4;
    f32x4 v[16];
#pragma unroll
    for (int i = 0; i < 16; ++i) v[i] = f(k0 + 4 * i + kr, n0 + 4 * nq);
#pragma unroll
    for (int i = 0; i < 16; ++i) { const int k = 4 * i + kr;
        scr[(4 * nq + 0) * 65 + k] = v[i].x; scr[(4 * nq + 1) * 65 + k] = v[i].y; scr[(4 * nq + 2) * 65 + k] = v[i].z; scr[(4 * nq + 3) * 65 + k] = v[i].w; }
    LDS_WAIT(); asm volatile("" ::: "memory");
    const int kc = lane & 7, nr = lane >> 3;
#pragma unroll
    for (int j = 0; j < 8; ++j) { const int n = nr + 8 * j; const LAS float* s = scr + n * 65 + 8 * kc;
        if (OUT8) { *(GAS v2u*)((unsigned char*)dst + (size_t)(n0 + n) * ldd + k0 + 8 * kc) = pack_fp8x8(s[0], s[1], s[2], s[3], s[4], s[5], s[6], s[7]); }
        else { v4u o; o.x = pk2(s[0], s[1]); o.y = pk2(s[2], s[3]); o.z = pk2(s[4], s[5]); o.w = pk2(s[6], s[7]);
            *(GAS v4u*)(dst + (size_t)(n0 + n) * ldd + k0 + 8 * kc) = o; } }
    LDS_WAIT(); asm volatile("" ::: "memory");
}
struct SrcPlain {
    const float* W; int ld; int coff; float scale;
    __device__ __forceinline__ f32x4 operator()(int k, int n) const { const f32x4 v = *(const GAS f32x4*)(W + (size_t)k * ld + n + coff); return v * scale; }
};
struct SrcZero { __device__ __forceinline__ f32x4 operator()(int, int) const { return (f32x4){0.f, 0.f, 0.f, 0.f}; } };
struct SrcKrope {
    const float* W;
    __device__ __forceinline__ f32x4 operator()(int k, int n) const { if (n >= PC_KROPE + 32) return (f32x4){0.f, 0.f, 0.f, 0.f}; return *(const GAS f32x4*)(W + (size_t)k * P_IN + SRC_KROPE + (n - PC_KROPE)); }
};
__device__ __forceinline__ int rope_dim_of_pos(int p) { return (p & 4) ? 16 + 4 * (p >> 3) + (p & 3) : 4 * (p >> 3) + (p & 3); }
struct SrcUp {
    const float* wuq; const float* gq; const float* wukv; const float* gkv; float c2a;
    __device__ __forceinline__ float one(int k, int n) const {
        if (n < 384) { if (k >= 192) return 0.f; const int h = n / 96, j = n % 96; const int col = h * 96 + (j < 64 ? j : 64 + rope_dim_of_pos(j - 64)); return gq[k] * wuq[(size_t)k * 384 + col] * c2a; }
        if (n < 512) return 0.f;
        if (k < 256) return 0.f;
        return gkv[k - 256] * wukv[(size_t)(k - 256) * 512 + (n - 512)];
    }
    __device__ __forceinline__ f32x4 operator()(int k, int n) const { return (f32x4){one(k, n), one(k, n + 1), one(k, n + 2), one(k, n + 3)}; }
};

constexpr float C2A = 0.10206207261596577f * LOG2E;
constexpr float C2B = 0.125f * LOG2E;
constexpr float C2D = 0.17677669529663687f * LOG2E;

__device__ __forceinline__ int t5_bucket(int rel) {
    const int n = rel < 0 ? -rel : rel; const int base = rel > 0 ? 16 : 0;
    if (n < 8) return base + n;
    const int fl = 31 - __builtin_clz((unsigned)(n * n));
    int large = 8 + fl - 6; if (large > 15) large = 15;
    return base + large;
}

constexpr int CV_IN = 16 * 44, CV_UP = 6 * 16, CV_OUT = 16 * 16, CV_GU = 16 * 16 * NEXP, CV_D = 8 * 16 * NEXP, CV_LAYER = CV_IN + CV_UP + CV_OUT + CV_GU + CV_D;
constexpr int CV_DENSE = CV_IN + CV_UP + CV_OUT, CV_MOE = CV_GU + CV_D;
__device__ __forceinline__ void convert_item(Frame& F, CArgs& A, int l, int r, LAS float* scr) {
    if (r < CV_IN) {
        const int nb = r / 16, kb = r % 16, n0 = nb * 64, k0 = kb * 64; bf16* dst = WSP(bf16, WS_WIN) + (size_t)l * PN * DM; const float* W = IN_w_in + (size_t)l * DM * P_IN;
        if (n0 < 192) transpose_item(SrcPlain{W, P_IN, 0, 1.f}, dst, DM, k0, n0, scr, F.lane);
        else if (n0 < 256) transpose_item(SrcZero{}, dst, DM, k0, n0, scr, F.lane);
        else if (n0 < 384) transpose_item(SrcPlain{W, P_IN, SRC_CKV - PC_CKV, 1.f}, dst, DM, k0, n0, scr, F.lane);
        else if (n0 < 448) transpose_item(SrcKrope{W}, dst, DM, k0, n0, scr, F.lane);
        else if (n0 < 512) transpose_item(SrcZero{}, dst, DM, k0, n0, scr, F.lane);
        else if (n0 < PC_CONV) transpose_item(SrcPlain{W, P_IN, SRC_FOX - PC_FOX, n0 < PC_FOX + 256 ? C2B : 1.f}, dst, DM, k0, n0, scr, F.lane);
        else if (n0 < PC_DIFF) transpose_item(SrcPlain{W, P_IN, SRC_CONV - PC_CONV, 1.f}, dst, DM, k0, n0, scr, F.lane);
        else transpose_item(SrcPlain{W, P_IN, SRC_DIFF - PC_DIFF, n0 < PC_DIFF + 256 ? C2D : 1.f}, dst, DM, k0, n0, scr, F.lane);
        return; }
    r -= CV_IN;
    if (r < CV_UP) { const int nb = r / 6, kb = r % 6;
        transpose_item(SrcUp{IN_w_uq + (size_t)l * 192 * 384, IN_gq + l * 192, IN_w_ukv + (size_t)l * 128 * 512, IN_gkv + l * 128, C2A}, WSP(bf16, WS_WUP) + (size_t)l * NUP * KUP, KUP, kb * 64, nb * 64, scr, F.lane);
        return; }
    r -= CV_UP;
    if (r < CV_OUT) { const int nb = r / 16, kb = r % 16;
        transpose_item<SrcPlain, true>(SrcPlain{IN_w_out + (size_t)l * DM * DM, DM, 0, W8_SCALE}, (bf16*)(WSP(unsigned char, WS_WOUT) + (size_t)l * DM * DM), DM, kb * 64, nb * 64, scr, F.lane);
        return; }
    r -= CV_OUT;
    if (r < CV_GU) { const int e = r / 256, q = r % 256, nb = q / 16, kb = q % 16, n0 = nb * 64;
        const int pn = n0 >> 8, half = (n0 >> 7) & 1, j0 = n0 & 127;
        const float* W = (half ? IN_wu : IN_wg) + ((size_t)l * NEXP + e) * DM * DEXP;
        transpose_item<SrcPlain, true>(SrcPlain{W, DEXP, 128 * pn + j0 - n0, W8_SCALE}, (bf16*)(WSP(unsigned char, WS_WGU) + ((size_t)l * NEXP + e) * 1024 * 1024), DM, kb * 64, n0, scr, F.lane);
        return; }
    r -= CV_GU;
    { const int e = r / 128, q = r % 128, nb = q / 8, kb = q % 8;
      transpose_item<SrcPlain, true>(SrcPlain{IN_wd + ((size_t)l * NEXP + e) * DEXP * DM, DM, 0, W8_SCALE}, (bf16*)(WSP(unsigned char, WS_WD) + ((size_t)l * NEXP + e) * 1024 * DEXP), DEXP, kb * 64, nb * 64, scr, F.lane); }
}

__device__ __forceinline__ void prologue(Frame& F, CArgs& A) {
    const int gw = F.c * 8 + F.wave, NGW = F.G * 8;
    const int gt = F.c * 512 + F.tid, NGT = F.G * 512;
    {
        LAS float* cs = (LAS float*)(F.lds + RING_OFF);
        bool loaded = false;
        float* MOD = WSP(float, WS_MOD);
        for (int it = F.c; it < DEPTH * 64; it += F.G) {
            if (!loaded) { for (int e = F.tid; e < NB * DM; e += 512) { const int b = e >> 10, k = e & 1023; cs[k * 32 + b] = silu_f(IN_cnd[e]); } loaded = true; __syncthreads(); }
            const int l = it >> 6, n0 = (it & 63) * 96;
            const int col = F.tid >> 2, ks = F.tid & 3;
            if (F.tid < 384) {
                const float* W = IN_ada_w + (size_t)l * DM * 6144 + n0 + col;
                float acc[32];
#pragma unroll
                for (int b = 0; b < 32; ++b) acc[b] = 0.f;
                for (int kk0 = 0; kk0 < 256; kk0 += 16) { float w[16];
#pragma unroll
                    for (int u = 0; u < 16; ++u) w[u] = W[(size_t)(4 * (kk0 + u) + ks) * 6144];
#pragma unroll
                    for (int u = 0; u < 16; ++u) { const int k = 4 * (kk0 + u) + ks;
#pragma unroll
                        for (int b4 = 0; b4 < 8; ++b4) { const f32x4 c4 = *(const LAS f32x4*)(cs + k * 32 + 4 * b4); acc[4 * b4] += c4.x * w[u]; acc[4 * b4 + 1] += c4.y * w[u]; acc[4 * b4 + 2] += c4.z * w[u]; acc[4 * b4 + 3] += c4.w * w[u]; } } }
#pragma unroll
                for (int b = 0; b < 32; ++b) { float v = acc[b]; v += shx(v, 1, F.lane); v += shx(v, 2, F.lane); acc[b] = v; }
                if (ks == 0) { const float bias = IN_ada_b[l * 6144 + n0 + col];
#pragma unroll
                    for (int b = 0; b < 32; ++b) MOD[((size_t)l * NB + b) * 6144 + n0 + col] = acc[b] + bias; }
            }
        }
        __syncthreads();
    }
    { float* T5 = WSP(float, WS_T5);
      for (int i = gt; i < 4 * 2112; i += NGT) { const int h = i / 2112, r = i % 2112; T5[i] = IN_t5[t5_bucket(r - 2047) * 4 + h] * LOG2E; }
      float* LAM = WSP(float, WS_LAM);
      if (gt < DEPTH) { const int l = gt; const float* p = IN_dlam + l * 128; float s0 = 0.f, s1 = 0.f;
          for (int i = 0; i < 32; ++i) { s0 += p[i] * p[32 + i]; s1 += p[64 + i] * p[96 + i]; }
          LAM[l] = expf(s0) - expf(s1) + (0.8f - 0.6f * expf(-0.3f * (float)l)); }
      float* WF = WSP(float, WS_WF);
      for (int i = gt; i < DEPTH * 4 * DM; i += NGT) { const int l = i >> 12, j = (i >> 10) & 3, k = i & 1023; WF[i] = IN_w_in[((size_t)l * DM + k) * P_IN + SRC_FLOG + j]; }
      bf16* WRT = WSP(bf16, WS_WRT);
      for (int i = gt; i < DEPTH * NLOG * DM; i += NGT) { const int l = i / (NLOG * DM), r = i % (NLOG * DM), n = r >> 10, k = r & 1023;
          const float v = n < 8 ? IN_rg_w[((size_t)l * DM + k) * 8 + n] : (n < 72 ? IN_re_w[((size_t)l * DM + k) * 64 + (n - 8)] : 0.f);
          const unsigned hi = f2bf(v); const float lo = v - __builtin_bit_cast(float, hi << 16);
          WRT[((size_t)l * 2 + 0) * NLOG * DM + r] = (bf16)hi; WRT[((size_t)l * 2 + 1) * NLOG * DM + r] = (bf16)f2bf(lo); }
    }
    {
        LAS float* scr = (LAS float*)(F.lds + RING_OFF) + F.wave * (64 * 65);
        for (int it = gw; it < CV_DENSE; it += NGW) convert_item(F, A, 0, it, scr);
    }
}
__device__ __forceinline__ float rope_rev(int i) {
    constexpr float T[16] = {1.591549431e-01f, 8.949940161e-02f, 5.032921210e-02f, 2.830219583e-02f, 1.591549431e-02f, 8.949940161e-03f, 5.032921210e-03f, 2.830219583e-03f,
                             1.591549431e-03f, 8.949940161e-04f, 5.032921210e-04f, 2.830219583e-04f, 1.591549431e-04f, 8.949940161e-05f, 5.032921210e-05f, 2.830219583e-05f};
    return T[i];
}
__device__ __forceinline__ void rope_cs(float posf, float rev, float& c, float& s) { float a = posf * rev; a -= rintf(a); c = __builtin_amdgcn_cosf(a); s = __builtin_amdgcn_sinf(a); }

__device__ __forceinline__ void moe_block_starts(Frame& F, int lm) {
    LAS int* mbs = (LAS int*)(F.lds + UT_OFF + 256); LAS int* cnts = mbs + 72;
    if (F.tid < 64) cnts[F.tid] = (int)__hip_atomic_load(F.ctl + CW_GCNT + (lm * 64 + F.tid) * 16, RLX_AGENT);
    __syncthreads();
    if (F.tid == 0) { int a = 0; for (int e = 0; e < 64; ++e) { mbs[e] = a; a += (cnts[e] + 255) >> 8; } mbs[64] = a; }
    __syncthreads();
}

template <bool FINAL, bool COMB>
__device__ __forceinline__ void mix_norm_phase(Frame& F, CArgs& A, int l) {
    if (COMB) moe_block_starts(F, l - 1);
    const LAS int* mbs = (const LAS int*)(F.lds + UT_OFF + 256);
    const float* MOD = WSP(float, WS_MOD);
    const unsigned char* Y = WSP(unsigned char, WS_Y); const int* DEST = WSP(int, WS_DEST); const float* GATE = WSP(float, WS_GATE);
    bf16* H = WSP(bf16, WS_H); float* FLOG = WSP(float, WS_FLOG);
    f16* XR = WSP(f16, WS_XR);
    LAS float* G1 = (LAS float*)(F.lds + RING_OFF); LAS float* SH = G1 + 1024; LAS float* GF = G1 + 2048; LAS float* wfl = G1 + 3072;
    if (!FINAL) {
        const bf16* WRT = WSP(bf16, WS_WRT) + (size_t)l * 2 * NLOG * DM;
        for (int bb = F.c; bb < NB; bb += F.G) { const float* shf = MOD + ((size_t)l * NB + bb) * 6144 + 3 * 1024;
            for (int n = F.wave; n < NLOG; n += 8) { float sacc = 0.f;
#pragma unroll
                for (int j = 0; j < 4; ++j) { const int k = 4 * F.lane + 256 * j; const v2u wh = *(const GAS v2u*)(WRT + (size_t)n * DM + k), wl = *(const GAS v2u*)(WRT + (size_t)(NLOG + n) * DM + k); const f32x4 sf = *(const GAS f32x4*)(shf + k);
                    sacc += sf.x * (bflo(wh.x) + bflo(wl.x)) + sf.y * (bfhi(wh.x) + bfhi(wl.x)) + sf.z * (bflo(wh.y) + bflo(wl.y)) + sf.w * (bfhi(wh.y) + bfhi(wl.y)); }
                sacc = wave_sum(sacc, F.lane);
                if (F.lane == 0) WSP(float, WS_SHWB)[((size_t)l * NB + bb) * NLOG + n] = sacc + (n < 8 ? IN_rg_b[l * 8 + n] : (n < 72 ? IN_re_b[l * 64 + n - 8] : 0.f)); } }
    }
    for (int tile = F.c; tile < NTOK / 256; tile += F.G) {
        const int b = tile >> 3;
        __syncthreads();
        for (int k = F.tid; k < DM; k += 512) {
            if (FINAL) G1[k] = IN_g_fin[k];
            else { G1[k] = IN_g_mix[l * DM + k] * (1.f + MOD[((size_t)l * NB + b) * 6144 + 1024 + k]); SH[k] = MOD[((size_t)l * NB + b) * 6144 + k]; }
            if (COMB) GF[k] = MOD[((size_t)(l - 1) * NB + b) * 6144 + 5 * 1024 + k]; }
        if (!FINAL) for (int i = F.tid; i < 1024; i += 512) *(LAS f32x4*)(wfl + 4 * i) = *(const GAS f32x4*)(WSP(float, WS_WF) + (size_t)l * 4 * DM + 4 * i);
        __syncthreads();
        const size_t rowbase = (size_t)tile * 256 + F.wave * 32;
        unsigned r0v = 0u, r1v = 0u; float g0v = 0.f, g1v = 0.f;
        if (COMB && F.lane < 32) { const i32x4 d = *(const GAS i32x4*)(DEST + (rowbase + F.lane) * 4); const f32x2 gt = *(const GAS f32x2*)(GATE + (rowbase + F.lane) * 2);
            r0v = 256u * (unsigned)mbs[d.x] + (unsigned)d.y; r1v = 256u * (unsigned)mbs[d.z] + (unsigned)d.w; g0v = gt.x; g1v = gt.y; }
        struct RowBuf { f32x4 v[COMB ? 1 : 4]; f16x4 hx[COMB ? 4 : 1]; unsigned y0[COMB ? 4 : 1], y1[COMB ? 4 : 1]; float g0, g1; };
#define MN_LOAD(S, JR) do { const size_t row_ = rowbase + (JR); \
            if (COMB) { const size_t q0_ = (size_t)__builtin_amdgcn_readlane(r0v, (JR)), q1_ = (size_t)__builtin_amdgcn_readlane(r1v, (JR)); \
                S.g0 = __uint_as_float(__builtin_amdgcn_readlane(__float_as_uint(g0v), (JR))); S.g1 = __uint_as_float(__builtin_amdgcn_readlane(__float_as_uint(g1v), (JR))); \
                _Pragma("unroll") for (int j = 0; j < (COMB ? 4 : 0); ++j) { S.hx[j] = *(const GAS f16x4*)(XR + row_ * DM + 4 * F.lane + 256 * j); \
                    S.y0[j] = *(const GAS unsigned*)(Y + q0_ * DM + 4 * F.lane + 256 * j); S.y1[j] = *(const GAS unsigned*)(Y + q1_ * DM + 4 * F.lane + 256 * j); } } \
            else { _Pragma("unroll") for (int j = 0; j < (COMB ? 0 : 4); ++j) S.v[j] = *(const GAS f32x4*)(IN_x + row_ * DM + 4 * F.lane + 256 * j); } } while (0)
#define MN_COMPUTE(S, JR) do { const size_t row = rowbase + (JR); f32x4 v[4]; \
            if (COMB) { \
                _Pragma("unroll") for (int j = 0; j < (COMB ? 4 : 0); ++j) { const f32x4 gf4 = *(const LAS f32x4*)(GF + 4 * F.lane + 256 * j); \
                    const f32x2 a01 = __builtin_amdgcn_cvt_pk_f32_fp8((int)S.y0[j], false), a23 = __builtin_amdgcn_cvt_pk_f32_fp8((int)S.y0[j], true), b01 = __builtin_amdgcn_cvt_pk_f32_fp8((int)S.y1[j], false), b23 = __builtin_amdgcn_cvt_pk_f32_fp8((int)S.y1[j], true); \
                    f32x4 m; m.x = S.g0 * a01.x + S.g1 * b01.x; m.y = S.g0 * a01.y + S.g1 * b01.y; m.z = S.g0 * a23.x + S.g1 * b23.x; m.w = S.g0 * a23.y + S.g1 * b23.y; m = m * (1.f / Y8_SCALE); \
                    v[j] = (f32x4){(float)S.hx[j].x, (float)S.hx[j].y, (float)S.hx[j].z, (float)S.hx[j].w} + gf4 * m; } \
                if (!FINAL) { \
                    _Pragma("unroll") for (int j = 0; j < 4; ++j) { const f16x4 hx = (f16x4){(f16)v[j].x, (f16)v[j].y, (f16)v[j].z, (f16)v[j].w}; *(GAS f16x4*)(XR + row * DM + 4 * F.lane + 256 * j) = hx; v[j] = (f32x4){(float)hx.x, (float)hx.y, (float)hx.z, (float)hx.w}; } } \
            } else { _Pragma("unroll") for (int j = 0; j < (COMB ? 0 : 4); ++j) v[j] = S.v[j]; } \
            float ss = 0.f; \
            _Pragma("unroll") for (int j = 0; j < 4; ++j) ss += (v[j].x * v[j].x + v[j].y * v[j].y) + (v[j].z * v[j].z + v[j].w * v[j].w); \
            const float rs = 1.f / sqrtf(wave_sum(ss, F.lane) * (1.f / DM) + EPS); \
            if (FINAL) { \
                _Pragma("unroll") for (int j = 0; j < 4; ++j) *(GAS f32x4*)(F.out + row * DM + 4 * F.lane + 256 * j) = v[j] * rs * *(const LAS f32x4*)(G1 + 4 * F.lane + 256 * j); \
            } else { \
                float fl[4] = {0.f, 0.f, 0.f, 0.f}; \
                _Pragma("unroll") for (int j = 0; j < 4; ++j) { const f32x4 hh = (v[j] * rs) * *(const LAS f32x4*)(G1 + 4 * F.lane + 256 * j) + *(const LAS f32x4*)(SH + 4 * F.lane + 256 * j); \
                    v2u o; o.x = pk2(hh.x, hh.y); o.y = pk2(hh.z, hh.w); \
                    *(GAS v2u*)(H + row * DM + 4 * F.lane + 256 * j) = o; \
                    _Pragma("unroll") for (int q = 0; q < 4; ++q) { const f32x4 w4 = *(const LAS f32x4*)(wfl + q * DM + 4 * F.lane + 256 * j); fl[q] += (hh.x * w4.x + hh.y * w4.y) + (hh.z * w4.z + hh.w * w4.w); } } \
                _Pragma("unroll") for (int q = 0; q < 4; ++q) fl[q] = wave_sum(fl[q], F.lane); \
                if (F.lane == 0) *(GAS f32x4*)(FLOG + row * 4) = (f32x4){fl[0], fl[1], fl[2], fl[3]}; \
            } } while (0)
        RowBuf RA, RB, RC;
        MN_LOAD(RA, 0); MN_LOAD(RB, 1);
        for (int jr = 0; jr < 30; jr += 3) {
            MN_LOAD(RC, jr + 2);
            MN_COMPUTE(RA, jr);
            MN_LOAD(RA, jr + 3);
            MN_COMPUTE(RB, jr + 1);
            MN_LOAD(RB, jr + 4);
            MN_COMPUTE(RC, jr + 2);
        }
        MN_COMPUTE(RA, 30); MN_COMPUTE(RB, 31);
#undef MN_LOAD
#undef MN_COMPUTE
    }
}

__device__ __forceinline__ v4u widen_pair(const v2u x, const v2u y) {
    auto r0 = __builtin_amdgcn_permlane32_swap(x.x, y.x, false, false); auto r1 = __builtin_amdgcn_permlane32_swap(x.y, y.y, false, false);
    v4u o; o.x = r0[0]; o.y = r1[0]; o.z = r0[1]; o.w = r1[1]; return o;
}
struct EpiStoreBf16 {
    static constexpr bool PERM = true, PERMW = false;
    bf16* O; int ldc; int pn_mask;
    __device__ __forceinline__ void operator()(const f32x4 (&acc)[2][2][4][2], const pg8::Unit& u, int wr, int wc, int fr, int fq) const {
        const size_t row0 = (size_t)u.pm * 256 + wr * 64 + fr; const int col0 = (u.pn & pn_mask) * 256 + wc * 32 + 8 * fq;
#pragma unroll
        for (int ai = 0; ai < 2; ++ai)
#pragma unroll
            for (int m = 0; m < 4; ++m) { bf16* rowp = O + (row0 + ai * 128 + m * 16) * ldc + col0;
#pragma unroll
                for (int bj = 0; bj < 2; ++bj) { const f32x4 v0 = acc[ai][bj][m][0], v1 = acc[ai][bj][m][1]; v4u w;
                    w.x = pg8::cvt_pk_bf16(v0[0], v0[1]); w.y = pg8::cvt_pk_bf16(v0[2], v0[3]); w.z = pg8::cvt_pk_bf16(v1[0], v1[1]); w.w = pg8::cvt_pk_bf16(v1[2], v1[3]);
                    *(GAS v4u*)(rowp + bj * 128) = w; } }
    }
};
struct EpiStoreFp8 {
    static constexpr bool PERM = true, PERMW = true;
    unsigned char* O; int ldc; int pn_mask; float scale;
    __device__ __forceinline__ void operator()(const f32x4 (&acc)[2][2][4][2], const pg8::Unit& u, int wr, int wc, int fr, int fq) const {
        const int hi32 = fq >> 1, g0 = (fq & 1) << 1;
        const size_t row0 = (size_t)u.pm * 256 + wr * 64 + fr + 16 * hi32; const int col0 = (u.pn & pn_mask) * 256 + wc * 32 + 8 * g0;
#pragma unroll
        for (int ai = 0; ai < 2; ++ai)
#pragma unroll
            for (int mp = 0; mp < 2; ++mp) { unsigned char* rowp = O + (row0 + ai * 128 + mp * 32) * ldc + col0;
#pragma unroll
                for (int bj = 0; bj < 2; ++bj) { const f32x4 a0 = acc[ai][bj][2 * mp][0] * scale, a1 = acc[ai][bj][2 * mp][1] * scale, b0 = acc[ai][bj][2 * mp + 1][0] * scale, b1 = acc[ai][bj][2 * mp + 1][1] * scale;
                    *(GAS v4u*)(rowp + bj * 128) = widen_pair(pack_fp8x8(a0[0], a0[1], a0[2], a0[3], a1[0], a1[1], a1[2], a1[3]), pack_fp8x8(b0[0], b0[1], b0[2], b0[3], b1[0], b1[1], b1[2], b1[3])); } }
    }
};
struct EpiOut {
    static constexpr bool PERM = true, PERMW = false;
    const float* xin32; const f16* xin16; f16* xout; const float* gm; float* SS;
    __device__ __forceinline__ void operator()(const f32x4 (&acc)[2][2][4][2], const pg8::Unit& u, int wr, int wc, int fr, int fq) const {
        const size_t row0 = (size_t)u.pm * 256 + wr * 64 + fr; const int col0 = u.pn * 256 + wc * 32 + 8 * fq; const int b = u.pm >> 3; const int lane = fq * 16 + fr;
        f32x4 gvv[2][2];
#pragma unroll
        for (int bj = 0; bj < 2; ++bj)
#pragma unroll
            for (int n = 0; n < 2; ++n) gvv[bj][n] = *(const GAS f32x4*)(gm + (size_t)b * 6144 + col0 + bj * 128 + n * 4);
#pragma unroll
        for (int ai = 0; ai < 2; ++ai)
#pragma unroll
            for (int m = 0; m < 4; ++m) { const size_t ro = (row0 + ai * 128 + m * 16) * DM + col0; float ss = 0.f;
#pragma unroll
                for (int bj = 0; bj < 2; ++bj) { f32x4 x0, x1;
                    if (xin32) { x0 = *(const GAS f32x4*)(xin32 + ro + bj * 128); x1 = *(const GAS f32x4*)(xin32 + ro + bj * 128 + 4); }
                    else { const f16x8 hx = *(const GAS f16x8*)(xin16 + ro + bj * 128); x0 = (f32x4){(float)hx[0], (float)hx[1], (float)hx[2], (float)hx[3]}; x1 = (f32x4){(float)hx[4], (float)hx[5], (float)hx[6], (float)hx[7]}; }
                    x0 = x0 + gvv[bj][0] * acc[ai][bj][m][0]; x1 = x1 + gvv[bj][1] * acc[ai][bj][m][1];
                    const f16x8 ho = (f16x8){(f16)x0.x, (f16)x0.y, (f16)x0.z, (f16)x0.w, (f16)x1.x, (f16)x1.y, (f16)x1.z, (f16)x1.w};
                    *(GAS f16x8*)(xout + ro + bj * 128) = ho;
#pragma unroll
                    for (int i = 0; i < 8; ++i) { const float q = (float)ho[i]; ss += q * q; } }
                ss += shx(ss, 16, lane); ss += shx(ss, 32, lane);
                if (fq == 0) SS[(row0 + ai * 128 + m * 16) * 16 + u.pn * 4 + wc] = ss; }
    }
};
struct EpiGateUp {
    static constexpr bool PERM = true, PERMW = true;
    unsigned char* O;
    __device__ __forceinline__ void operator()(const f32x4 (&acc)[2][2][4][2], const pg8::Unit& u, int wr, int wc, int fr, int fq) const {
        const int hi32 = fq >> 1, g0 = (fq & 1) << 1;
        const size_t row0 = (size_t)u.pm * 256 + wr * 64 + fr + 16 * hi32; const int col0 = (u.pn & 3) * 128 + wc * 32 + 8 * g0;
#pragma unroll
        for (int ai = 0; ai < 2; ++ai)
#pragma unroll
            for (int mp = 0; mp < 2; ++mp) { float ha[8], hb[8];
#pragma unroll
                for (int n = 0; n < 2; ++n)
#pragma unroll
                    for (int i = 0; i < 4; ++i) { ha[4 * n + i] = silu_f(acc[ai][0][2 * mp][n][i]) * acc[ai][1][2 * mp][n][i] * HID8_SCALE; hb[4 * n + i] = silu_f(acc[ai][0][2 * mp + 1][n][i]) * acc[ai][1][2 * mp + 1][n][i] * HID8_SCALE; }
                *(GAS v4u*)(O + (row0 + ai * 128 + mp * 32) * DEXP + col0) = widen_pair(pack_fp8x8(ha[0], ha[1], ha[2], ha[3], ha[4], ha[5], ha[6], ha[7]), pack_fp8x8(hb[0], hb[1], hb[2], hb[3], hb[4], hb[5], hb[6], hb[7])); }
    }
};

__device__ __forceinline__ void mla_up_phase(Frame& F, CArgs& A, int l) {
    bf16* PROJ = WSP(bf16, WS_PROJ);
    {
        for (int tok = F.c * 512 + F.tid; tok < NTOK; tok += F.G * 512) {
            GAS v4u* p = (GAS v4u*)(PROJ + (size_t)tok * PN + PC_KROPE);
            v4u w[4]; float t[32], o[32];
#pragma unroll
            for (int i = 0; i < 4; ++i) w[i] = p[i];
#pragma unroll
            for (int i = 0; i < 4; ++i) { t[8 * i] = bflo(w[i].x); t[8 * i + 1] = bfhi(w[i].x); t[8 * i + 2] = bflo(w[i].y); t[8 * i + 3] = bfhi(w[i].y); t[8 * i + 4] = bflo(w[i].z); t[8 * i + 5] = bfhi(w[i].z); t[8 * i + 6] = bflo(w[i].w); t[8 * i + 7] = bfhi(w[i].w); }
            const float posf = (float)IN_pos[tok];
#pragma unroll
            for (int i = 0; i < 16; ++i) { float c, s; rope_cs(posf, rope_rev(i), c, s);
                const int p1 = 8 * (i >> 2) + (i & 3), p2 = p1 + 4;
                o[p1] = t[i] * c - t[i + 16] * s; o[p2] = t[i + 16] * c + t[i] * s; }
#pragma unroll
            for (int i = 0; i < 4; ++i) { v4u q; q.x = pk2(o[8 * i], o[8 * i + 1]); q.y = pk2(o[8 * i + 2], o[8 * i + 3]); q.z = pk2(o[8 * i + 4], o[8 * i + 5]); q.w = pk2(o[8 * i + 6], o[8 * i + 7]); p[i] = q; }
        }
    }
    {
        const float* FLOG = WSP(float, WS_FLOG); float* FB = WSP(float, WS_FB);
        LAS float* wt = (LAS float*)(F.lds + RING_OFF);
        for (int bh = F.c; bh < NB * 4; bh += F.G) {
            const int b = bh >> 2, h = bh & 3; const float fb = IN_fb[l * 4 + h];
            float v[4]; float run = 0.f;
#pragma unroll
            for (int j = 0; j < 4; ++j) { const float xx = FLOG[((size_t)b * SEQ + 4 * F.tid + j) * 4 + h] + fb; const float ls = fminf(xx, 0.f) - log1pf(expf(-fabsf(xx))); run += ls; v[j] = run; }
            float inc = run;
#pragma unroll
            for (int o = 1; o < 64; o <<= 1) { const float n = __builtin_bit_cast(float, __builtin_amdgcn_ds_bpermute((F.lane - o) << 2, __builtin_bit_cast(int, inc))); if (F.lane >= o) inc += n; }
            if (F.lane == 63) wt[F.wave] = inc;
            __syncthreads();
            float base = inc - run;
            for (int w = 0; w < F.wave; ++w) base += wt[w];
#pragma unroll
            for (int j = 0; j < 4; ++j) FB[((size_t)b * 4 + h) * SEQ + 4 * F.tid + j] = -LOG2E * (base + v[j]);
            __syncthreads();
        }
    }
    for (int pm = F.c; pm < NTOK / 256; pm += F.G) {
        {
            const bool isq = F.lane < 24, iskv = (F.lane >= 32 && F.lane < 48), act = isq || iskv;
            const size_t coff = isq ? 8 * F.lane : PC_CKV + 8 * (F.lane & 15);
            GAS v4u* p0 = (GAS v4u*)(PROJ + ((size_t)pm * 256 + F.wave * 32) * PN + coff);
            v4u w[32];
#pragma unroll
            for (int jr = 0; jr < 32; ++jr) w[jr] = act ? *(p0 + (size_t)jr * (PN / 8)) : (v4u){0u, 0u, 0u, 0u};
#pragma unroll
            for (int jr = 0; jr < 32; ++jr) {
                const float a0 = bflo(w[jr].x), a1 = bfhi(w[jr].x), a2 = bflo(w[jr].y), a3 = bfhi(w[jr].y), a4 = bflo(w[jr].z), a5 = bfhi(w[jr].z), a6 = bflo(w[jr].w), a7 = bfhi(w[jr].w);
                float ss = (a0 * a0 + a1 * a1) + (a2 * a2 + a3 * a3) + (a4 * a4 + a5 * a5) + (a6 * a6 + a7 * a7);
                ss += shx(ss, 1, F.lane); ss += shx(ss, 2, F.lane); ss += shx(ss, 4, F.lane); ss += shx(ss, 8, F.lane); ss += shx(ss, 16, F.lane);
                const float rs = isq ? 1.f / sqrtf(ss * (1.f / 192.f) + EPS) : 1.f / sqrtf(ss * (1.f / 128.f) + EPS);
                if (act) { v4u o; o.x = pk2(a0 * rs, a1 * rs); o.y = pk2(a2 * rs, a3 * rs); o.z = pk2(a4 * rs, a5 * rs); o.w = pk2(a6 * rs, a7 * rs); *(p0 + (size_t)jr * (PN / 8)) = o; } }
        }
        VM_WAIT();
        __syncthreads();
        for (int part = 0; part < 2; ++part) {
            int po = part; asm volatile("" : "+s"(po));
            const int kof = po * 256, nof = po * 512;
            pg8::Gemm g{PROJ + kof, WSP(bf16, WS_WUP) + (size_t)l * NUP * KUP + (size_t)nof * KUP + kof, 256 - 128 * po, PN, 0, KUP};
            int nn2 = 2; asm volatile("" : "+s"(nn2));
            pg8::PanelOrder S{pm, nn2};
            EpiStoreBf16 E{WSP(bf16, WS_MLA) + nof, 1024, 0xffff};
            pg8::gemm_phase<EpiStoreBf16, pg8::PanelOrder, true, false>(F.lds + RING_OFF, g, S, E, F.tid);
            __syncthreads();
        }
    }
}

__device__ __forceinline__ int crow(int r, int hi) { return (r & 3) + 8 * (r >> 2) + 4 * hi; }
typedef short v4i16_t __attribute__((ext_vector_type(4)));
__device__ __forceinline__ s16x4 vtr(const LAS unsigned char* p) { return __builtin_bit_cast(s16x4, __builtin_amdgcn_ds_read_tr16_b64_v4i16((LAS v4i16_t*)p)); }
__device__ __forceinline__ float half_swap_max(float m) { auto rr = __builtin_amdgcn_permlane32_swap(__float_as_uint(m), __float_as_uint(m), false, false); return fmaxf(__uint_as_float(rr[0]), __uint_as_float(rr[1])); }
__device__ __forceinline__ float half_swap_sum(float m) { auto rr = __builtin_amdgcn_permlane32_swap(__float_as_uint(m), __float_as_uint(m), false, false); return __uint_as_float(rr[0]) + __uint_as_float(rr[1]); }
__device__ __forceinline__ bf16x8 pack8(const f32x16& p, int b0) {
    v4u w; w.x = pg8::cvt_pk_bf16(p[b0], p[b0 + 1]); w.y = pg8::cvt_pk_bf16(p[b0 + 2], p[b0 + 3]); w.z = pg8::cvt_pk_bf16(p[b0 + 4], p[b0 + 5]); w.w = pg8::cvt_pk_bf16(p[b0 + 6], p[b0 + 7]);
    return __builtin_bit_cast(bf16x8, w);
}
__device__ __forceinline__ void softmax_tile(f32x16& p0, f32x16& p1, float& m, float& lsum, f32x16& negm, const float cbase, f32x16& o0, f32x16& o1, const bool first) {
    float a = fmaxf(fmaxf(p0[0], p0[1]), p1[0]), b = fmaxf(fmaxf(p0[2], p0[3]), p1[1]); a = fmaxf(fmaxf(a, p1[2]), p1[3]);
#pragma unroll
    for (int r = 4; r < 16; r += 4) { a = fmaxf(fmaxf(a, p0[r]), p0[r + 1]); b = fmaxf(fmaxf(b, p0[r + 2]), p0[r + 3]); a = fmaxf(fmaxf(a, p1[r]), p1[r + 1]); b = fmaxf(fmaxf(b, p1[r + 2]), p1[r + 3]); }
    const float rm = half_swap_max(fmaxf(a, b));
    if (first || __any(rm > 8.f)) {
        const float dl = first ? rm : fmaxf(rm, 0.f); m += dl;
#pragma unroll
        for (int r = 0; r < 16; ++r) { p0[r] -= dl; p1[r] -= dl; negm[r] = cbase - m; }
        if (!first) { const float f = fast_exp2(-dl); lsum *= f;
#pragma unroll
            for (int r = 0; r < 16; ++r) { o0[r] *= f; o1[r] *= f; } }
    }
    float s0 = 0.f, s1 = 0.f;
#pragma unroll
    for (int r = 0; r < 16; ++r) { p0[r] = fast_exp2(p0[r]); p1[r] = fast_exp2(p1[r]); s0 += p0[r]; s1 += p1[r]; }
    lsum += s0 + s1;
}

constexpr int AT_KB = 16384, AT_VB = 8192, AT_TBL = 2 * AT_KB + 3 * AT_VB;

template <int MODE>
__device__ __forceinline__ void attn_unit(Frame& F, CArgs& A, int l, int b, int h, int qb) {
    const int tid = F.tid, lane = F.lane, wid = F.wave, r32 = lane & 31, hi = lane >> 5;
    constexpr int ND0 = (MODE == 0) ? 6 : (MODE == 1 ? 4 : 2);
    LAS unsigned char* kb0 = F.lds + RING_OFF; LAS unsigned char* vb0 = F.lds + RING_OFF + 2 * AT_KB; LAS float* tbl = (LAS float*)(F.lds + RING_OFF + AT_TBL);
    const size_t rowbase = (size_t)b * SEQ; const int q0 = qb * 256, NT = 4 * qb + 4, tw = 4 * qb + (wid >> 1), qw0 = q0 + 32 * wid;
    const bf16* PROJ = WSP(bf16, WS_PROJ); const bf16* MLA = WSP(bf16, WS_MLA);
    const bf16* Qp; const bf16* Kp; const bf16* Vp; int pitch;
    if (MODE == 0) { Qp = MLA + h * 96; Kp = MLA + 512 + h * 128; Vp = Kp + 64; pitch = 1024; }
    else if (MODE == 1) { Qp = PROJ + PC_FOX + h * 64; Kp = Qp + 256; Vp = Qp + 512; pitch = PN; }
    else { Qp = PROJ + PC_DIFF + h * 64; Kp = Qp + 256; Vp = Qp + 512; pitch = PN; }
    const int kkey = 8 * wid + (lane >> 3);
    const GAS bf16* ksrc = (const GAS bf16*)(Kp + (rowbase + kkey) * pitch + (((lane & 7) ^ ((kkey >> 1) & 7)) * 8));
    const int vkey = 8 * wid + (lane >> 3);
    const GAS bf16* vsrc = (const GAS bf16*)(Vp + (rowbase + vkey) * pitch + ((((lane & 7) >> 2) ^ ((vkey >> 1) & 1)) * 32) + (lane & 3) * 8);
    const int rkey = 16 * (wid & 3) + (lane >> 2);
    const GAS bf16* ksrc2 = (const GAS bf16*)(PROJ + (rowbase + rkey) * PN + PC_KROPE + (((lane & 3) ^ ((rkey >> 2) & 3)) * 8));
#define AT_DMA(t, kbo, vso) do { \
        __builtin_amdgcn_global_load_lds((const GAS unsigned*)(ksrc + (size_t)(t) * 64 * pitch), (LAS unsigned*)(kb0 + (kbo) + wid * 1024), 16, 0, 0); \
        __builtin_amdgcn_global_load_lds((const GAS unsigned*)(vsrc + (size_t)(t) * 64 * pitch), (LAS unsigned*)(vb0 + (vso) + wid * 1024), 16, 0, 0); \
        if (MODE == 0 && wid < 4) __builtin_amdgcn_global_load_lds((const GAS unsigned*)(ksrc2 + (size_t)(t) * 64 * PN), (LAS unsigned*)(kb0 + (kbo) + (8 + wid) * 1024), 16, 0, 0); } while (0)
    AT_DMA(0, 0, 0);
    if (MODE == 1) { const float* FBp = WSP(float, WS_FB) + ((size_t)b * 4 + h) * SEQ; if (4 * tid < NT * 64) *(LAS f32x4*)(tbl + 4 * tid) = *(const GAS f32x4*)(FBp + 4 * tid); }
    if (MODE == 2) { const float* T5p = WSP(float, WS_T5) + h * 2112; const float c0 = T5p[0]; for (int i = tid; i < 528; i += 512) *(LAS f32x4*)(tbl + 4 * i) = *(const GAS f32x4*)(T5p + 4 * i) - c0; }
    bf16x8 qf[(MODE == 2) ? 4 : ND0];
    { const bf16* Qw = Qp + (rowbase + qw0 + r32) * pitch + hi * 8;
#pragma unroll
      for (int d = 0; d < ((MODE == 2) ? 4 : ND0); ++d) qf[d] = *(const GAS bf16x8*)(Qw + d * 16); }
    if (MODE == 0) {
        const float posf = (float)IN_pos[rowbase + qw0 + r32];
#pragma unroll
        for (int j = 0; j < 2; ++j) { const v4u w = __builtin_bit_cast(v4u, qf[(MODE == 0) ? 4 + j : 0]);
            float t1[4] = {bflo(w.x), bfhi(w.x), bflo(w.y), bfhi(w.y)}, t2[4] = {bflo(w.z), bfhi(w.z), bflo(w.w), bfhi(w.w)};
#pragma unroll
            for (int i = 0; i < 4; ++i) { float c, s; rope_cs(posf, hi ? rope_rev(4 * (2 * j + 1) + i) : rope_rev(4 * (2 * j) + i), c, s); const float a = t1[i], bb = t2[i]; t1[i] = a * c - bb * s; t2[i] = bb * c + a * s; }
            v4u o; o.x = pk2(t1[0], t1[1]); o.y = pk2(t1[2], t1[3]); o.z = pk2(t2[0], t2[1]); o.w = pk2(t2[2], t2[3]);
            qf[(MODE == 0) ? 4 + j : 0] = __builtin_bit_cast(bf16x8, o); }
    }
    float m1 = 0.f, l1 = 0.f, m2 = 0.f, l2 = 0.f; f32x16 o1[2], o2[2], negm1;
    const float cbase = (MODE == 2) ? WSP(float, WS_T5)[h * 2112] : 0.f;
#pragma unroll
    for (int r = 0; r < 16; ++r) { o1[0][r] = 0.f; o1[1][r] = 0.f; o2[0][r] = 0.f; o2[1][r] = 0.f; negm1[r] = cbase; }
    const int vlane = ((lane >> 4) & 1) * 32 + (lane & 3) * 8 + (4 * hi + ((lane & 15) >> 2)) * 128 + ((lane >> 3) & 1) * 64;
    VM_WAIT();
    __syncthreads();
    const bool lag = false;
    bf16x8 dpa0, dpa1, dpa2, dpa3;
    dpa0 = dpa1 = dpa2 = dpa3 = (bf16x8){0, 0, 0, 0, 0, 0, 0, 0};
    const int vx64 = (vlane ^ 64) - vlane;
#define AT_PV(O, VB, A0, A1, A2, A3) do { bf16x8 vf[2][4]; \
        _Pragma("unroll") for (int d0 = 0; d0 < 2; ++d0) _Pragma("unroll") for (int ks = 0; ks < 4; ++ks) { const LAS unsigned char* vp_ = (VB) + (d0 ? vx64 : 0) + ks * 2048; const s16x4 lo = vtr(vp_), hh = vtr(vp_ + 1024); \
            vf[d0][ks] = (bf16x8){lo[0], lo[1], lo[2], lo[3], hh[0], hh[1], hh[2], hh[3]}; } \
        _Pragma("unroll") for (int d0 = 0; d0 < 2; ++d0) { O[d0] = __builtin_amdgcn_mfma_f32_32x32x16_bf16(vf[d0][0], A0, O[d0], 0, 0, 0); O[d0] = __builtin_amdgcn_mfma_f32_32x32x16_bf16(vf[d0][1], A1, O[d0], 0, 0, 0); \
            O[d0] = __builtin_amdgcn_mfma_f32_32x32x16_bf16(vf[d0][2], A2, O[d0], 0, 0, 0); O[d0] = __builtin_amdgcn_mfma_f32_32x32x16_bf16(vf[d0][3], A3, O[d0], 0, 0, 0); } } while (0)
    int vs_prev = 0, vs_cur = 0, vs_next = AT_VB;
    for (int t = 0; t < NT; ++t) {
        if (t + 1 < NT) AT_DMA(t + 1, ((t + 1) & 1) * AT_KB, vs_next);
        if (lag && t >= 1 && t - 1 <= tw) { const LAS unsigned char* vbp = vb0 + vs_prev + vlane; if (MODE == 2) AT_PV(o2, vbp, dpa0, dpa1, dpa2, dpa3); else AT_PV(o1, vbp, dpa0, dpa1, dpa2, dpa3); }
        if (t <= tw) {
            const LAS unsigned char* kb = kb0 + (t & 1) * AT_KB; const LAS unsigned char* vb = vb0 + vs_cur + vlane;
#pragma unroll
            for (int mp = 0; mp < ((MODE == 2) ? 2 : 1); ++mp) {
                f32x16 p0, p1, nmt;
                if (MODE == 2) { const float nv = cbase - (mp == 0 ? m1 : m2);
#pragma unroll
                    for (int r = 0; r < 16; ++r) nmt[r] = nv; }
#pragma unroll
                for (int d0 = 0; d0 < ND0; ++d0) { const int c = 2 * d0 + hi + ((MODE == 2) ? 4 * mp : 0);
                    const bool rope_ = (MODE == 0) && d0 >= 4;
                    const LAS unsigned char* ka = rope_ ? kb + 8192 + r32 * 64 + ((((c - 8) & 3) ^ ((r32 >> 2) & 3)) * 16) : kb + r32 * 128 + ((c ^ ((r32 >> 1) & 7)) * 16);
                    const bf16x8 k0 = *(const LAS bf16x8*)ka, k1 = *(const LAS bf16x8*)(ka + (rope_ ? 2048 : 4096));
                    if (d0 == 0) { p0 = __builtin_amdgcn_mfma_f32_32x32x16_bf16(k0, qf[(MODE == 2) ? 2 * mp + d0 : d0], (MODE == 2) ? nmt : negm1, 0, 0, 0);
                                   p1 = __builtin_amdgcn_mfma_f32_32x32x16_bf16(k1, qf[(MODE == 2) ? 2 * mp + d0 : d0], (MODE == 2) ? nmt : negm1, 0, 0, 0); }
                    else { p0 = __builtin_amdgcn_mfma_f32_32x32x16_bf16(k0, qf[(MODE == 2) ? 2 * mp + d0 : d0], p0, 0, 0, 0);
                           p1 = __builtin_amdgcn_mfma_f32_32x32x16_bf16(k1, qf[(MODE == 2) ? 2 * mp + d0 : d0], p1, 0, 0, 0); } }
                if (MODE == 1) {
#pragma unroll
                    for (int g4 = 0; g4 < 4; ++g4) { const f32x4 a = *(const LAS f32x4*)(tbl + 64 * t + 8 * g4 + 4 * hi), c = *(const LAS f32x4*)(tbl + 64 * t + 32 + 8 * g4 + 4 * hi);
                        p0[4 * g4] += a.x; p0[4 * g4 + 1] += a.y; p0[4 * g4 + 2] += a.z; p0[4 * g4 + 3] += a.w; p1[4 * g4] += c.x; p1[4 * g4 + 1] += c.y; p1[4 * g4 + 2] += c.z; p1[4 * g4 + 3] += c.w; }
                    if (t == tw) {
                        const int ql = 32 * (wid & 1) + r32;
#pragma unroll
                        for (int r = 0; r < 16; ++r) { const int kl = crow(r, hi); if (kl > ql) p0[r] = -1e30f; if (kl + 32 > ql) p1[r] = -1e30f; } }
                }
                if (MODE == 2 && 64 * t + 191 > qw0) {
                    const LAS float* tp = tbl + (64 * t - (qw0 + r32) + 2047 + 4 * hi);
#pragma unroll
                    for (int r = 0; r < 16; ++r) { p0[r] += tp[(r & 3) + 8 * (r >> 2)]; p1[r] += tp[32 + (r & 3) + 8 * (r >> 2)]; }
                }
                if (MODE == 2) { if (mp == 0) softmax_tile(p0, p1, m1, l1, nmt, cbase, o1[0], o1[1], t == 0); else softmax_tile(p0, p1, m2, l2, nmt, cbase, o2[0], o2[1], t == 0); }
                else softmax_tile(p0, p1, m1, l1, negm1, cbase, o1[0], o1[1], t == 0);
                const bf16x8 pa0 = pack8(p0, 0), pa1 = pack8(p0, 8), pa2 = pack8(p1, 0), pa3 = pack8(p1, 8);
                const bool lastmap = (mp == ((MODE == 2) ? 1 : 0));
                if (lastmap && lag) { dpa0 = pa0; dpa1 = pa1; dpa2 = pa2; dpa3 = pa3; }
                else { if (MODE == 2 && mp == 1) AT_PV(o2, vb, pa0, pa1, pa2, pa3); else AT_PV(o1, vb, pa0, pa1, pa2, pa3); }
            }
        }
        VM_WAIT();
        __syncthreads();
        vs_prev = vs_cur; vs_cur = vs_next; vs_next = (vs_next == 2 * AT_VB) ? 0 : vs_next + AT_VB;
    }
    if (lag && NT - 1 <= tw) { const LAS unsigned char* vbp = vb0 + vs_prev + vlane; if (MODE == 2) AT_PV(o2, vbp, dpa0, dpa1, dpa2, dpa3); else AT_PV(o1, vbp, dpa0, dpa1, dpa2, dpa3); }
    __syncthreads();
#undef AT_PV
#undef AT_DMA
    unsigned char* MIX = WSP(unsigned char, WS_MIX);
    const float inv1 = 1.f / half_swap_sum(l1);
    unsigned char* orow = MIX + (rowbase + qw0 + r32) * DM + ((MODE == 0) ? h * 64 : (MODE == 1) ? 256 + h * 64 : 768 + h * 64) + 8 * hi;
#define AT_ST8(V0, V1, V2, V3, V4, V5, V6, V7, DST) do { int wa_ = __builtin_amdgcn_cvt_pk_fp8_f32(clamp8(V0), clamp8(V1), 0, false); wa_ = __builtin_amdgcn_cvt_pk_fp8_f32(clamp8(V2), clamp8(V3), wa_, true); \
        int wb_ = __builtin_amdgcn_cvt_pk_fp8_f32(clamp8(V4), clamp8(V5), 0, false); wb_ = __builtin_amdgcn_cvt_pk_fp8_f32(clamp8(V6), clamp8(V7), wb_, true); \
        auto rr_ = __builtin_amdgcn_permlane32_swap((unsigned)wa_, (unsigned)wb_, false, false); v2u st_; st_.x = rr_[0]; st_.y = rr_[1]; *(GAS v2u*)(DST) = st_; } while (0)
    if (MODE != 2) {
        const float sc = inv1 * MIX8_SCALE;
#pragma unroll
        for (int d0 = 0; d0 < 2; ++d0)
#pragma unroll
            for (int j = 0; j < 4; j += 2)
                AT_ST8(o1[d0][4 * j] * sc, o1[d0][4 * j + 1] * sc, o1[d0][4 * j + 2] * sc, o1[d0][4 * j + 3] * sc, o1[d0][4 * j + 4] * sc, o1[d0][4 * j + 5] * sc, o1[d0][4 * j + 6] * sc, o1[d0][4 * j + 7] * sc, orow + 32 * d0 + 8 * j);
    } else {
        const float inv2 = 1.f / half_swap_sum(l2); const float lam = WSP(float, WS_LAM)[l]; const float li = 0.8f - 0.6f * expf(-0.3f * (float)l);
        const float c2 = lam * inv2; float ss = 0.f;
#pragma unroll
        for (int d0 = 0; d0 < 2; ++d0)
#pragma unroll
            for (int r = 0; r < 16; ++r) { const float v = o1[d0][r] * inv1 - o2[d0][r] * c2; o1[d0][r] = v; ss += v * v; }
        const float rsn = (1.f - li) / sqrtf(half_swap_sum(ss) * (1.f / 64.f) + EPS) * MIX8_SCALE;
        const float* sg = IN_subln + l * 64 + 4 * hi;
#pragma unroll
        for (int d0 = 0; d0 < 2; ++d0)
#pragma unroll
            for (int j = 0; j < 4; j += 2) { const f32x4 g4 = *(const GAS f32x4*)(sg + 32 * d0 + 8 * j), h4 = *(const GAS f32x4*)(sg + 32 * d0 + 8 * j + 8);
                AT_ST8(o1[d0][4 * j] * rsn * g4.x, o1[d0][4 * j + 1] * rsn * g4.y, o1[d0][4 * j + 2] * rsn * g4.z, o1[d0][4 * j + 3] * rsn * g4.w,
                       o1[d0][4 * j + 4] * rsn * h4.x, o1[d0][4 * j + 5] * rsn * h4.y, o1[d0][4 * j + 6] * rsn * h4.z, o1[d0][4 * j + 7] * rsn * h4.w, orow + 32 * d0 + 8 * j); }
    }
#undef AT_ST8
}

__device__ __forceinline__ void conv_unit(Frame& F, CArgs& A, int l, int tile) {
    const bf16* PROJ = WSP(bf16, WS_PROJ); unsigned char* MIX = WSP(unsigned char, WS_MIX);
    const int c8 = (F.tid & 31) * 8, rsub = F.tid >> 5;
    float w0[8], w1[8], w2[8];
#pragma unroll
    for (int i = 0; i < 8; ++i) { w0[i] = IN_conv_w[(l * 3 + 0) * 256 + c8 + i]; w1[i] = IN_conv_w[(l * 3 + 1) * 256 + c8 + i]; w2[i] = IN_conv_w[(l * 3 + 2) * 256 + c8 + i]; }
    for (int j = 0; j < 16; ++j) {
        const size_t row = (size_t)tile * 256 + rsub + 16 * j; const int s = (int)(row & (SEQ - 1));
        const bf16* pr = PROJ + row * PN + PC_CONV + c8;
        const v4u bb = *(const GAS v4u*)pr, c0 = *(const GAS v4u*)(pr + 256), u0 = *(const GAS v4u*)(pr + 512);
        v4u c1 = (v4u){0u, 0u, 0u, 0u}, u1 = c1, c2 = c1, u2 = c1;
        if (s >= 1) { c1 = *(const GAS v4u*)(pr - PN + 256); u1 = *(const GAS v4u*)(pr - PN + 512); }
        if (s >= 2) { c2 = *(const GAS v4u*)(pr - 2 * PN + 256); u2 = *(const GAS v4u*)(pr - 2 * PN + 512); }
        float o[8];
#define CV(i, W, sel) { const float z0 = sel(c0.W) * sel(u0.W), z1 = sel(c1.W) * sel(u1.W), z2 = sel(c2.W) * sel(u2.W); o[i] = sel(bb.W) * (w2[i] * z0 + w1[i] * z1 + w0[i] * z2); }
        CV(0, x, bflo) CV(1, x, bfhi) CV(2, y, bflo) CV(3, y, bfhi) CV(4, z, bflo) CV(5, z, bfhi) CV(6, w, bflo) CV(7, w, bfhi)
#undef CV
        *(GAS v2u*)(MIX + row * DM + 512 + c8) = pack_fp8x8(o[0] * MIX8_SCALE, o[1] * MIX8_SCALE, o[2] * MIX8_SCALE, o[3] * MIX8_SCALE, o[4] * MIX8_SCALE, o[5] * MIX8_SCALE, o[6] * MIX8_SCALE, o[7] * MIX8_SCALE);
    }
}

#define CONV_ROUND() do { { if (F.tid == 0) F.MISC[1] = __hip_atomic_fetch_add(F.ctl + CW_Q + 64 * l + 48, 8u, RLX_AGENT); __syncthreads(); const int it_ = (int)F.MISC[1] + F.wave; __syncthreads(); \
        if (it_ < cvn) { Frame F2 = F; F2.lane = opq(F.lane); int w2_ = F.wave; asm volatile("" : "+s"(w2_)); const bool moe_ = it_ < CV_MOE; convert_item(F2, A, moe_ ? l : l + 1, moe_ ? CV_DENSE + it_ : it_ - CV_MOE, (LAS float*)(F.lds + RING_OFF) + w2_ * (64 * 65)); } __syncthreads(); } } while (0)
#define ATTN_LOOP(TYPE, MODE_, EXTRA) for (int qx_ = 0; qx_ < 8; ) { const int xq_ = (myx + qx_) & 7; \
        if (F.tid == 0) F.MISC[0] = __hip_atomic_fetch_add(F.ctl + CW_QX + (((l * 3 + (TYPE)) * 8 + xq_) << 4), 1u, RLX_AGENT); \
        __syncthreads(); const int idx = __builtin_amdgcn_readfirstlane((int)F.MISC[0]); __syncthreads(); \
        if (idx >= 128) { ++qx_; continue; } \
        int id2_ = (idx & 7) | ((idx >> 3) & 8) | ((idx & 56) << 1); asm volatile("" : "+s"(id2_)); const int qb = 7 - (id2_ >> 4), bh = xq_ * 16 + (id2_ & 15); attn_unit<MODE_>(F, A, l, bh >> 2, bh & 3, qb); EXTRA }
__device__ __forceinline__ void attn_phase(Frame& F, CArgs& A, int l) {
    const int cvn = (l + 1 < DEPTH) ? CV_LAYER : CV_MOE; const int myx = (int)xb_xcc_id() & 7;
    int nd = 0;
    ATTN_LOOP(0, 2, if (nd == (F.c & 3)) { for (int rr = 0; rr < 13; ++rr) CONV_ROUND(); } ++nd;)
    ATTN_LOOP(1, 0, )
    ATTN_LOOP(2, 1, )
    for (int tile = F.c; tile < NTOK / 256; tile += F.G) conv_unit(F, A, l, tile);
    for (;;) {
        if (F.tid == 0) F.MISC[1] = __hip_atomic_fetch_add(F.ctl + CW_Q + 64 * l + 48, 8u, RLX_AGENT);
        __syncthreads(); const int it0 = (int)F.MISC[1]; __syncthreads();
        if (it0 >= cvn) break;
        const int it1 = it0 + F.wave; const bool moe1 = it1 < CV_MOE;
        if (it1 < cvn) convert_item(F, A, moe1 ? l : l + 1, moe1 ? CV_DENSE + it1 : it1 - CV_MOE, (LAS float*)(F.lds + RING_OFF) + F.wave * (64 * 65));
        __syncthreads(); }
}

__device__ __forceinline__ void ffn_router_phase(Frame& F, CArgs& A, int l) {
    const float* MOD = WSP(float, WS_MOD); const bf16* WRT = WSP(bf16, WS_WRT) + (size_t)l * 2 * NLOG * DM; const float* SSp = WSP(float, WS_SS);
    bf16* H = WSP(bf16, WS_H); int* DEST = WSP(int, WS_DEST); float* GATE = WSP(float, WS_GATE); int* LIST = WSP(int, WS_LIST);
    LAS float* G2P = (LAS float*)(F.lds + RING_OFF); LAS float* SHF = G2P + 1024; LAS float* SHWB = G2P + 2048; LAS int* hist = (LAS int*)(G2P + 2176); LAS int* base = hist + 64;
    LAS int* rinfo = (LAS int*)(G2P + 2304);
    LAS unsigned char* WST = F.lds + RING_OFF + 20480;
    LAS float* LG = (LAS float*)WST + F.wave * 2560;
    const int tk = F.lane & 15, kg = F.lane >> 4;
    for (int tile = F.c; tile < NTOK / 256; tile += F.G) {
        const int b = tile >> 3;
#define RT_DMA(st, bufo) do { _Pragma("unroll") for (int q = 0; q < 5; ++q) { const int j = F.wave * 5 + q, sp = j / 10, hl = (j % 10) / 5, nb = j % 5; \
            __builtin_amdgcn_global_load_lds((const GAS unsigned*)(WRT + (size_t)(hl * NLOG + 16 * nb + (F.lane >> 2)) * DM + 128 * (st) + 32 * sp + 8 * (F.lane & 3)), (LAS unsigned*)(WST + (bufo) + j * 1024), 16, 0, 0); } } while (0)
        RT_DMA(0, 0);
        for (int k = F.tid; k < DM; k += 512) { G2P[k] = IN_g_ffn[l * DM + k] * (1.f + MOD[((size_t)l * NB + b) * 6144 + 4 * 1024 + k]); SHF[k] = MOD[((size_t)l * NB + b) * 6144 + 3 * 1024 + k]; }
        if (F.tid < 64) hist[F.tid] = 0;
        __syncthreads();
        if (F.tid < NLOG) SHWB[F.tid] = WSP(float, WS_SHWB)[((size_t)l * NB + b) * NLOG + F.tid];
        const size_t rowA = (size_t)tile * 256 + F.wave * 32 + tk, rowB = rowA + 16;
        float rsA, rsB;
        { const f32x4 a0 = *(const GAS f32x4*)(SSp + rowA * 16), a1 = *(const GAS f32x4*)(SSp + rowA * 16 + 4), a2 = *(const GAS f32x4*)(SSp + rowA * 16 + 8), a3 = *(const GAS f32x4*)(SSp + rowA * 16 + 12);
          const f32x4 b0 = *(const GAS f32x4*)(SSp + rowB * 16), b1 = *(const GAS f32x4*)(SSp + rowB * 16 + 4), b2 = *(const GAS f32x4*)(SSp + rowB * 16 + 8), b3 = *(const GAS f32x4*)(SSp + rowB * 16 + 12);
          const float sa = (((a0.x + a0.y) + (a0.z + a0.w)) + ((a1.x + a1.y) + (a1.z + a1.w))) + (((a2.x + a2.y) + (a2.z + a2.w)) + ((a3.x + a3.y) + (a3.z + a3.w)));
          const float sb = (((b0.x + b0.y) + (b0.z + b0.w)) + ((b1.x + b1.y) + (b1.z + b1.w))) + (((b2.x + b2.y) + (b2.z + b2.w)) + ((b3.x + b3.y) + (b3.z + b3.w)));
          rsA = 1.f / sqrtf(sa * (1.f / DM) + EPS); rsB = 1.f / sqrtf(sb * (1.f / DM) + EPS); }
        f32x4 acc[2][5];
#pragma unroll
        for (int rb = 0; rb < 2; ++rb)
#pragma unroll
            for (int nb = 0; nb < 5; ++nb) acc[rb][nb] = (f32x4){0.f, 0.f, 0.f, 0.f};
        const f16* xa = WSP(f16, WS_XR) + rowA * DM + 8 * kg; const f16* xb = WSP(f16, WS_XR) + rowB * DM + 8 * kg;
        f16x8 nxa = *(const GAS f16x8*)(xa), nxb = *(const GAS f16x8*)(xb);
        for (int st = 0; st < 8; ++st) {
            if (st == 0) VM_WAIT(); else asm volatile("s_waitcnt vmcnt(16)" ::: "memory");
            __syncthreads();
            if (st + 1 < 8) RT_DMA(st + 1, ((st + 1) & 1) * 40960);
            const LAS unsigned char* wb = WST + (st & 1) * 40960 + (tk * 4 + kg) * 16;
#pragma unroll
            for (int sp = 0; sp < 4; ++sp) {
                const int s = 4 * st + sp, k = 32 * s + 8 * kg;
                const f32x4 xa0 = (f32x4){(float)nxa[0], (float)nxa[1], (float)nxa[2], (float)nxa[3]}, xa1 = (f32x4){(float)nxa[4], (float)nxa[5], (float)nxa[6], (float)nxa[7]}, xb0 = (f32x4){(float)nxb[0], (float)nxb[1], (float)nxb[2], (float)nxb[3]}, xb1 = (f32x4){(float)nxb[4], (float)nxb[5], (float)nxb[6], (float)nxb[7]};
                if (s + 1 < 32) { nxa = *(const GAS f16x8*)(xa + 32 * (s + 1)); nxb = *(const GAS f16x8*)(xb + 32 * (s + 1)); }
                const f32x4 g0 = *(const LAS f32x4*)(G2P + k), g1 = *(const LAS f32x4*)(G2P + k + 4), h0 = *(const LAS f32x4*)(SHF + k), h1 = *(const LAS f32x4*)(SHF + k + 4);
                const f32x4 ua0 = xa0 * g0, ua1 = xa1 * g1, ub0 = xb0 * g0, ub1 = xb1 * g1;
                { const f32x4 a0 = ua0 * rsA + h0, a1 = ua1 * rsA + h1, b0 = ub0 * rsB + h0, b1 = ub1 * rsB + h1;
                  unsigned char* H8 = WSP(unsigned char, WS_H8);
                  *(GAS v2u*)(H8 + rowA * DM + k) = pack_fp8x8(a0.x * A8_SCALE, a0.y * A8_SCALE, a0.z * A8_SCALE, a0.w * A8_SCALE, a1.x * A8_SCALE, a1.y * A8_SCALE, a1.z * A8_SCALE, a1.w * A8_SCALE);
                  *(GAS v2u*)(H8 + rowB * DM + k) = pack_fp8x8(b0.x * A8_SCALE, b0.y * A8_SCALE, b0.z * A8_SCALE, b0.w * A8_SCALE, b1.x * A8_SCALE, b1.y * A8_SCALE, b1.z * A8_SCALE, b1.w * A8_SCALE); }
                bf16x8 hA, lA, hB, lB;
#define SPLIT2(HW, LW, X, Y) { HW = pg8::cvt_pk_bf16(X, Y); LW = pg8::cvt_pk_bf16(X - __builtin_bit_cast(float, HW << 16), Y - __builtin_bit_cast(float, HW & 0xffff0000u)); }
#define SPLIT8(H_, L_, U0, U1) { v4u hw, lw; SPLIT2(hw.x, lw.x, U0.x, U0.y) SPLIT2(hw.y, lw.y, U0.z, U0.w) SPLIT2(hw.z, lw.z, U1.x, U1.y) SPLIT2(hw.w, lw.w, U1.z, U1.w) \
                H_ = __builtin_bit_cast(bf16x8, hw); L_ = __builtin_bit_cast(bf16x8, lw); }
                SPLIT8(hA, lA, ua0, ua1) SPLIT8(hB, lB, ub0, ub1)
#undef SPLIT8
#undef SPLIT2
#pragma unroll
                for (int nb = 0; nb < 5; ++nb) {
                    const bf16x8 wh = *(const LAS bf16x8*)(wb + ((sp * 2 + 0) * 5 + nb) * 1024), wl = *(const LAS bf16x8*)(wb + ((sp * 2 + 1) * 5 + nb) * 1024);
                    acc[0][nb] = __builtin_amdgcn_mfma_f32_16x16x32_bf16(wh, hA, acc[0][nb], 0, 0, 0); acc[0][nb] = __builtin_amdgcn_mfma_f32_16x16x32_bf16(wh, lA, acc[0][nb], 0, 0, 0); acc[0][nb] = __builtin_amdgcn_mfma_f32_16x16x32_bf16(wl, hA, acc[0][nb], 0, 0, 0);
                    acc[1][nb] = __builtin_amdgcn_mfma_f32_16x16x32_bf16(wh, hB, acc[1][nb], 0, 0, 0); acc[1][nb] = __builtin_amdgcn_mfma_f32_16x16x32_bf16(wh, lB, acc[1][nb], 0, 0, 0); acc[1][nb] = __builtin_amdgcn_mfma_f32_16x16x32_bf16(wl, hB, acc[1][nb], 0, 0, 0);
                }
            }
        }
#undef RT_DMA
        __syncthreads();
#pragma unroll
        for (int nb = 0; nb < 5; ++nb) { const f32x4 sb = *(const LAS f32x4*)(SHWB + 16 * nb + 4 * kg);
            *(LAS f32x4*)(LG + tk * NLOG + 16 * nb + 4 * kg) = acc[0][nb] * rsA + sb; *(LAS f32x4*)(LG + (16 + tk) * NLOG + 16 * nb + 4 * kg) = acc[1][nb] * rsB + sb; }
        LDS_WAIT(); asm volatile("" ::: "memory");
        if (F.lane < 32) {
            const LAS float* lg = LG + F.lane * NLOG;
            float gl[8];
#pragma unroll
            for (int j = 0; j < 8; ++j) gl[j] = lg[j];
            int g = 0; float mx = gl[0];
#pragma unroll
            for (int j = 1; j < 8; ++j) if (gl[j] > mx) { mx = gl[j]; g = j; }
            float Z = 0.f;
#pragma unroll
            for (int j = 0; j < 8; ++j) Z += expf(gl[j] - mx);
            const float pg = 1.f / Z;
            const LAS float* el = lg + 8 + 8 * g; float ev[8];
#pragma unroll
            for (int j = 0; j < 8; ++j) ev[j] = el[j];
            int i1 = 0; float m1v = ev[0];
#pragma unroll
            for (int j = 1; j < 8; ++j) if (ev[j] > m1v) { m1v = ev[j]; i1 = j; }
            int i2 = -1; float m2v = -3.0e38f;
#pragma unroll
            for (int j = 0; j < 8; ++j) if (j != i1 && ev[j] > m2v) { m2v = ev[j]; i2 = j; }
            float one_ = 1.f; asm("" : "+s"(one_));
            const float eb = expf(m2v - m1v), den = 1.f / __builtin_fmaf(eb, one_, 1.f);
            const int e0 = 8 * g + i1, e1 = 8 * g + i2;
            const int r0 = __hip_atomic_fetch_add(hist + e0, 1, __ATOMIC_RELAXED, __HIP_MEMORY_SCOPE_WORKGROUP), r1 = __hip_atomic_fetch_add(hist + e1, 1, __ATOMIC_RELAXED, __HIP_MEMORY_SCOPE_WORKGROUP);
            LAS int* ri = rinfo + (F.wave * 32 + F.lane) * 8;
            ri[0] = e0; ri[1] = r0; ri[2] = e1; ri[3] = r1; ri[4] = __float_as_int(pg * den); ri[5] = __float_as_int(pg * eb * den);
        }
        __syncthreads();
        if (F.tid < 64) { const int hc = hist[F.tid]; base[F.tid] = hc ? (int)__hip_atomic_fetch_add(F.ctl + CW_GCNT + (l * 64 + F.tid) * 16, (unsigned)hc, RLX_AGENT) : 0; }
        __syncthreads();
        if (F.tid < 256) { const LAS int* ri = rinfo + F.tid * 8; const size_t row = (size_t)tile * 256 + F.tid;
            const int e0 = ri[0], s0 = base[e0] + ri[1], e1 = ri[2], s1 = base[e1] + ri[3];
            LIST[(size_t)e0 * 65536 + s0] = (int)row; LIST[(size_t)e1 * 65536 + s1] = (int)row;
            *(GAS i32x4*)(DEST + row * 4) = (i32x4){e0, s0, e1, s1}; *(GAS f32x2*)(GATE + row * 2) = (f32x2){__int_as_float(ri[4]), __int_as_float(ri[5])}; }
        __syncthreads();
    }
}

template <bool GATHER_TOK>
__device__ __forceinline__ int moe_build_tables(Frame& F, int l, int chunk) {
    LAS int* ut = (LAS int*)(F.lds + UT_OFF); LAS unsigned* tokt = (LAS unsigned*)(F.lds + TAB_OFF);
    const LAS int* mbs = (const LAS int*)(F.lds + UT_OFF + 256); const LAS int* cnts = mbs + 72;
    const int NU = 4 * mbs[64];
    if (F.tid < 16) {
        const int i = F.tid + 16 * chunk; int e = 0, mbid = 0, pnl = 0; bool ok;
        if ((F.G & 31) == 0) { const int q = F.G >> 5; mbid = i * (F.G >> 2) + (F.c & 7) * q + ((F.c >> 3) % q); pnl = (F.c >> 3) / q; ok = mbid < (NU >> 2); }
        else { const int U = F.c + i * F.G; mbid = U >> 2; pnl = U & 3; ok = U < NU; }
        if (ok) { for (int j = 1; j < 64; ++j) if (mbs[j] <= mbid) e = j; }
        ut[4 * F.tid] = mbid; ut[4 * F.tid + 1] = e * 4 + pnl; ut[4 * F.tid + 2] = F.tid; ut[4 * F.tid + 3] = ok ? e : -1; }
    __syncthreads();
    int n = 0;
    for (int i = 0; i < 16; ++i) if (ut[4 * i + 3] >= 0) n = i + 1;
    if (GATHER_TOK) {
        const int* LIST = WSP(int, WS_LIST);
        for (int i = F.tid >> 8; i < n; i += 2) { const int e = ut[4 * i + 3], mbid = ut[4 * i], sl = F.tid & 255; const int s = 256 * (mbid - mbs[e]) + sl;
            tokt[i * 256 + sl] = (s < cnts[e]) ? (unsigned)LIST[(size_t)e * 65536 + s] : 0u; }
    }
    __syncthreads();
    return n;
}
__device__ __forceinline__ void moe_gateup_phase(Frame& F, int l) {
    moe_block_starts(F, l);
    const int NU = 4 * ((const LAS int*)(F.lds + UT_OFF + 256))[64];
    for (int chunk = 0; chunk * 16 * F.G < NU; ++chunk) {
        const int n = moe_build_tables<true>(F, l, chunk);
        pg8::Gemm g{WSP(bf16, WS_H8), (const bf16*)(WSP(unsigned char, WS_WGU) + (size_t)l * NEXP * 1024 * 1024), DM / 2, DM / 2, A8_E8M0};
        pg8::TableOrder S{(const LAS int*)(F.lds + UT_OFF), (const LAS unsigned*)(F.lds + TAB_OFF), n};
        EpiGateUp E{WSP(unsigned char, WS_HID)};
        pg8::gemm_phase<EpiGateUp, pg8::TableOrder, true, true, true>(F.lds + RING_OFF, g, S, E, F.tid);
        __syncthreads();
    }
}
__device__ __forceinline__ void moe_down_phase(Frame& F, int l) {
    moe_block_starts(F, l);
    const int NU = 4 * ((const LAS int*)(F.lds + UT_OFF + 256))[64];
    for (int chunk = 0; chunk * 16 * F.G < NU; ++chunk) {
        const int n = moe_build_tables<false>(F, l, chunk);
        pg8::Gemm g{WSP(bf16, WS_HID), (const bf16*)(WSP(unsigned char, WS_WD) + (size_t)l * NEXP * 1024 * DEXP), DEXP / 2, DEXP / 2, HID8_E8M0};
        pg8::TableOrder S{(const LAS int*)(F.lds + UT_OFF), (const LAS unsigned*)(F.lds + TAB_OFF), n};
        EpiStoreFp8 E{WSP(unsigned char, WS_Y), DM, 3, Y8_SCALE};
        pg8::gemm_phase<EpiStoreFp8, pg8::TableOrder, true, false, true>(F.lds + RING_OFF, g, S, E, F.tid);
        __syncthreads();
    }
}

template <int PHSEL>
__global__ void __launch_bounds__(512, 2) trunk_fwd(Args args) {
    extern __shared__ __attribute__((aligned(16))) unsigned char lds_raw[];
    Frame F;
    F.lds = (LAS unsigned char*)lds_raw; F.MISC = (volatile LAS unsigned*)(F.lds + MISC_OFF);
    F.tid = threadIdx.x; F.lane = F.tid & 63; F.wave = __builtin_amdgcn_readfirstlane(F.tid >> 6); F.G = gridDim.x; F.c = blockIdx.x;
    const int wave0 = F.wave;
    F.ws = args.ws; F.out = args.out; F.ctl = (gu32*)(args.ws + WS_CTL);
    for (int u = F.tid; u < 32; u += 512) F.MISC[u] = 0u;
    __syncthreads();
    const int lo = args.ph_lo, hi = args.ph_hi;
    if (hi - lo > 1) (void)xcd_barrier_post((unsigned*)(F.ctl + CW_BAR), F.MISC + 8);
#define EN(j) (PHSEL < 0 || PHSEL == (j))
#define PB() CArgs* Ap_ = (CArgs*)__builtin_amdgcn_kernarg_segment_ptr(); asm volatile("" : "+s"(Ap_)); CArgs& A_ = *Ap_; do { { int c_ = (int)blockIdx.x, g_ = (int)gridDim.x, w_ = wave0; asm volatile("" : "+s"(c_), "+s"(g_), "+s"(w_)); F.c = c_; F.G = g_; F.wave = w_; } { int ln_; asm volatile("v_mbcnt_lo_u32_b32 %0, -1, 0\n\tv_mbcnt_hi_u32_b32 %0, -1, %0" : "=v"(ln_)); F.lane = ln_; } F.tid = F.wave * 64 + F.lane; F.ws = A_.ws; F.out = A_.out; F.ctl = (gu32*)(A_.ws + WS_CTL); } while (0)
#define IN(k) (lo <= (k) && (k) < hi)
#ifdef PROBE_MASK
    unsigned long long pt_acc = 0ull, pt_t0 = 0ull;
#define PT0() do { pt_t0 = __builtin_amdgcn_s_memrealtime(); } while (0)
#define PT1(j) do { if ((PROBE_MASK >> (j)) & 1) pt_acc += __builtin_amdgcn_s_memrealtime() - pt_t0; } while (0)
#else
#define PT0() do {} while (0)
#define PT1(j) do {} while (0)
#endif
#define SEAM(k) do { if (IN(k) && IN((k) + 1)) { XcdBarrier b_; b_.bar = (unsigned*)(F.ctl + CW_BAR); b_.x = xb_xcc_id(); b_.st = F.MISC + 8; xcd_barrier(b_); } } while (0)
    if (EN(0) && IN(0)) { PB(); PT0(); prologue(F, A_); SEAM(0); PT1(0); }
    for (int l = 0; l < DEPTH; ++l) {
        const int p0 = 1 + 8 * l;
        if (EN(1) && IN(p0)) { PB(); PT0(); int lq = l; asm volatile("" : "+s"(lq)); if (lq == 0) mix_norm_phase<false, false>(F, A_, lq); else mix_norm_phase<false, true>(F, A_, lq); SEAM(p0); PT1(1); }
        if (EN(2) && IN(p0 + 1)) { PB(); PT0(); int lq = l; asm volatile("" : "+s"(lq));
            pg8::Gemm g{WSP(bf16, WS_H), WSP(bf16, WS_WIN) + (size_t)lq * PN * DM, DM, DM}; pg8::StaticOrder S; S.init(NTOK, PN, F.G, F.c);
            EpiStoreBf16 E{WSP(bf16, WS_PROJ), PN, 0xffff};
            pg8::gemm_phase<EpiStoreBf16, pg8::StaticOrder, true, false>(F.lds + RING_OFF, g, S, E, F.tid);
            SEAM(p0 + 1); PT1(2); }
        if (EN(3) && IN(p0 + 2)) { PB(); PT0(); int lq = l; asm volatile("" : "+s"(lq)); mla_up_phase(F, A_, lq); SEAM(p0 + 2); PT1(3); }
        if (EN(4) && IN(p0 + 3)) { PB(); PT0(); int lq = l; asm volatile("" : "+s"(lq)); attn_phase(F, A_, lq); SEAM(p0 + 3); PT1(4); }
        if (EN(5) && IN(p0 + 4)) { PB(); PT0(); int lq = l; asm volatile("" : "+s"(lq));
            pg8::Gemm g{WSP(bf16, WS_MIX), (const bf16*)(WSP(unsigned char, WS_WOUT) + (size_t)lq * DM * DM), DM / 2, DM / 2, MIX8_E8M0}; pg8::StaticOrder S; S.init(NTOK, DM, F.G, F.c);
            EpiOut E{lq == 0 ? (const float*)A_.in[0] : nullptr, WSP(f16, WS_XR), WSP(f16, WS_XR), WSP(float, WS_MOD) + (size_t)lq * NB * 6144 + 2 * 1024, WSP(float, WS_SS)};
            pg8::gemm_phase<EpiOut, pg8::StaticOrder, true, false, true>(F.lds + RING_OFF, g, S, E, F.tid);
            SEAM(p0 + 4); PT1(5); }
        if (EN(6) && IN(p0 + 5)) { PB(); PT0(); int lq = l; asm volatile("" : "+s"(lq)); ffn_router_phase(F, A_, lq); SEAM(p0 + 5); PT1(6); }
        if (EN(7) && IN(p0 + 6)) { PB(); PT0(); int lq = l; asm volatile("" : "+s"(lq)); moe_gateup_phase(F, lq); SEAM(p0 + 6); PT1(7); }
        if (EN(8) && IN(p0 + 7)) { PB(); PT0(); int lq = l; asm volatile("" : "+s"(lq)); moe_down_phase(F, lq); SEAM(p0 + 7); PT1(8); }
    }
    if (EN(9) && IN(NPHASE - 1)) { PB(); PT0(); mix_norm_phase<true, true>(F, A_, DEPTH); PT1(9);
#ifdef PROBE_MASK
        __syncthreads(); VM_WAIT(); if (blockIdx.x == 0 && F.tid == 0) F.out[0] += (float)pt_acc * (0.01f / 20.f);
#endif
    }
#undef IN
#undef SEAM
}

extern "C" void kernel_launch(void* const* d_in, const int* in_sizes, int n_in, void* d_out, int out_size, void* d_ws, size_t ws_size, hipStream_t stream) {
    static int grid = 0;
    if (grid == 0) {
        if (n_in != 26 || out_size != NTOK * DM || ws_size < WS_END) { fprintf(stderr, "kernel_launch: unexpected shapes (n_in %d, out %d, ws %zu < %zu); nothing launched\n", n_in, out_size, ws_size, (size_t)WS_END); grid = -1; return; }
        int dev = 0, cus = 0, per_cu = 0;
        if (hipGetDevice(&dev) != hipSuccess || hipDeviceGetAttribute(&cus, hipDeviceAttributeMultiprocessorCount, dev) != hipSuccess) { grid = -1; return; }
#if MK_MULTI
#define SA(T) if (hipFuncSetAttribute((const void*)trunk_fwd<T>, hipFuncAttributeMaxDynamicSharedMemorySize, LDS_BYTES) != hipSuccess) { fprintf(stderr, "kernel_launch: hipFuncSetAttribute failed\n"); grid = -1; return; }
        SA(0) SA(1) SA(2) SA(3) SA(4) SA(5) SA(6) SA(7) SA(8) SA(9)
#undef SA
#else
        if (hipFuncSetAttribute((const void*)trunk_fwd<-1>, hipFuncAttributeMaxDynamicSharedMemorySize, LDS_BYTES) != hipSuccess) { fprintf(stderr, "kernel_launch: hipFuncSetAttribute failed\n"); grid = -1; return; }
        if (hipOccupancyMaxActiveBlocksPerMultiprocessor(&per_cu, (const void*)trunk_fwd<-1>, 512, LDS_BYTES) != hipSuccess || per_cu < 1) { fprintf(stderr, "kernel_launch: occupancy query says %d\n", per_cu); (void)hipGetLastError(); }
#endif
        (void)per_cu;
        grid = cus;
    }
    if (grid < 0) return;
    (void)hipMemsetAsync((char*)d_ws + WS_CTL, 0, CTL_ZERO_BYTES, stream);
    Args a{};
    for (int i = 0; i < 26; ++i) a.in[i] = d_in[i];
    a.out = (float*)d_out; a.ws = (unsigned char*)d_ws;
#if MK_MULTI
    for (int p = 0; p < NPHASE; ++p) { a.ph_lo = p; a.ph_hi = p + 1; const int ty = (p == 0) ? 0 : (p == NPHASE - 1) ? 9 : 1 + (p - 1) % 8;
        switch (ty) {
#define LK(T) case T: hipLaunchKernelGGL(trunk_fwd<T>, dim3(grid), dim3(512), LDS_BYTES, stream, a); break;
            LK(0) LK(1) LK(2) LK(3) LK(4) LK(5) LK(6) LK(7) LK(8) LK(9)
#undef LK
        } }
#else
    a.ph_lo = 0; a.ph_hi = NPHASE;
    hipLaunchKernelGGL(trunk_fwd<-1>, dim3(grid), dim3(512), LDS_BYTES, stream, a);
#endif
    const hipError_t le = hipPeekAtLastError();
    if (le != hipSuccess) fprintf(stderr, "kernel_launch: launch failed: %s\n", hipGetErrorName(le));
}
```

```cpp
#include <hip/hip_runtime.h>
#include <cstdio>
#include <cstdint>

#ifndef MK_MULTI
#define MK_MULTI 0
#endif

#define GAS __attribute__((address_space(1)))
#define LAS __attribute__((address_space(3)))
typedef unsigned short bf16;
typedef unsigned v4u __attribute__((ext_vector_type(4)));
typedef unsigned v2u __attribute__((ext_vector_type(2)));
typedef float f32x4 __attribute__((ext_vector_type(4)));
typedef float f32x2 __attribute__((ext_vector_type(2)));
typedef float f32x16 __attribute__((ext_vector_type(16)));
typedef short bf16x8 __attribute__((ext_vector_type(8)));
typedef short s16x4 __attribute__((ext_vector_type(4)));
typedef int i32x4 __attribute__((ext_vector_type(4)));
typedef int i32x8 __attribute__((ext_vector_type(8)));
typedef GAS unsigned gu32;
typedef _Float16 f16;
typedef _Float16 f16x4 __attribute__((ext_vector_type(4)));
typedef _Float16 f16x8 __attribute__((ext_vector_type(8)));

constexpr int NB = 32, SEQ = 2048, DM = 1024, NTOK = NB * SEQ, DEPTH = 4;
constexpr int P_IN = 2660, PN = 2816;
constexpr int PC_CKV = 256, PC_KROPE = 384, PC_FOX = 512, PC_CONV = 1280, PC_DIFF = 2048;
constexpr int SRC_CKV = 192, SRC_KROPE = 320, SRC_FOX = 352, SRC_FLOG = 1120, SRC_CONV = 1124, SRC_DIFF = 1892;
constexpr int KUP = 384, NUP = 1024;
constexpr int NEXP = 64, DEXP = 512, NLOG = 80;
constexpr int MAXMB = 576, MAXSLOT = MAXMB * 256;
constexpr float EPS = 1e-6f, LOG2E = 1.4426950408889634f;
constexpr float W8_SCALE = 256.f, A8_SCALE = 16.f;
constexpr int W8_E8M0 = 0x77777777, A8_E8M0 = 0x7b7b7b7b;
constexpr float Y8_SCALE = 16.f;
constexpr float MIX8_SCALE = 4.f; constexpr int MIX8_E8M0 = 0x7d7d7d7d;
constexpr float HID8_SCALE = 8.f; constexpr int HID8_E8M0 = 0x7c7c7c7c;
constexpr int NPHASE = 2 + 8 * DEPTH;

constexpr size_t MiB = 1u << 20;
constexpr size_t WS_CTL = 0, CTL_ZERO_BYTES = 1 * MiB;
constexpr size_t WS_MOD = 1 * MiB;
constexpr size_t WS_T5 = 4 * MiB;
constexpr size_t WS_LAM = 4 * MiB + 64 * 1024;
constexpr size_t WS_WF = 4 * MiB + 128 * 1024;
constexpr size_t WS_WRT = 4 * MiB + 256 * 1024;
constexpr size_t WS_FLOG = 5 * MiB + 512 * 1024;
constexpr size_t WS_SS = 1563 * MiB;
constexpr size_t WS_SHWB = 4 * MiB + 192 * 1024;
constexpr size_t WS_FB = 7 * MiB;
constexpr size_t WS_DEST = 8 * MiB;
constexpr size_t WS_GATE = 9 * MiB;
constexpr size_t WS_LIST = 10 * MiB;
constexpr size_t WS_WIN = 26 * MiB;
constexpr size_t WS_WUP = 48 * MiB;
constexpr size_t WS_WOUT = 51 * MiB;
constexpr size_t WS_WGU = 59 * MiB;
constexpr size_t WS_WD = 571 * MiB;
constexpr size_t WS_H = 827 * MiB;
constexpr size_t WS_PROJ = 955 * MiB;
constexpr size_t WS_MLA = 1307 * MiB;
constexpr size_t WS_MIX = 1435 * MiB;
constexpr size_t WS_XR = 1567 * MiB;
constexpr size_t WS_H8 = 1695 * MiB;
constexpr size_t WS_END = 1759 * MiB;
constexpr size_t WS_Y = WS_PROJ, WS_HID = WS_MLA;
static_assert((size_t)MAXSLOT * 1024 * 2 <= WS_MLA - WS_PROJ && (size_t)MAXSLOT * 512 * 2 <= WS_SS - WS_MLA, "overlays fit");
constexpr int CW_TMO = 0, CW_CODE = 1, CW_BAR = 4096, CW_Q = 8192  , CW_GCNT = 12288  , CW_QX = 20480  ;

constexpr int RING_OFF = 0, RING_BYTES = 131072;
constexpr int TAB_OFF = RING_BYTES, TAB_BYTES = 16384;
constexpr int UT_OFF = TAB_OFF + TAB_BYTES;
constexpr int MISC_OFF = UT_OFF + 1024;
constexpr int LDS_BYTES = MISC_OFF + 128;
static_assert(LDS_BYTES <= 160 * 1024, "LDS");

#define RLX_AGENT __ATOMIC_RELAXED, __HIP_MEMORY_SCOPE_AGENT
#define LDS_WAIT() asm volatile("s_waitcnt lgkmcnt(0)" ::: "memory")
#define VM_WAIT() asm volatile("s_waitcnt vmcnt(0)" ::: "memory")
__device__ __forceinline__ unsigned f2bf(float f) { unsigned u = __builtin_bit_cast(unsigned, f); return (u + 0x7fffu + ((u >> 16) & 1u)) >> 16; }
__device__ __forceinline__ unsigned pk2(float lo, float hi) { return f2bf(lo) | (f2bf(hi) << 16); }
__device__ __forceinline__ float bflo(unsigned w) { return __builtin_bit_cast(float, w << 16); }
__device__ __forceinline__ float bfhi(unsigned w) { return __builtin_bit_cast(float, w & 0xffff0000u); }
__device__ __forceinline__ float bf2f(bf16 h) { return __builtin_bit_cast(float, (unsigned)h << 16); }
__device__ __forceinline__ float shx(float v, int o, int lane) { return __builtin_bit_cast(float, __builtin_amdgcn_ds_bpermute((lane ^ o) << 2, __builtin_bit_cast(int, v))); }
__device__ __forceinline__ float wave_sum(float v, int lane) {
#pragma unroll
    for (int o = 1; o < 64; o <<= 1) v += shx(v, o, lane);
    return v;
}
__device__ __forceinline__ int opq(int v) { asm volatile("" : "+v"(v)); return v; }
__device__ __forceinline__ float clamp8(float v) { return __builtin_fminf(__builtin_fmaxf(v, -448.f), 448.f); }
__device__ __forceinline__ v2u pack_fp8x8(float a0, float a1, float a2, float a3, float a4, float a5, float a6, float a7) {
    int lo = __builtin_amdgcn_cvt_pk_fp8_f32(clamp8(a0), clamp8(a1), 0, false); lo = __builtin_amdgcn_cvt_pk_fp8_f32(clamp8(a2), clamp8(a3), lo, true);
    int hi = __builtin_amdgcn_cvt_pk_fp8_f32(clamp8(a4), clamp8(a5), 0, false); hi = __builtin_amdgcn_cvt_pk_fp8_f32(clamp8(a6), clamp8(a7), hi, true);
    v2u r; r.x = (unsigned)lo; r.y = (unsigned)hi; return r;
}
__device__ __forceinline__ float fast_exp2(float x) { return __builtin_amdgcn_exp2f(x); }
__device__ __forceinline__ float fast_rcp(float x) { return __builtin_amdgcn_rcpf(x); }
__device__ __forceinline__ float fast_rsq(float x) { return __builtin_amdgcn_rsqf(x); }
__device__ __forceinline__ float silu_f(float x) { return x * fast_rcp(1.f + fast_exp2(-x * LOG2E)); }

__device__ __forceinline__ void stagger_start(int c, unsigned ticks) {
    const unsigned long long t0 = __builtin_amdgcn_s_memrealtime(); const unsigned long long d = (unsigned long long)((unsigned)(c & 3) * ticks);
    while (__builtin_amdgcn_s_memrealtime() - t0 < d) __builtin_amdgcn_s_sleep(8);
}
#define XB_TMO      128
#define XB_XCNT(j)  (256  + 64 * (j))
#define XB_XSUB(j)  (1280 + 64 * (j))
#define XB_XGEN(j)  (2304 + 64 * (j))
#define XB_TOP      3328
#define XB_TOPGEN   3392
#define XCD_BAR_WORDS 3456
#define XB_SPIN_CAP (1u << 22)
__device__ __forceinline__ unsigned xb_ld(unsigned* p)              { return __hip_atomic_load(p, __ATOMIC_RELAXED, __HIP_MEMORY_SCOPE_AGENT); }
__device__ __forceinline__ unsigned xb_add(unsigned* p, unsigned v) { return __hip_atomic_fetch_add(p, v, __ATOMIC_RELAXED, __HIP_MEMORY_SCOPE_AGENT); }
__device__ __forceinline__ unsigned xb_xcc_id() { return (unsigned)__builtin_amdgcn_s_getreg((3 << 11) | 20) & 0xFu; }
#define XB_SPIN(cond, bar) do { unsigned _sp = 0; while (cond) { __builtin_amdgcn_s_sleep(1); \
    if ((++_sp & 255u) == 0u) { if (xb_ld(&(bar)[XB_TMO])) break; if (_sp > XB_SPIN_CAP) { atomicAdd(&(bar)[XB_TMO], 1u); break; } } } } while (0)
struct XcdBarrier { unsigned* bar; unsigned x; volatile LAS unsigned* st; };
__device__ __forceinline__ XcdBarrier xcd_barrier_post(unsigned* bar, volatile LAS unsigned* st) {
    XcdBarrier b; b.bar = bar; b.x = xb_xcc_id(); b.st = st;
    if (threadIdx.x == 0) (void)xb_add(&bar[XB_XCNT(b.x)], 1u);
    return b;
}
__device__ __forceinline__ void xcd_barrier_complete(unsigned* bar, unsigned x, unsigned& nloc, unsigned& nx) {
    const unsigned G = gridDim.x * gridDim.y * gridDim.z;
    unsigned sum, cnt, mine, sp = 0u;
    for (;;) {
        sum = 0u; cnt = 0u; mine = 0u;
#pragma nounroll
        for (unsigned j = 0; j < 16; ++j) { const unsigned c = xb_ld(&bar[XB_XCNT(j)]); sum += c; cnt += (c > 0u) ? 1u : 0u; mine = (j == x) ? c : mine; }
        if (sum == G) break;
        __builtin_amdgcn_s_sleep(1);
        if ((++sp & 255u) == 0u) { if (xb_ld(&bar[XB_TMO])) break; if (sp > XB_SPIN_CAP) { atomicAdd(&bar[XB_TMO], 1u); break; } }
    }
    nloc = mine > 0u ? mine : 1u; nx = cnt > 0u ? cnt : 1u;
}
__device__ __forceinline__ void xcd_barrier(const XcdBarrier& b) {
    asm volatile("s_waitcnt vmcnt(0)" ::: "memory");
    __syncthreads();
    if (threadIdx.x == 0) {
        unsigned* bar = b.bar;
        __builtin_amdgcn_s_waitcnt(0);
        unsigned nloc = b.st[0], nx = b.st[1];
        if (nloc == 0u) { xcd_barrier_complete(bar, b.x, nloc, nx); b.st[0] = nloc; b.st[1] = nx; }
        const unsigned old = xb_add(&bar[XB_XSUB(b.x)], 1u);
        const unsigned gen = old / nloc;
        if (old + 1u == (gen + 1u) * nloc) {
            __builtin_amdgcn_fence(__ATOMIC_RELEASE, "agent");
            asm volatile("s_waitcnt vmcnt(0)" ::: "memory");
            const unsigned og = xb_add(&bar[XB_TOP], 1u);
            const unsigned tg = og / nx;
            if (og + 1u == (tg + 1u) * nx) xb_add(&bar[XB_TOPGEN], 1u);
            else XB_SPIN(xb_ld(&bar[XB_TOPGEN]) == tg, bar);
            __builtin_amdgcn_fence(__ATOMIC_ACQUIRE, "agent");
            xb_add(&bar[XB_XGEN(b.x)], 1u);
            asm volatile("s_waitcnt vmcnt(0)" ::: "memory");
        } else {
            XB_SPIN(xb_ld(&bar[XB_XGEN(b.x)]) == gen, bar);
            __builtin_amdgcn_fence(__ATOMIC_ACQUIRE, "agent");
            asm volatile("s_waitcnt vmcnt(0)" ::: "memory");
        }
    }
    __syncthreads();
}

namespace pg8 {
constexpr int BM = 256, BK = 64, HALF = 128, HTB = HALF * BK * 2, NXCD = 8, WGM = 8;
__host__ __device__ __forceinline__ int lds_byte(int r, int c) { return r * 128 + (((c >> 3) ^ ((r >> 1) & 7)) * 16) + (c & 7) * 2; }
__host__ __device__ __forceinline__ void stage_rc(int b, int& R, int& C) { R = b / 128; C = ((((b % 128) / 16) ^ ((R >> 1) & 7)) * 8) + (b % 16) / 2; }
__host__ __device__ __forceinline__ int perm32(int rho) { const int n = rho >> 4, i = rho & 15; return 8 * (i >> 2) + 4 * n + (i & 3); }
__host__ __device__ __forceinline__ int perm32w(int rho) { const int n = rho >> 4, i = rho & 15, fq = i >> 2, g = ((fq & 1) << 1) | (fq >> 1); return 8 * g + 4 * n + (i & 3); }
struct Unit { int pm, pn, aux; };
struct Gemm { const bf16* A; const bf16* Bt; int K; int lda; int sa8 = 0; int ldb = 0; };

struct StaticOrder {
    int nM, nN, nwg, G, c;
    __device__ void init(int M, int N, int G_, int c_) { nM = M / BM; nN = N / BM; nwg = nM * nN; G = G_; c = c_; }
    __device__ __forceinline__ bool next(int i, Unit& u) const {
        const long L = (long)i * G + c; if (L >= nwg) return false;
        int wgid = (int)L; { const int q = nwg / NXCD, r = nwg % NXCD, xcd = wgid % NXCD, off = wgid / NXCD; wgid = (xcd < r ? xcd * (q + 1) : r * (q + 1) + (xcd - r) * q) + off; }
        const int nig = WGM * nN, gid = wgid / nig, fm = gid * WGM, gsz = (nM - fm) < WGM ? (nM - fm) : WGM;
        u.pm = fm + ((wgid % nig) % gsz); u.pn = (wgid % nig) / gsz; u.aux = 0; return true;
    }
    __device__ __forceinline__ unsigned tok(const Unit&, int) const { return 0u; }
};
struct PanelOrder {
    int pm, nN;
    __device__ __forceinline__ bool next(int i, Unit& u) const { if (i >= nN) return false; int p_ = pm; asm volatile("" : "+s"(p_)); u.pm = p_; u.pn = i; u.aux = 0; return true; }
    __device__ __forceinline__ unsigned tok(const Unit&, int) const { return 0u; }
};
struct TableOrder {
    const LAS int* ut; const LAS unsigned* tokt; int n;
    __device__ __forceinline__ bool next(int i, Unit& u) const { if (i >= n) return false; const i32x4 d = *(const LAS i32x4*)(ut + 4 * i); u.pm = __builtin_amdgcn_readfirstlane(d.x); u.pn = __builtin_amdgcn_readfirstlane(d.y); u.aux = __builtin_amdgcn_readfirstlane(d.z); return true; }
    __device__ __forceinline__ unsigned tok(const Unit& u, int slot) const { return tokt[u.aux * 256 + slot]; }
};

__device__ __forceinline__ unsigned cvt_pk_bf16(float lo, float hi) { unsigned r; asm volatile("v_cvt_pk_bf16_f32 %0, %1, %2" : "=v"(r) : "v"(lo), "v"(hi)); return r; }

template <class Epi, class Sched, bool ALIGN_EPI, bool GATHER, bool FP8 = false>
__device__ __forceinline__ void gemm_phase(LAS unsigned char* lds, const Gemm g, const Sched& S, const Epi& E, const int tid_in) {
    const int tid = opq(tid_in), wid = __builtin_amdgcn_readfirstlane(tid >> 6), lane = tid & 63, wr = wid >> 2, wc = wid & 3, fr = lane & 15, fq = lane >> 4;
    const int K = g.K, nt = K / BK, lda = g.lda, ldb = g.ldb ? g.ldb : K;
    unsigned voffA[2], voffB[2]; int RA[2]; unsigned CA[2];
    const size_t kstep = (size_t)(BK * 2);
    const size_t hstepA = (size_t)HALF * lda * 2, hstepB = (size_t)HALF * ldb * 2;
    const size_t tstepA = 2 * hstepA, tstepB = 2 * hstepB;
#pragma unroll
    for (int i = 0; i < 2; ++i) { int R, C; stage_rc(tid * 16 + i * 8192, R, C); const int Rb = Epi::PERM ? ((R & ~31) + (Epi::PERMW ? perm32w(R & 31) : perm32(R & 31))) : R;
        RA[i] = R; CA[i] = (unsigned)C * 2u; voffB[i] = (unsigned)(Rb * ldb + C) * 2u; voffA[i] = (unsigned)(R * lda + C) * 2u; }
    const unsigned ldsw = (unsigned)wid * 1024u;
    const int aoff = lds_byte(wr * 64 + fr, fq * 8), boff = lds_byte(wc * 32 + fr, fq * 8), x64 = (fr & 8) ? -64 : 64;
#define PG8_SA(b, h) (((b) * 2 + (h)) * HTB)
#define PG8_SB(b, h) ((4 + (b) * 2 + (h)) * HTB)
#define PG8_GLDS(gp, bufoff, _i) __builtin_amdgcn_global_load_lds((const unsigned*)(gp), (LAS unsigned*)(lds + (bufoff) + ldsw + (_i) * 8192), 16, 0, 0)
#define PG8_STAGE_B(bufoff, gbase) do { _Pragma("unroll") for (int _i = 0; _i < 2; ++_i) PG8_GLDS((const char*)(gbase) + voffB[_i], bufoff, _i); } while (0)
#define PG8_STAGE_A(bufoff, gbase, OA, h) do { _Pragma("unroll") for (int _i = 0; _i < 2; ++_i) { if constexpr (GATHER) PG8_GLDS((const char*)(gbase) + OA[h][_i], bufoff, _i); else PG8_GLDS((const char*)(gbase) + (size_t)(h) * hstepA + voffA[_i], bufoff, _i); } } while (0)
#define PG8_LD8(P, X) __builtin_shufflevector(*(const LAS i32x4*)(P), *(const LAS i32x4*)((P) + (X)), 0, 1, 2, 3, 4, 5, 6, 7)
#define PG8_LDA(dst, b, h) do { _Pragma("unroll") for (int m = 0; m < 4; ++m) { if constexpr (FP8) dst##8[m] = PG8_LD8(lds + PG8_SA(b, h) + aoff + m * 2048, x64); else { _Pragma("unroll") for (int k = 0; k < 2; ++k) dst[m][k] = *(const LAS bf16x8*)(lds + PG8_SA(b, h) + aoff + m * 2048 + (k ? x64 : 0)); } } } while (0)
#define PG8_LDB(dst, b, h) do { _Pragma("unroll") for (int n = 0; n < 2; ++n) { if constexpr (FP8) dst##8[n] = PG8_LD8(lds + PG8_SB(b, h) + boff + n * 2048, x64); else { _Pragma("unroll") for (int k = 0; k < 2; ++k) dst[n][k] = *(const LAS bf16x8*)(lds + PG8_SB(b, h) + boff + n * 2048 + (k ? x64 : 0)); } } } while (0)
#define PG8_CAT(X0, X1) __builtin_shufflevector(__builtin_bit_cast(i32x4, X0), __builtin_bit_cast(i32x4, X1), 0, 1, 2, 3, 4, 5, 6, 7)
#define PG8_MMA(ai, bj, At, Bt) do { __builtin_amdgcn_s_setprio(1); _Pragma("unroll") for (int m = 0; m < 4; ++m) _Pragma("unroll") for (int n = 0; n < 2; ++n) { \
        if constexpr (FP8) asm("v_mfma_scale_f32_16x16x128_f8f6f4 %0, %1, %2, %0, %3, %4 op_sel_hi:[0,0,0]" : "+v"(acc[ai][bj][m][n]) : "v"(Bt##8[n]), "v"(At##8[m]), "v"(sc8w), "v"(sc8a)); \
        else { _Pragma("unroll") for (int k = 0; k < 2; ++k) acc[ai][bj][m][n] = __builtin_amdgcn_mfma_f32_16x16x32_bf16(Bt[n][k], At[m][k], acc[ai][bj][m][n], 0, 0, 0); } } __builtin_amdgcn_s_setprio(0); } while (0)
#define PG8_WAIT_V(n) asm volatile("s_waitcnt vmcnt(" #n ")" ::: "memory")
#define PG8_WAIT_L(n) asm volatile("s_waitcnt lgkmcnt(" #n ")" ::: "memory")
#define PG8_BAR __builtin_amdgcn_s_barrier()
#define PG8_SCHED __builtin_amdgcn_sched_barrier(0)
#define PG8_SETOA(OA, U) do { _Pragma("unroll") for (int _h = 0; _h < 2; ++_h) _Pragma("unroll") for (int _i = 0; _i < 2; ++_i) \
        OA[_h][_i] = GATHER ? (S.tok(U, _h * HALF + RA[_i]) * (unsigned)lda * 2u + CA[_i]) : 0u; } while (0)
    Unit cur, nxt; int ui = 0;
    if (!S.next(0, cur)) return;
    f32x4 acc[2][2][4][2];
#pragma unroll
    for (int a = 0; a < 2; ++a)
#pragma unroll
        for (int b = 0; b < 2; ++b)
#pragma unroll
            for (int m = 0; m < 4; ++m)
#pragma unroll
                for (int n = 0; n < 2; ++n) acc[a][b][m][n] = (f32x4){0.f, 0.f, 0.f, 0.f};
    bf16x8 At[4][2], B0[2][2], B1[2][2]; i32x8 At8[4], B08[2], B18[2];
    const int sc8w = W8_E8M0, sc8a = g.sa8;
    unsigned oc[2][2], on[2][2];
    PG8_SETOA(oc, cur);
    const char* cA = (const char*)g.A + (GATHER ? (size_t)0 : (size_t)cur.pm * tstepA); const char* cB = (const char*)g.Bt + (size_t)cur.pn * tstepB;
    PG8_STAGE_B(PG8_SB(0, 0), cB); PG8_STAGE_B(PG8_SB(0, 1), cB + hstepB); PG8_STAGE_A(PG8_SA(0, 0), cA, oc, 0); PG8_STAGE_A(PG8_SA(0, 1), cA, oc, 1);
    if (wr == 1) PG8_BAR;
    PG8_WAIT_V(2); PG8_BAR;
    PG8_STAGE_B(PG8_SB(1, 0), cB + kstep); PG8_STAGE_A(PG8_SA(1, 0), cA + kstep, oc, 0); PG8_STAGE_B(PG8_SB(1, 1), cB + hstepB + kstep);
    PG8_WAIT_V(6); PG8_BAR;
    for (;;) {
        const bool has_next = S.next(ui + 1, nxt);
        const char* nA = has_next ? (const char*)g.A + (GATHER ? (size_t)0 : (size_t)nxt.pm * tstepA) : cA; const char* nB = has_next ? (const char*)g.Bt + (size_t)nxt.pn * tstepB : cB;
        if (has_next) { PG8_SETOA(on, nxt); } else {
#pragma unroll
            for (int _h = 0; _h < 2; ++_h)
#pragma unroll
                for (int _i = 0; _i < 2; ++_i) on[_h][_i] = oc[_h][_i]; }
#pragma nounroll
        for (int t = 0; t < nt; t += 2) {
            const bool last = (t == nt - 2);
            const char* a1 = cA + (size_t)(t + 1) * kstep;
            const char* a2 = last ? nA : cA + (size_t)(t + 2) * kstep; const char* b2 = last ? nB : cB + (size_t)(t + 2) * kstep;
            const char* a3 = a2 + kstep; const char* b3 = b2 + kstep;
            unsigned o2[2][2];
#pragma unroll
            for (int _h = 0; _h < 2; ++_h)
#pragma unroll
                for (int _i = 0; _i < 2; ++_i) o2[_h][_i] = last ? on[_h][_i] : oc[_h][_i];
            PG8_LDB(B0, 0, 0); PG8_LDB(B1, 0, 1); PG8_SCHED; PG8_LDA(At, 0, 0); PG8_STAGE_A(PG8_SA(1, 1), a1, oc, 1);
            PG8_WAIT_V(8); PG8_WAIT_L(0); PG8_BAR; PG8_MMA(0, 0, At, B0); PG8_MMA(0, 1, At, B1); PG8_BAR; PG8_SCHED;
            PG8_LDA(At, 0, 1); PG8_STAGE_B(PG8_SB(0, 0), b2); PG8_STAGE_B(PG8_SB(0, 1), b2 + hstepB); PG8_STAGE_A(PG8_SA(0, 0), a2, o2, 0);
            PG8_WAIT_V(8); PG8_WAIT_L(0); PG8_BAR; PG8_MMA(1, 0, At, B0); PG8_MMA(1, 1, At, B1); PG8_BAR; PG8_SCHED;
            PG8_LDB(B0, 1, 0); PG8_LDB(B1, 1, 1); PG8_SCHED; PG8_LDA(At, 1, 0); PG8_STAGE_A(PG8_SA(0, 1), a2, o2, 1);
            PG8_WAIT_V(8); PG8_WAIT_L(0); PG8_BAR; PG8_MMA(0, 0, At, B0); PG8_MMA(0, 1, At, B1); PG8_BAR; PG8_SCHED;
            PG8_LDA(At, 1, 1); PG8_STAGE_B(PG8_SB(1, 0), b3); PG8_STAGE_B(PG8_SB(1, 1), b3 + hstepB); PG8_STAGE_A(PG8_SA(1, 0), a3, o2, 0);
            PG8_WAIT_V(8); PG8_WAIT_L(0); PG8_BAR; PG8_MMA(1, 0, At, B0); PG8_MMA(1, 1, At, B1); PG8_BAR; PG8_SCHED;
        }
        if constexpr (ALIGN_EPI) { if (wr == 0) PG8_BAR; }
        if constexpr (FP8) asm volatile("s_nop 15\n\ts_nop 15" ::: "memory");
        E(acc, cur, wr, wc, fr, fq);
        if (!has_next) break;
#pragma unroll
        for (int a = 0; a < 2; ++a)
#pragma unroll
            for (int b = 0; b < 2; ++b)
#pragma unroll
                for (int m = 0; m < 4; ++m)
#pragma unroll
                    for (int n = 0; n < 2; ++n) acc[a][b][m][n] = (f32x4){0.f, 0.f, 0.f, 0.f};
        cur = nxt; cA = nA; cB = nB; ++ui;
#pragma unroll
        for (int _h = 0; _h < 2; ++_h)
#pragma unroll
            for (int _i = 0; _i < 2; ++_i) oc[_h][_i] = on[_h][_i];
        if constexpr (ALIGN_EPI) { if (wr == 1) PG8_BAR; }
    }
    PG8_WAIT_V(0);
    if constexpr (!ALIGN_EPI) { if (wr == 0) PG8_BAR; }
    PG8_BAR;
#undef PG8_SA
#undef PG8_SB
#undef PG8_GLDS
#undef PG8_STAGE_A
#undef PG8_STAGE_B
#undef PG8_LDA
#undef PG8_LD8
#undef PG8_LDB
#undef PG8_MMA
#undef PG8_CAT
#undef PG8_WAIT_V
#undef PG8_WAIT_L
#undef PG8_BAR
#undef PG8_SCHED
#undef PG8_SETOA
}
}

struct Args { const void* in[26]; float* out; unsigned char* ws; int ph_lo, ph_hi; };
typedef const __attribute__((address_space(4))) Args CArgs;
struct Frame {
    LAS unsigned char* lds;
    volatile LAS unsigned* MISC;
    gu32* ctl;
    int tid, lane, wave, G, c;
    unsigned char* ws; float* out;
};
#define IN_x ((const float*)A.in[0])
#define IN_cnd ((const float*)A.in[1])
#define IN_pos ((const int*)A.in[2])
#define IN_t5 ((const float*)A.in[3])
#define IN_ada_w ((const float*)A.in[4])
#define IN_ada_b ((const float*)A.in[5])
#define IN_g_mix ((const float*)A.in[6])
#define IN_g_ffn ((const float*)A.in[7])
#define IN_w_in ((const float*)A.in[8])
#define IN_gq ((const float*)A.in[9])
#define IN_w_uq ((const float*)A.in[10])
#define IN_gkv ((const float*)A.in[11])
#define IN_w_ukv ((const float*)A.in[12])
#define IN_fb ((const float*)A.in[13])
#define IN_conv_w ((const float*)A.in[14])
#define IN_dlam ((const float*)A.in[15])
#define IN_subln ((const float*)A.in[16])
#define IN_w_out ((const float*)A.in[17])
#define IN_rg_w ((const float*)A.in[18])
#define IN_rg_b ((const float*)A.in[19])
#define IN_re_w ((const float*)A.in[20])
#define IN_re_b ((const float*)A.in[21])
#define IN_wg ((const float*)A.in[22])
#define IN_wu ((const float*)A.in[23])
#define IN_wd ((const float*)A.in[24])
#define IN_g_fin ((const float*)A.in[25])
#define WSP(T, off) ((T*)(F.ws + (off)))

template <class Fn, bool OUT8 = false>
__device__ __forceinline__ void transpose_item(const Fn& f, bf16* dst, int ldd, int k0, int n0, LAS float* scr, int lane) {
    const int nq = lane & 15, kr = lane >> 4;
    f32x4 v[16];
#pragma unroll
    for (int i = 0; i < 16; ++i) v[i] = f(k0 + 4 * i + kr, n0 + 4 * nq);
#pragma unroll
    for (int i = 0; i < 16; ++i) { const int k = 4 * i + kr;
        scr[(4 * nq + 0) * 65 + k] = v[i].x; scr[(4 * nq + 1) * 65 + k] = v[i].y; scr[(4 * nq + 2) * 65 + k] = v[i].z; scr[(4 * nq + 3) * 65 + k] = v[i].w; }
    LDS_WAIT(); asm volatile("" ::: "memory");
    const int kc = lane & 7, nr = lane >> 3;
#pragma unroll
    for (int j = 0; j < 8; ++j) { const int n = nr + 8 * j; const LAS float* s = scr + n * 65 + 8 * kc;
        if (OUT8) { *(GAS v2u*)((unsigned char*)dst + (size_t)(n0 + n) * ldd + k0 + 8 * kc) = pack_fp8x8(s[0], s[1], s[2], s[3], s[4], s[5], s[6], s[7]); }
        else { v4u o; o.x = pk2(s[0], s[1]); o.y = pk2(s[2], s[3]); o.z = pk2(s[4], s[5]); o.w = pk2(s[6], s[7]);
            *(GAS v4u*)(dst + (size_t)(n0 + n) * ldd + k0 + 8 * kc) = o; } }
    LDS_WAIT(); asm volatile("" ::: "memory");
}
struct SrcPlain {
    const float* W; int ld; int coff; float scale;
    __device__ __forceinline__ f32x4 operator()(int k, int n) const { const f32x4 v = *(const GAS f32x4*)(W + (size_t)k * ld + n + coff); return v * scale; }
};
struct SrcZero { __device__ __forceinline__ f32x4 operator()(int, int) const { return (f32x4){0.f, 0.f, 0.f, 0.f}; } };
struct SrcKrope {
    const float* W;
    __device__ __forceinline__ f32x4 operator()(int k, int n) const { if (n >= PC_KROPE + 32) return (f32x4){0.f, 0.f, 0.f, 0.f}; return *(const GAS f32x4*)(W + (size_t)k * P_IN + SRC_KROPE + (n - PC_KROPE)); }
};
__device__ __forceinline__ int rope_dim_of_pos(int p) { return (p & 4) ? 16 + 4 * (p >> 3) + (p & 3) : 4 * (p >> 3) + (p & 3); }
struct SrcUp {
    const float* wuq; const float* gq; const float* wukv; const float* gkv; float c2a;
    __device__ __forceinline__ float one(int k, int n) const {
        if (n < 384) { if (k >= 192) return 0.f; const int h = n / 96, j = n % 96; const int col = h * 96 + (j < 64 ? j : 64 + rope_dim_of_pos(j - 64)); return gq[k] * wuq[(size_t)k * 384 + col] * c2a; }
        if (n < 512) return 0.f;
        if (k < 256) return 0.f;
        return gkv[k - 256] * wukv[(size_t)(k - 256) * 512 + (n - 512)];
    }
    __device__ __forceinline__ f32x4 operator()(int k, int n) const { return (f32x4){one(k, n), one(k, n + 1), one(k, n + 2), one(k, n + 3)}; }
};

constexpr float C2A = 0.10206207261596577f * LOG2E;
constexpr float C2B = 0.125f * LOG2E;
constexpr float C2D = 0.17677669529663687f * LOG2E;

__device__ __forceinline__ int t5_bucket(int rel) {
    const int n = rel < 0 ? -rel : rel; const int base = rel > 0 ? 16 : 0;
    if (n < 8) return base + n;
    const int fl = 31 - __builtin_clz((unsigned)(n * n));
    int large = 8 + fl - 6; if (large > 15) large = 15;
    return base + large;
}

constexpr int CV_IN = 16 * 44, CV_UP = 6 * 16, CV_OUT = 16 * 16, CV_GU = 16 * 16 * NEXP, CV_D = 8 * 16 * NEXP, CV_LAYER = CV_IN + CV_UP + CV_OUT + CV_GU + CV_D;
constexpr int CV_DENSE = CV_IN + CV_UP + CV_OUT, CV_MOE = CV_GU + CV_D;
__device__ __forceinline__ void convert_item(Frame& F, CArgs& A, int l, int r, LAS float* scr) {
    if (r < CV_IN) {
        const int nb = r / 16, kb = r % 16, n0 = nb * 64, k0 = kb * 64; bf16* dst = WSP(bf16, WS_WIN) + (size_t)l * PN * DM; const float* W = IN_w_in + (size_t)l * DM * P_IN;
        if (n0 < 192) transpose_item(SrcPlain{W, P_IN, 0, 1.f}, dst, DM, k0, n0, scr, F.lane);
        else if (n0 < 256) transpose_item(SrcZero{}, dst, DM, k0, n0, scr, F.lane);
        else if (n0 < 384) transpose_item(SrcPlain{W, P_IN, SRC_CKV - PC_CKV, 1.f}, dst, DM, k0, n0, scr, F.lane);
        else if (n0 < 448) transpose_item(SrcKrope{W}, dst, DM, k0, n0, scr, F.lane);
        else if (n0 < 512) transpose_item(SrcZero{}, dst, DM, k0, n0, scr, F.lane);
        else if (n0 < PC_CONV) transpose_item(SrcPlain{W, P_IN, SRC_FOX - PC_FOX, n0 < PC_FOX + 256 ? C2B : 1.f}, dst, DM, k0, n0, scr, F.lane);
        else if (n0 < PC_DIFF) transpose_item(SrcPlain{W, P_IN, SRC_CONV - PC_CONV, 1.f}, dst, DM, k0, n0, scr, F.lane);
        else transpose_item(SrcPlain{W, P_IN, SRC_DIFF - PC_DIFF, n0 < PC_DIFF + 256 ? C2D : 1.f}, dst, DM, k0, n0, scr, F.lane);
        return; }
    r -= CV_IN;
    if (r < CV_UP) { const int nb = r / 6, kb = r % 6;
        transpose_item(SrcUp{IN_w_uq + (size_t)l * 192 * 384, IN_gq + l * 192, IN_w_ukv + (size_t)l * 128 * 512, IN_gkv + l * 128, C2A}, WSP(bf16, WS_WUP) + (size_t)l * NUP * KUP, KUP, kb * 64, nb * 64, scr, F.lane);
        return; }
    r -= CV_UP;
    if (r < CV_OUT) { const int nb = r / 16, kb = r % 16;
        transpose_item<SrcPlain, true>(SrcPlain{IN_w_out + (size_t)l * DM * DM, DM, 0, W8_SCALE}, (bf16*)(WSP(unsigned char, WS_WOUT) + (size_t)l * DM * DM), DM, kb * 64, nb * 64, scr, F.lane);
        return; }
    r -= CV_OUT;
    if (r < CV_GU) { const int e = r / 256, q = r % 256, nb = q / 16, kb = q % 16, n0 = nb * 64;
        const int pn = n0 >> 8, half = (n0 >> 7) & 1, j0 = n0 & 127;
        const float* W = (half ? IN_wu : IN_wg) + ((size_t)l * NEXP + e) * DM * DEXP;
        transpose_item<SrcPlain, true>(SrcPlain{W, DEXP, 128 * pn + j0 - n0, W8_SCALE}, (bf16*)(WSP(unsigned char, WS_WGU) + ((size_t)l * NEXP + e) * 1024 * 1024), DM, kb * 64, n0, scr, F.lane);
        return; }
    r -= CV_GU;
    { const int e = r / 128, q = r % 128, nb = q / 8, kb = q % 8;
      transpose_item<SrcPlain, true>(SrcPlain{IN_wd + ((size_t)l * NEXP + e) * DEXP * DM, DM, 0, W8_SCALE}, (bf16*)(WSP(unsigned char, WS_WD) + ((size_t)l * NEXP + e) * 1024 * DEXP), DEXP, kb * 64, nb * 64, scr, F.lane); }
}

__device__ __forceinline__ void prologue(Frame& F, CArgs& A) {
    const int gw = F.c * 8 + F.wave, NGW = F.G * 8;
    const int gt = F.c * 512 + F.tid, NGT = F.G * 512;
    {
        LAS float* cs = (LAS float*)(F.lds + RING_OFF);
        bool loaded = false;
        float* MOD = WSP(float, WS_MOD);
        for (int it = F.c; it < DEPTH * 64; it += F.G) {
            if (!loaded) { for (int e = F.tid; e < NB * DM; e += 512) { const int b = e >> 10, k = e & 1023; cs[k * 32 + b] = silu_f(IN_cnd[e]); } loaded = true; __syncthreads(); }
            const int l = it >> 6, n0 = (it & 63) * 96;
            const int col = F.tid >> 2, ks = F.tid & 3;
            if (F.tid < 384) {
                const float* W = IN_ada_w + (size_t)l * DM * 6144 + n0 + col;
                float acc[32];
#pragma unroll
                for (int b = 0; b < 32; ++b) acc[b] = 0.f;
                for (int kk0 = 0; kk0 < 256; kk0 += 16) { float w[16];
#pragma unroll
                    for (int u = 0; u < 16; ++u) w[u] = W[(size_t)(4 * (kk0 + u) + ks) * 6144];
#pragma unroll
                    for (int u = 0; u < 16; ++u) { const int k = 4 * (kk0 + u) + ks;
#pragma unroll
                        for (int b4 = 0; b4 < 8; ++b4) { const f32x4 c4 = *(const LAS f32x4*)(cs + k * 32 + 4 * b4); acc[4 * b4] += c4.x * w[u]; acc[4 * b4 + 1] += c4.y * w[u]; acc[4 * b4 + 2] += c4.z * w[u]; acc[4 * b4 + 3] += c4.w * w[u]; } } }
#pragma unroll
                for (int b = 0; b < 32; ++b) { float v = acc[b]; v += shx(v, 1, F.lane); v += shx(v, 2, F.lane); acc[b] = v; }
                if (ks == 0) { const float bias = IN_ada_b[l * 6144 + n0 + col];
#pragma unroll
                    for (int b = 0; b < 32; ++b) MOD[((size_t)l * NB + b) * 6144 + n0 + col] = acc[b] + bias; }
            }
        }
        __syncthreads();
    }
    { float* T5 = WSP(float, WS_T5);
      for (int i = gt; i < 4 * 2112; i += NGT) { const int h = i / 2112, r = i % 2112; T5[i] = IN_t5[t5_bucket(r - 2047) * 4 + h] * LOG2E; }
      float* LAM = WSP(float, WS_LAM);
      if (gt < DEPTH) { const int l = gt; const float* p = IN_dlam + l * 128; float s0 = 0.f, s1 = 0.f;
          for (int i = 0; i < 32; ++i) { s0 += p[i] * p[32 + i]; s1 += p[64 + i] * p[96 + i]; }
          LAM[l] = expf(s0) - expf(s1) + (0.8f - 0.6f * expf(-0.3f * (float)l)); }
      float* WF = WSP(float, WS_WF);
      for (int i = gt; i < DEPTH * 4 * DM; i += NGT) { const int l = i >> 12, j = (i >> 10) & 3, k = i & 1023; WF[i] = IN_w_in[((size_t)l * DM + k) * P_IN + SRC_FLOG + j]; }
      bf16* WRT = WSP(bf16, WS_WRT);
      for (int i = gt; i < DEPTH * NLOG * DM; i += NGT) { const int l = i / (NLOG * DM), r = i % (NLOG * DM), n = r >> 10, k = r & 1023;
          const float v = n < 8 ? IN_rg_w[((size_t)l * DM + k) * 8 + n] : (n < 72 ? IN_re_w[((size_t)l * DM + k) * 64 + (n - 8)] : 0.f);
          const unsigned hi = f2bf(v); const float lo = v - __builtin_bit_cast(float, hi << 16);
          WRT[((size_t)l * 2 + 0) * NLOG * DM + r] = (bf16)hi; WRT[((size_t)l * 2 + 1) * NLOG * DM + r] = (bf16)f2bf(lo); }
    }
    {
        LAS float* scr = (LAS float*)(F.lds + RING_OFF) + F.wave * (64 * 65);
        for (int it = gw; it < CV_DENSE; it += NGW) convert_item(F, A, 0, it, scr);
    }
}
__device__ __forceinline__ float rope_rev(int i) {
    constexpr float T[16] = {1.591549431e-01f, 8.949940161e-02f, 5.032921210e-02f, 2.830219583e-02f, 1.591549431e-02f, 8.949940161e-03f, 5.032921210e-03f, 2.830219583e-03f,
                             1.591549431e-03f, 8.949940161e-04f, 5.032921210e-04f, 2.830219583e-04f, 1.591549431e-04f, 8.949940161e-05f, 5.032921210e-05f, 2.830219583e-05f};
    return T[i];
}
__device__ __forceinline__ void rope_cs(float posf, float rev, float& c, float& s) { float a = posf * rev; a -= rintf(a); c = __builtin_amdgcn_cosf(a); s = __builtin_amdgcn_sinf(a); }

__device__ __forceinline__ void moe_block_starts(Frame& F, int lm) {
    LAS int* mbs = (LAS int*)(F.lds + UT_OFF + 256); LAS int* cnts = mbs + 72;
    if (F.tid < 64) cnts[F.tid] = (int)__hip_atomic_load(F.ctl + CW_GCNT + (lm * 64 + F.tid) * 16, RLX_AGENT);
    __syncthreads();
    if (F.tid == 0) { int a = 0; for (int e = 0; e < 64; ++e) { mbs[e] = a; a += (cnts[e] + 255) >> 8; } mbs[64] = a; }
    __syncthreads();
}

template <bool FINAL, bool COMB>
__device__ __forceinline__ void mix_norm_phase(Frame& F, CArgs& A, int l) {
    if (COMB) moe_block_starts(F, l - 1);
    const LAS int* mbs = (const LAS int*)(F.lds + UT_OFF + 256);
    const float* MOD = WSP(float, WS_MOD);
    const unsigned char* Y = WSP(unsigned char, WS_Y); const int* DEST = WSP(int, WS_DEST); const float* GATE = WSP(float, WS_GATE);
    bf16* H = WSP(bf16, WS_H); float* FLOG = WSP(float, WS_FLOG);
    f16* XR = WSP(f16, WS_XR);
    LAS float* G1 = (LAS float*)(F.lds + RING_OFF); LAS float* SH = G1 + 1024; LAS float* GF = G1 + 2048; LAS float* wfl = G1 + 3072;
    if (!FINAL) {
        const bf16* WRT = WSP(bf16, WS_WRT) + (size_t)l * 2 * NLOG * DM;
        for (int bb = F.c; bb < NB; bb += F.G) { const float* shf = MOD + ((size_t)l * NB + bb) * 6144 + 3 * 1024;
            for (int n = F.wave; n < NLOG; n += 8) { float sacc = 0.f;
#pragma unroll
                for (int j = 0; j < 4; ++j) { const int k = 4 * F.lane + 256 * j; const v2u wh = *(const GAS v2u*)(WRT + (size_t)n * DM + k), wl = *(const GAS v2u*)(WRT + (size_t)(NLOG + n) * DM + k); const f32x4 sf = *(const GAS f32x4*)(shf + k);
                    sacc += sf.x * (bflo(wh.x) + bflo(wl.x)) + sf.y * (bfhi(wh.x) + bfhi(wl.x)) + sf.z * (bflo(wh.y) + bflo(wl.y)) + sf.w * (bfhi(wh.y) + bfhi(wl.y)); }
                sacc = wave_sum(sacc, F.lane);
                if (F.lane == 0) WSP(float, WS_SHWB)[((size_t)l * NB + bb) * NLOG + n] = sacc + (n < 8 ? IN_rg_b[l * 8 + n] : (n < 72 ? IN_re_b[l * 64 + n - 8] : 0.f)); } }
    }
    for (int tile = F.c; tile < NTOK / 256; tile += F.G) {
        const int b = tile >> 3;
        __syncthreads();
        for (int k = F.tid; k < DM; k += 512) {
            if (FINAL) G1[k] = IN_g_fin[k];
            else { G1[k] = IN_g_mix[l * DM + k] * (1.f + MOD[((size_t)l * NB + b) * 6144 + 1024 + k]); SH[k] = MOD[((size_t)l * NB + b) * 6144 + k]; }
            if (COMB) GF[k] = MOD[((size_t)(l - 1) * NB + b) * 6144 + 5 * 1024 + k]; }
        if (!FINAL) for (int i = F.tid; i < 1024; i += 512) *(LAS f32x4*)(wfl + 4 * i) = *(const GAS f32x4*)(WSP(float, WS_WF) + (size_t)l * 4 * DM + 4 * i);
        __syncthreads();
        const size_t rowbase = (size_t)tile * 256 + F.wave * 32;
        unsigned r0v = 0u, r1v = 0u; float g0v = 0.f, g1v = 0.f;
        if (COMB && F.lane < 32) { const i32x4 d = *(const GAS i32x4*)(DEST + (rowbase + F.lane) * 4); const f32x2 gt = *(const GAS f32x2*)(GATE + (rowbase + F.lane) * 2);
            r0v = 256u * (unsigned)mbs[d.x] + (unsigned)d.y; r1v = 256u * (unsigned)mbs[d.z] + (unsigned)d.w; g0v = gt.x; g1v = gt.y; }
        struct RowBuf { f32x4 v[COMB ? 1 : 4]; f16x4 hx[COMB ? 4 : 1]; unsigned y0[COMB ? 4 : 1], y1[COMB ? 4 : 1]; float g0, g1; };
#define MN_LOAD(S, JR) do { const size_t row_ = rowbase + (JR); \
            if (COMB) { const size_t q0_ = (size_t)__builtin_amdgcn_readlane(r0v, (JR)), q1_ = (size_t)__builtin_amdgcn_readlane(r1v, (JR)); \
                S.g0 = __uint_as_float(__builtin_amdgcn_readlane(__float_as_uint(g0v), (JR))); S.g1 = __uint_as_float(__builtin_amdgcn_readlane(__float_as_uint(g1v), (JR))); \
                _Pragma("unroll") for (int j = 0; j < (COMB ? 4 : 0); ++j) { S.hx[j] = *(const GAS f16x4*)(XR + row_ * DM + 4 * F.lane + 256 * j); \
                    S.y0[j] = *(const GAS unsigned*)(Y + q0_ * DM + 4 * F.lane + 256 * j); S.y1[j] = *(const GAS unsigned*)(Y + q1_ * DM + 4 * F.lane + 256 * j); } } \
            else { _Pragma("unroll") for (int j = 0; j < (COMB ? 0 : 4); ++j) S.v[j] = *(const GAS f32x4*)(IN_x + row_ * DM + 4 * F.lane + 256 * j); } } while (0)
#define MN_COMPUTE(S, JR) do { const size_t row = rowbase + (JR); f32x4 v[4]; \
            if (COMB) { \
                _Pragma("unroll") for (int j = 0; j < (COMB ? 4 : 0); ++j) { const f32x4 gf4 = *(const LAS f32x4*)(GF + 4 * F.lane + 256 * j); \
                    const f32x2 a01 = __builtin_amdgcn_cvt_pk_f32_fp8((int)S.y0[j], false), a23 = __builtin_amdgcn_cvt_pk_f32_fp8((int)S.y0[j], true), b01 = __builtin_amdgcn_cvt_pk_f32_fp8((int)S.y1[j], false), b23 = __builtin_amdgcn_cvt_pk_f32_fp8((int)S.y1[j], true); \
                    f32x4 m; m.x = S.g0 * a01.x + S.g1 * b01.x; m.y = S.g0 * a01.y + S.g1 * b01.y; m.z = S.g0 * a23.x + S.g1 * b23.x; m.w = S.g0 * a23.y + S.g1 * b23.y; m = m * (1.f / Y8_SCALE); \
                    v[j] = (f32x4){(float)S.hx[j].x, (float)S.hx[j].y, (float)S.hx[j].z, (float)S.hx[j].w} + gf4 * m; } \
                if (!FINAL) { \
                    _Pragma("unroll") for (int j = 0; j < 4; ++j) { const f16x4 hx = (f16x4){(f16)v[j].x, (f16)v[j].y, (f16)v[j].z, (f16)v[j].w}; *(GAS f16x4*)(XR + row * DM + 4 * F.lane + 256 * j) = hx; v[j] = (f32x4){(float)hx.x, (float)hx.y, (float)hx.z, (float)hx.w}; } } \
            } else { _Pragma("unroll") for (int j = 0; j < (COMB ? 0 : 4); ++j) v[j] = S.v[j]; } \
            float ss = 0.f; \
            _Pragma("unroll") for (int j = 0; j < 4; ++j) ss += (v[j].x * v[j].x + v[j].y * v[j].y) + (v[j].z * v[j].z + v[j].w * v[j].w); \
            const float rs = 1.f / sqrtf(wave_sum(ss, F.lane) * (1.f / DM) + EPS); \
            if (FINAL) { \
                _Pragma("unroll") for (int j = 0; j < 4; ++j) *(GAS f32x4*)(F.out + row * DM + 4 * F.lane + 256 * j) = v[j] * rs * *(const LAS f32x4*)(G1 + 4 * F.lane + 256 * j); \
            } else { \
                float fl[4] = {0.f, 0.f, 0.f, 0.f}; \
                _Pragma("unroll") for (int j = 0; j < 4; ++j) { const f32x4 hh = (v[j] * rs) * *(const LAS f32x4*)(G1 + 4 * F.lane + 256 * j) + *(const LAS f32x4*)(SH + 4 * F.lane + 256 * j); \
                    v2u o; o.x = pk2(hh.x, hh.y); o.y = pk2(hh.z, hh.w); \
                    *(GAS v2u*)(H + row * DM + 4 * F.lane + 256 * j) = o; \
                    _Pragma("unroll") for (int q = 0; q < 4; ++q) { const f32x4 w4 = *(const LAS f32x4*)(wfl + q * DM + 4 * F.lane + 256 * j); fl[q] += (hh.x * w4.x + hh.y * w4.y) + (hh.z * w4.z + hh.w * w4.w); } } \
                _Pragma("unroll") for (int q = 0; q < 4; ++q) fl[q] = wave_sum(fl[q], F.lane); \
                if (F.lane == 0) *(GAS f32x4*)(FLOG + row * 4) = (f32x4){fl[0], fl[1], fl[2], fl[3]}; \
            } } while (0)
        RowBuf RA, RB, RC;
        MN_LOAD(RA, 0); MN_LOAD(RB, 1);
        for (int jr = 0; jr < 30; jr += 3) {
            MN_LOAD(RC, jr + 2);
            MN_COMPUTE(RA, jr);
            MN_LOAD(RA, jr + 3);
            MN_COMPUTE(RB, jr + 1);
            MN_LOAD(RB, jr + 4);
            MN_COMPUTE(RC, jr + 2);
        }
        MN_COMPUTE(RA, 30); MN_COMPUTE(RB, 31);
#undef MN_LOAD
#undef MN_COMPUTE
    }
}

__device__ __forceinline__ v4u widen_pair(const v2u x, const v2u y) {
    auto r0 = __builtin_amdgcn_permlane32_swap(x.x, y.x, false, false); auto r1 = __builtin_amdgcn_permlane32_swap(x.y, y.y, false, false);
    v4u o; o.x = r0[0]; o.y = r1[0]; o.z = r0[1]; o.w = r1[1]; return o;
}
struct EpiStoreBf16 {
    static constexpr bool PERM = true, PERMW = false;
    bf16* O; int ldc; int pn_mask;
    __device__ __forceinline__ void operator()(const f32x4 (&acc)[2][2][4][2], const pg8::Unit& u, int wr, int wc, int fr, int fq) const {
        const size_t row0 = (size_t)u.pm * 256 + wr * 64 + fr; const int col0 = (u.pn & pn_mask) * 256 + wc * 32 + 8 * fq;
#pragma unroll
        for (int ai = 0; ai < 2; ++ai)
#pragma unroll
            for (int m = 0; m < 4; ++m) { bf16* rowp = O + (row0 + ai * 128 + m * 16) * ldc + col0;
#pragma unroll
                for (int bj = 0; bj < 2; ++bj) { const f32x4 v0 = acc[ai][bj][m][0], v1 = acc[ai][bj][m][1]; v4u w;
                    w.x = pg8::cvt_pk_bf16(v0[0], v0[1]); w.y = pg8::cvt_pk_bf16(v0[2], v0[3]); w.z = pg8::cvt_pk_bf16(v1[0], v1[1]); w.w = pg8::cvt_pk_bf16(v1[2], v1[3]);
                    *(GAS v4u*)(rowp + bj * 128) = w; } }
    }
};
struct EpiStoreFp8 {
    static constexpr bool PERM = true, PERMW = true;
    unsigned char* O; int ldc; int pn_mask; float scale;
    __device__ __forceinline__ void operator()(const f32x4 (&acc)[2][2][4][2], const pg8::Unit& u, int wr, int wc, int fr, int fq) const {
        const int hi32 = fq >> 1, g0 = (fq & 1) << 1;
        const size_t row0 = (size_t)u.pm * 256 + wr * 64 + fr + 16 * hi32; const int col0 = (u.pn & pn_mask) * 256 + wc * 32 + 8 * g0;
#pragma unroll
        for (int ai = 0; ai < 2; ++ai)
#pragma unroll
            for (int mp = 0; mp < 2; ++mp) { unsigned char* rowp = O + (row0 + ai * 128 + mp * 32) * ldc + col0;
#pragma unroll
                for (int bj = 0; bj < 2; ++bj) { const f32x4 a0 = acc[ai][bj][2 * mp][0] * scale, a1 = acc[ai][bj][2 * mp][1] * scale, b0 = acc[ai][bj][2 * mp + 1][0] * scale, b1 = acc[ai][bj][2 * mp + 1][1] * scale;
                    *(GAS v4u*)(rowp + bj * 128) = widen_pair(pack_fp8x8(a0[0], a0[1], a0[2], a0[3], a1[0], a1[1], a1[2], a1[3]), pack_fp8x8(b0[0], b0[1], b0[2], b0[3], b1[0], b1[1], b1[2], b1[3])); } }
    }
};
struct EpiOut {
    static constexpr bool PERM = true, PERMW = false;
    const float* xin32; const f16* xin16; f16* xout; const float* gm; float* SS;
    __device__ __forceinline__ void operator()(const f32x4 (&acc)[2][2][4][2], const pg8::Unit& u, int wr, int wc, int fr, int fq) const {
        const size_t row0 = (size_t)u.pm * 256 + wr * 64 + fr; const int col0 = u.pn * 256 + wc * 32 + 8 * fq; const int b = u.pm >> 3; const int lane = fq * 16 + fr;
        f32x4 gvv[2][2];
#pragma unroll
        for (int bj = 0; bj < 2; ++bj)
#pragma unroll
            for (int n = 0; n < 2; ++n) gvv[bj][n] = *(const GAS f32x4*)(gm + (size_t)b * 6144 + col0 + bj * 128 + n * 4);
#pragma unroll
        for (int ai = 0; ai < 2; ++ai)
#pragma unroll
            for (int m = 0; m < 4; ++m) { const size_t ro = (row0 + ai * 128 + m * 16) * DM + col0; float ss = 0.f;
#pragma unroll
                for (int bj = 0; bj < 2; ++bj) { f32x4 x0, x1;
                    if (xin32) { x0 = *(const GAS f32x4*)(xin32 + ro + bj * 128); x1 = *(const GAS f32x4*)(xin32 + ro + bj * 128 + 4); }
                    else { const f16x8 hx = *(const GAS f16x8*)(xin16 + ro + bj * 128); x0 = (f32x4){(float)hx[0], (float)hx[1], (float)hx[2], (float)hx[3]}; x1 = (f32x4){(float)hx[4], (float)hx[5], (float)hx[6], (float)hx[7]}; }
                    x0 = x0 + gvv[bj][0] * acc[ai][bj][m][0]; x1 = x1 + gvv[bj][1] * acc[ai][bj][m][1];
                    const f16x8 ho = (f16x8){(f16)x0.x, (f16)x0.y, (f16)x0.z, (f16)x0.w, (f16)x1.x, (f16)x1.y, (f16)x1.z, (f16)x1.w};
                    *(GAS f16x8*)(xout + ro + bj * 128) = ho;
#pragma unroll
                    for (int i = 0; i < 8; ++i) { const float q = (float)ho[i]; ss += q * q; } }
                ss += shx(ss, 16, lane); ss += shx(ss, 32, lane);
                if (fq == 0) SS[(row0 + ai * 128 + m * 16) * 16 + u.pn * 4 + wc] = ss; }
    }
};
struct EpiGateUp {
    static constexpr bool PERM = true, PERMW = true;
    unsigned char* O;
    __device__ __forceinline__ void operator()(const f32x4 (&acc)[2][2][4][2], const pg8::Unit& u, int wr, int wc, int fr, int fq) const {
        const int hi32 = fq >> 1, g0 = (fq & 1) << 1;
        const size_t row0 = (size_t)u.pm * 256 + wr * 64 + fr + 16 * hi32; const int col0 = (u.pn & 3) * 128 + wc * 32 + 8 * g0;
#pragma unroll
        for (int ai = 0; ai < 2; ++ai)
#pragma unroll
            for (int mp = 0; mp < 2; ++mp) { float ha[8], hb[8];
#pragma unroll
                for (int n = 0; n < 2; ++n)
#pragma unroll
                    for (int i = 0; i < 4; ++i) { ha[4 * n + i] = silu_f(acc[ai][0][2 * mp][n][i]) * acc[ai][1][2 * mp][n][i] * HID8_SCALE; hb[4 * n + i] = silu_f(acc[ai][0][2 * mp + 1][n][i]) * acc[ai][1][2 * mp + 1][n][i] * HID8_SCALE; }
                *(GAS v4u*)(O + (row0 + ai * 128 + mp * 32) * DEXP + col0) = widen_pair(pack_fp8x8(ha[0], ha[1], ha[2], ha[3], ha[4], ha[5], ha[6], ha[7]), pack_fp8x8(hb[0], hb[1], hb[2], hb[3], hb[4], hb[5], hb[6], hb[7])); }
    }
};

__device__ __forceinline__ void mla_up_phase(Frame& F, CArgs& A, int l) {
    bf16* PROJ = WSP(bf16, WS_PROJ);
    {
        for (int tok = F.c * 512 + F.tid; tok < NTOK; tok += F.G * 512) {
            GAS v4u* p = (GAS v4u*)(PROJ + (size_t)tok * PN + PC_KROPE);
            v4u w[4]; float t[32], o[32];
#pragma unroll
            for (int i = 0; i < 4; ++i) w[i] = p[i];
#pragma unroll
            for (int i = 0; i < 4; ++i) { t[8 * i] = bflo(w[i].x); t[8 * i + 1] = bfhi(w[i].x); t[8 * i + 2] = bflo(w[i].y); t[8 * i + 3] = bfhi(w[i].y); t[8 * i + 4] = bflo(w[i].z); t[8 * i + 5] = bfhi(w[i].z); t[8 * i + 6] = bflo(w[i].w); t[8 * i + 7] = bfhi(w[i].w); }
            const float posf = (float)IN_pos[tok];
#pragma unroll
            for (int i = 0; i < 16; ++i) { float c, s; rope_cs(posf, rope_rev(i), c, s);
                const int p1 = 8 * (i >> 2) + (i & 3), p2 = p1 + 4;
                o[p1] = t[i] * c - t[i + 16] * s; o[p2] = t[i + 16] * c + t[i] * s; }
#pragma unroll
            for (int i = 0; i < 4; ++i) { v4u q; q.x = pk2(o[8 * i], o[8 * i + 1]); q.y = pk2(o[8 * i + 2], o[8 * i + 3]); q.z = pk2(o[8 * i + 4], o[8 * i + 5]); q.w = pk2(o[8 * i + 6], o[8 * i + 7]); p[i] = q; }
        }
    }
    {
        const float* FLOG = WSP(float, WS_FLOG); float* FB = WSP(float, WS_FB);
        LAS float* wt = (LAS float*)(F.lds + RING_OFF);
        for (int bh = F.c; bh < NB * 4; bh += F.G) {
            const int b = bh >> 2, h = bh & 3; const float fb = IN_fb[l * 4 + h];
            float v[4]; float run = 0.f;
#pragma unroll
            for (int j = 0; j < 4; ++j) { const float xx = FLOG[((size_t)b * SEQ + 4 * F.tid + j) * 4 + h] + fb; const float ls = fminf(xx, 0.f) - log1pf(expf(-fabsf(xx))); run += ls; v[j] = run; }
            float inc = run;
#pragma unroll
            for (int o = 1; o < 64; o <<= 1) { const float n = __builtin_bit_cast(float, __builtin_amdgcn_ds_bpermute((F.lane - o) << 2, __builtin_bit_cast(int, inc))); if (F.lane >= o) inc += n; }
            if (F.lane == 63) wt[F.wave] = inc;
            __syncthreads();
            float base = inc - run;
            for (int w = 0; w < F.wave; ++w) base += wt[w];
#pragma unroll
            for (int j = 0; j < 4; ++j) FB[((size_t)b * 4 + h) * SEQ + 4 * F.tid + j] = -LOG2E * (base + v[j]);
            __syncthreads();
        }
    }
    for (int pm = F.c; pm < NTOK / 256; pm += F.G) {
        {
            const bool isq = F.lane < 24, iskv = (F.lane >= 32 && F.lane < 48), act = isq || iskv;
            const size_t coff = isq ? 8 * F.lane : PC_CKV + 8 * (F.lane & 15);
            GAS v4u* p0 = (GAS v4u*)(PROJ + ((size_t)pm * 256 + F.wave * 32) * PN + coff);
            v4u w[32];
#pragma unroll
            for (int jr = 0; jr < 32; ++jr) w[jr] = act ? *(p0 + (size_t)jr * (PN / 8)) : (v4u){0u, 0u, 0u, 0u};
#pragma unroll
            for (int jr = 0; jr < 32; ++jr) {
                const float a0 = bflo(w[jr].x), a1 = bfhi(w[jr].x), a2 = bflo(w[jr].y), a3 = bfhi(w[jr].y), a4 = bflo(w[jr].z), a5 = bfhi(w[jr].z), a6 = bflo(w[jr].w), a7 = bfhi(w[jr].w);
                float ss = (a0 * a0 + a1 * a1) + (a2 * a2 + a3 * a3) + (a4 * a4 + a5 * a5) + (a6 * a6 + a7 * a7);
                ss += shx(ss, 1, F.lane); ss += shx(ss, 2, F.lane); ss += shx(ss, 4, F.lane); ss += shx(ss, 8, F.lane); ss += shx(ss, 16, F.lane);
                const float rs = isq ? 1.f / sqrtf(ss * (1.f / 192.f) + EPS) : 1.f / sqrtf(ss * (1.f / 128.f) + EPS);
                if (act) { v4u o; o.x = pk2(a0 * rs, a1 * rs); o.y = pk2(a2 * rs, a3 * rs); o.z = pk2(a4 * rs, a5 * rs); o.w = pk2(a6 * rs, a7 * rs); *(p0 + (size_t)jr * (PN / 8)) = o; } }
        }
        VM_WAIT();
        __syncthreads();
        for (int part = 0; part < 2; ++part) {
            int po = part; asm volatile("" : "+s"(po));
            const int kof = po * 256, nof = po * 512;
            pg8::Gemm g{PROJ + kof, WSP(bf16, WS_WUP) + (size_t)l * NUP * KUP + (size_t)nof * KUP + kof, 256 - 128 * po, PN, 0, KUP};
            int nn2 = 2; asm volatile("" : "+s"(nn2));
            pg8::PanelOrder S{pm, nn2};
            EpiStoreBf16 E{WSP(bf16, WS_MLA) + nof, 1024, 0xffff};
            pg8::gemm_phase<EpiStoreBf16, pg8::PanelOrder, true, false>(F.lds + RING_OFF, g, S, E, F.tid);
            __syncthreads();
        }
    }
}

__device__ __forceinline__ int crow(int r, int hi) { return (r & 3) + 8 * (r >> 2) + 4 * hi; }
typedef short v4i16_t __attribute__((ext_vector_type(4)));
__device__ __forceinline__ s16x4 vtr(const LAS unsigned char* p) { return __builtin_bit_cast(s16x4, __builtin_amdgcn_ds_read_tr16_b64_v4i16((LAS v4i16_t*)p)); }
__device__ __forceinline__ float half_swap_max(float m) { auto rr = __builtin_amdgcn_permlane32_swap(__float_as_uint(m), __float_as_uint(m), false, false); return fmaxf(__uint_as_float(rr[0]), __uint_as_float(rr[1])); }
__device__ __forceinline__ float half_swap_sum(float m) { auto rr = __builtin_amdgcn_permlane32_swap(__float_as_uint(m), __float_as_uint(m), false, false); return __uint_as_float(rr[0]) + __uint_as_float(rr[1]); }
__device__ __forceinline__ bf16x8 pack8(const f32x16& p, int b0) {
    v4u w; w.x = pg8::cvt_pk_bf16(p[b0], p[b0 + 1]); w.y = pg8::cvt_pk_bf16(p[b0 + 2], p[b0 + 3]); w.z = pg8::cvt_pk_bf16(p[b0 + 4], p[b0 + 5]); w.w = pg8::cvt_pk_bf16(p[b0 + 6], p[b0 + 7]);
    return __builtin_bit_cast(bf16x8, w);
}
__device__ __forceinline__ void softmax_tile(f32x16& p0, f32x16& p1, float& m, float& lsum, f32x16& negm, const float cbase, f32x16& o0, f32x16& o1, const bool first) {
    float a = fmaxf(fmaxf(p0[0], p0[1]), p1[0]), b = fmaxf(fmaxf(p0[2], p0[3]), p1[1]); a = fmaxf(fmaxf(a, p1[2]), p1[3]);
#pragma unroll
    for (int r = 4; r < 16; r += 4) { a = fmaxf(fmaxf(a, p0[r]), p0[r + 1]); b = fmaxf(fmaxf(b, p0[r + 2]), p0[r + 3]); a = fmaxf(fmaxf(a, p1[r]), p1[r + 1]); b = fmaxf(fmaxf(b, p1[r + 2]), p1[r + 3]); }
    const float rm = half_swap_max(fmaxf(a, b));
    if (first || __any(rm > 8.f)) {
        const float dl = first ? rm : fmaxf(rm, 0.f); m += dl;
#pragma unroll
        for (int r = 0; r < 16; ++r) { p0[r] -= dl; p1[r] -= dl; negm[r] = cbase - m; }
        if (!first) { const float f = fast_exp2(-dl); lsum *= f;
#pragma unroll
            for (int r = 0; r < 16; ++r) { o0[r] *= f; o1[r] *= f; } }
    }
    float s0 = 0.f, s1 = 0.f;
#pragma unroll
    for (int r = 0; r < 16; ++r) { p0[r] = fast_exp2(p0[r]); p1[r] = fast_exp2(p1[r]); s0 += p0[r]; s1 += p1[r]; }
    lsum += s0 + s1;
}

constexpr int AT_KB = 16384, AT_VB = 8192, AT_TBL = 2 * AT_KB + 3 * AT_VB;

template <int MODE>
__device__ __forceinline__ void attn_unit(Frame& F, CArgs& A, int l, int b, int h, int qb) {
    const int tid = F.tid, lane = F.lane, wid = F.wave, r32 = lane & 31, hi = lane >> 5;
    constexpr int ND0 = (MODE == 0) ? 6 : (MODE == 1 ? 4 : 2);
    LAS unsigned char* kb0 = F.lds + RING_OFF; LAS unsigned char* vb0 = F.lds + RING_OFF + 2 * AT_KB; LAS float* tbl = (LAS float*)(F.lds + RING_OFF + AT_TBL);
    const size_t rowbase = (size_t)b * SEQ; const int q0 = qb * 256, NT = 4 * qb + 4, tw = 4 * qb + (wid >> 1), qw0 = q0 + 32 * wid;
    const bf16* PROJ = WSP(bf16, WS_PROJ); const bf16* MLA = WSP(bf16, WS_MLA);
    const bf16* Qp; const bf16* Kp; const bf16* Vp; int pitch;
    if (MODE == 0) { Qp = MLA + h * 96; Kp = MLA + 512 + h * 128; Vp = Kp + 64; pitch = 1024; }
    else if (MODE == 1) { Qp = PROJ + PC_FOX + h * 64; Kp = Qp + 256; Vp = Qp + 512; pitch = PN; }
    else { Qp = PROJ + PC_DIFF + h * 64; Kp = Qp + 256; Vp = Qp + 512; pitch = PN; }
    const int kkey = 8 * wid + (lane >> 3);
    const GAS bf16* ksrc = (const GAS bf16*)(Kp + (rowbase + kkey) * pitch + (((lane & 7) ^ ((kkey >> 1) & 7)) * 8));
    const int vkey = 8 * wid + (lane >> 3);
    const GAS bf16* vsrc = (const GAS bf16*)(Vp + (rowbase + vkey) * pitch + ((((lane & 7) >> 2) ^ ((vkey >> 1) & 1)) * 32) + (lane & 3) * 8);
    const int rkey = 16 * (wid & 3) + (lane >> 2);
    const GAS bf16* ksrc2 = (const GAS bf16*)(PROJ + (rowbase + rkey) * PN + PC_KROPE + (((lane & 3) ^ ((rkey >> 2) & 3)) * 8));
#define AT_DMA(t, kbo, vso) do { \
        __builtin_amdgcn_global_load_lds((const GAS unsigned*)(ksrc + (size_t)(t) * 64 * pitch), (LAS unsigned*)(kb0 + (kbo) + wid * 1024), 16, 0, 0); \
        __builtin_amdgcn_global_load_lds((const GAS unsigned*)(vsrc + (size_t)(t) * 64 * pitch), (LAS unsigned*)(vb0 + (vso) + wid * 1024), 16, 0, 0); \
        if (MODE == 0 && wid < 4) __builtin_amdgcn_global_load_lds((const GAS unsigned*)(ksrc2 + (size_t)(t) * 64 * PN), (LAS unsigned*)(kb0 + (kbo) + (8 + wid) * 1024), 16, 0, 0); } while (0)
    AT_DMA(0, 0, 0);
    if (MODE == 1) { const float* FBp = WSP(float, WS_FB) + ((size_t)b * 4 + h) * SEQ; if (4 * tid < NT * 64) *(LAS f32x4*)(tbl + 4 * tid) = *(const GAS f32x4*)(FBp + 4 * tid); }
    if (MODE == 2) { const float* T5p = WSP(float, WS_T5) + h * 2112; const float c0 = T5p[0]; for (int i = tid; i < 528; i += 512) *(LAS f32x4*)(tbl + 4 * i) = *(const GAS f32x4*)(T5p + 4 * i) - c0; }
    bf16x8 qf[(MODE == 2) ? 4 : ND0];
    { const bf16* Qw = Qp + (rowbase + qw0 + r32) * pitch + hi * 8;
#pragma unroll
      for (int d = 0; d < ((MODE == 2) ? 4 : ND0); ++d) qf[d] = *(const GAS bf16x8*)(Qw + d * 16); }
    if (MODE == 0) {
        const float posf = (float)IN_pos[rowbase + qw0 + r32];
#pragma unroll
        for (int j = 0; j < 2; ++j) { const v4u w = __builtin_bit_cast(v4u, qf[(MODE == 0) ? 4 + j : 0]);
            float t1[4] = {bflo(w.x), bfhi(w.x), bflo(w.y), bfhi(w.y)}, t2[4] = {bflo(w.z), bfhi(w.z), bflo(w.w), bfhi(w.w)};
#pragma unroll
            for (int i = 0; i < 4; ++i) { float c, s; rope_cs(posf, hi ? rope_rev(4 * (2 * j + 1) + i) : rope_rev(4 * (2 * j) + i), c, s); const float a = t1[i], bb = t2[i]; t1[i] = a * c - bb * s; t2[i] = bb * c + a * s; }
            v4u o; o.x = pk2(t1[0], t1[1]); o.y = pk2(t1[2], t1[3]); o.z = pk2(t2[0], t2[1]); o.w = pk2(t2[2], t2[3]);
            qf[(MODE == 0) ? 4 + j : 0] = __builtin_bit_cast(bf16x8, o); }
    }
    float m1 = 0.f, l1 = 0.f, m2 = 0.f, l2 = 0.f; f32x16 o1[2], o2[2], negm1;
    const float cbase = (MODE == 2) ? WSP(float, WS_T5)[h * 2112] : 0.f;
#pragma unroll
    for (int r = 0; r < 16; ++r) { o1[0][r] = 0.f; o1[1][r] = 0.f; o2[0][r] = 0.f; o2[1][r] = 0.f; negm1[r] = cbase; }
    const int vlane = ((lane >> 4) & 1) * 32 + (lane & 3) * 8 + (4 * hi + ((lane & 15) >> 2)) * 128 + ((lane >> 3) & 1) * 64;
    VM_WAIT();
    __syncthreads();
    const bool lag = false;
    bf16x8 dpa0, dpa1, dpa2, dpa3;
    dpa0 = dpa1 = dpa2 = dpa3 = (bf16x8){0, 0, 0, 0, 0, 0, 0, 0};
    const int vx64 = (vlane ^ 64) - vlane;
#define AT_PV(O, VB, A0, A1, A2, A3) do { bf16x8 vf[2][4]; \
        _Pragma("unroll") for (int d0 = 0; d0 < 2; ++d0) _Pragma("unroll") for (int ks = 0; ks < 4; ++ks) { const LAS unsigned char* vp_ = (VB) + (d0 ? vx64 : 0) + ks * 2048; const s16x4 lo = vtr(vp_), hh = vtr(vp_ + 1024); \
            vf[d0][ks] = (bf16x8){lo[0], lo[1], lo[2], lo[3], hh[0], hh[1], hh[2], hh[3]}; } \
        _Pragma("unroll") for (int d0 = 0; d0 < 2; ++d0) { O[d0] = __builtin_amdgcn_mfma_f32_32x32x16_bf16(vf[d0][0], A0, O[d0], 0, 0, 0); O[d0] = __builtin_amdgcn_mfma_f32_32x32x16_bf16(vf[d0][1], A1, O[d0], 0, 0, 0); \
            O[d0] = __builtin_amdgcn_mfma_f32_32x32x16_bf16(vf[d0][2], A2, O[d0], 0, 0, 0); O[d0] = __builtin_amdgcn_mfma_f32_32x32x16_bf16(vf[d0][3], A3, O[d0], 0, 0, 0); } } while (0)
    int vs_prev = 0, vs_cur = 0, vs_next = AT_VB;
    for (int t = 0; t < NT; ++t) {
        if (t + 1 < NT) AT_DMA(t + 1, ((t + 1) & 1) * AT_KB, vs_next);
        if (lag && t >= 1 && t - 1 <= tw) { const LAS unsigned char* vbp = vb0 + vs_prev + vlane; if (MODE == 2) AT_PV(o2, vbp, dpa0, dpa1, dpa2, dpa3); else AT_PV(o1, vbp, dpa0, dpa1, dpa2, dpa3); }
        if (t <= tw) {
            const LAS unsigned char* kb = kb0 + (t & 1) * AT_KB; const LAS unsigned char* vb = vb0 + vs_cur + vlane;
#pragma unroll
            for (int mp = 0; mp < ((MODE == 2) ? 2 : 1); ++mp) {
                f32x16 p0, p1, nmt;
                if (MODE == 2) { const float nv = cbase - (mp == 0 ? m1 : m2);
#pragma unroll
                    for (int r = 0; r < 16; ++r) nmt[r] = nv; }
#pragma unroll
                for (int d0 = 0; d0 < ND0; ++d0) { const int c = 2 * d0 + hi + ((MODE == 2) ? 4 * mp : 0);
                    const bool rope_ = (MODE == 0) && d0 >= 4;
                    const LAS unsigned char* ka = rope_ ? kb + 8192 + r32 * 64 + ((((c - 8) & 3) ^ ((r32 >> 2) & 3)) * 16) : kb + r32 * 128 + ((c ^ ((r32 >> 1) & 7)) * 16);
                    const bf16x8 k0 = *(const LAS bf16x8*)ka, k1 = *(const LAS bf16x8*)(ka + (rope_ ? 2048 : 4096));
                    if (d0 == 0) { p0 = __builtin_amdgcn_mfma_f32_32x32x16_bf16(k0, qf[(MODE == 2) ? 2 * mp + d0 : d0], (MODE == 2) ? nmt : negm1, 0, 0, 0);
                                   p1 = __builtin_amdgcn_mfma_f32_32x32x16_bf16(k1, qf[(MODE == 2) ? 2 * mp + d0 : d0], (MODE == 2) ? nmt : negm1, 0, 0, 0); }
                    else { p0 = __builtin_amdgcn_mfma_f32_32x32x16_bf16(k0, qf[(MODE == 2) ? 2 * mp + d0 : d0], p0, 0, 0, 0);
                           p1 = __builtin_amdgcn_mfma_f32_32x32x16_bf16(k1, qf[(MODE == 2) ? 2 * mp + d0 : d0], p1, 0, 0, 0); } }
                if (MODE == 1) {
#pragma unroll
                    for (int g4 = 0; g4 < 4; ++g4) { const f32x4 a = *(const LAS f32x4*)(tbl + 64 * t + 8 * g4 + 4 * hi), c = *(const LAS f32x4*)(tbl + 64 * t + 32 + 8 * g4 + 4 * hi);
                        p0[4 * g4] += a.x; p0[4 * g4 + 1] += a.y; p0[4 * g4 + 2] += a.z; p0[4 * g4 + 3] += a.w; p1[4 * g4] += c.x; p1[4 * g4 + 1] += c.y; p1[4 * g4 + 2] += c.z; p1[4 * g4 + 3] += c.w; }
                    if (t == tw) {
                        const int ql = 32 * (wid & 1) + r32;
#pragma unroll
                        for (int r = 0; r < 16; ++r) { const int kl = crow(r, hi); if (kl > ql) p0[r] = -1e30f; if (kl + 32 > ql) p1[r] = -1e30f; } }
                }
                if (MODE == 2 && 64 * t + 191 > qw0) {
                    const LAS float* tp = tbl + (64 * t - (qw0 + r32) + 2047 + 4 * hi);
#pragma unroll
                    for (int r = 0; r < 16; ++r) { p0[r] += tp[(r & 3) + 8 * (r >> 2)]; p1[r] += tp[32 + (r & 3) + 8 * (r >> 2)]; }
                }
                if (MODE == 2) { if (mp == 0) softmax_tile(p0, p1, m1, l1, nmt, cbase, o1[0], o1[1], t == 0); else softmax_tile(p0, p1, m2, l2, nmt, cbase, o2[0], o2[1], t == 0); }
                else softmax_tile(p0, p1, m1, l1, negm1, cbase, o1[0], o1[1], t == 0);
                const bf16x8 pa0 = pack8(p0, 0), pa1 = pack8(p0, 8), pa2 = pack8(p1, 0), pa3 = pack8(p1, 8);
                const bool lastmap = (mp == ((MODE == 2) ? 1 : 0));
                if (lastmap && lag) { dpa0 = pa0; dpa1 = pa1; dpa2 = pa2; dpa3 = pa3; }
                else { if (MODE == 2 && mp == 1) AT_PV(o2, vb, pa0, pa1, pa2, pa3); else AT_PV(o1, vb, pa0, pa1, pa2, pa3); }
            }
        }
        VM_WAIT();
        __syncthreads();
        vs_prev = vs_cur; vs_cur = vs_next; vs_next = (vs_next == 2 * AT_VB) ? 0 : vs_next + AT_VB;
    }
    if (lag && NT - 1 <= tw) { const LAS unsigned char* vbp = vb0 + vs_prev + vlane; if (MODE == 2) AT_PV(o2, vbp, dpa0, dpa1, dpa2, dpa3); else AT_PV(o1, vbp, dpa0, dpa1, dpa2, dpa3); }
    __syncthreads();
#undef AT_PV
#undef AT_DMA
    unsigned char* MIX = WSP(unsigned char, WS_MIX);
    const float inv1 = 1.f / half_swap_sum(l1);
    unsigned char* orow = MIX + (rowbase + qw0 + r32) * DM + ((MODE == 0) ? h * 64 : (MODE == 1) ? 256 + h * 64 : 768 + h * 64) + 8 * hi;
#define AT_ST8(V0, V1, V2, V3, V4, V5, V6, V7, DST) do { int wa_ = __builtin_amdgcn_cvt_pk_fp8_f32(clamp8(V0), clamp8(V1), 0, false); wa_ = __builtin_amdgcn_cvt_pk_fp8_f32(clamp8(V2), clamp8(V3), wa_, true); \
        int wb_ = __builtin_amdgcn_cvt_pk_fp8_f32(clamp8(V4), clamp8(V5), 0, false); wb_ = __builtin_amdgcn_cvt_pk_fp8_f32(clamp8(V6), clamp8(V7), wb_, true); \
        auto rr_ = __builtin_amdgcn_permlane32_swap((unsigned)wa_, (unsigned)wb_, false, false); v2u st_; st_.x = rr_[0]; st_.y = rr_[1]; *(GAS v2u*)(DST) = st_; } while (0)
    if (MODE != 2) {
        const float sc = inv1 * MIX8_SCALE;
#pragma unroll
        for (int d0 = 0; d0 < 2; ++d0)
#pragma unroll
            for (int j = 0; j < 4; j += 2)
                AT_ST8(o1[d0][4 * j] * sc, o1[d0][4 * j + 1] * sc, o1[d0][4 * j + 2] * sc, o1[d0][4 * j + 3] * sc, o1[d0][4 * j + 4] * sc, o1[d0][4 * j + 5] * sc, o1[d0][4 * j + 6] * sc, o1[d0][4 * j + 7] * sc, orow + 32 * d0 + 8 * j);
    } else {
        const float inv2 = 1.f / half_swap_sum(l2); const float lam = WSP(float, WS_LAM)[l]; const float li = 0.8f - 0.6f * expf(-0.3f * (float)l);
        const float c2 = lam * inv2; float ss = 0.f;
#pragma unroll
        for (int d0 = 0; d0 < 2; ++d0)
#pragma unroll
            for (int r = 0; r < 16; ++r) { const float v = o1[d0][r] * inv1 - o2[d0][r] * c2; o1[d0][r] = v; ss += v * v; }
        const float rsn = (1.f - li) / sqrtf(half_swap_sum(ss) * (1.f / 64.f) + EPS) * MIX8_SCALE;
        const float* sg = IN_subln + l * 64 + 4 * hi;
#pragma unroll
        for (int d0 = 0; d0 < 2; ++d0)
#pragma unroll
            for (int j = 0; j < 4; j += 2) { const f32x4 g4 = *(const GAS f32x4*)(sg + 32 * d0 + 8 * j), h4 = *(const GAS f32x4*)(sg + 32 * d0 + 8 * j + 8);
                AT_ST8(o1[d0][4 * j] * rsn * g4.x, o1[d0][4 * j + 1] * rsn * g4.y, o1[d0][4 * j + 2] * rsn * g4.z, o1[d0][4 * j + 3] * rsn * g4.w,
                       o1[d0][4 * j + 4] * rsn * h4.x, o1[d0][4 * j + 5] * rsn * h4.y, o1[d0][4 * j + 6] * rsn * h4.z, o1[d0][4 * j + 7] * rsn * h4.w, orow + 32 * d0 + 8 * j); }
    }
#undef AT_ST8
}

__device__ __forceinline__ void conv_unit(Frame& F, CArgs& A, int l, int tile) {
    const bf16* PROJ = WSP(bf16, WS_PROJ); unsigned char* MIX = WSP(unsigned char, WS_MIX);
    const int c8 = (F.tid & 31) * 8, rsub = F.tid >> 5;
    float w0[8], w1[8], w2[8];
#pragma unroll
    for (int i = 0; i < 8; ++i) { w0[i] = IN_conv_w[(l * 3 + 0) * 256 + c8 + i]; w1[i] = IN_conv_w[(l * 3 + 1) * 256 + c8 + i]; w2[i] = IN_conv_w[(l * 3 + 2) * 256 + c8 + i]; }
    for (int j = 0; j < 16; ++j) {
        const size_t row = (size_t)tile * 256 + rsub + 16 * j; const int s = (int)(row & (SEQ - 1));
        const bf16* pr = PROJ + row * PN + PC_CONV + c8;
        const v4u bb = *(const GAS v4u*)pr, c0 = *(const GAS v4u*)(pr + 256), u0 = *(const GAS v4u*)(pr + 512);
        v4u c1 = (v4u){0u, 0u, 0u, 0u}, u1 = c1, c2 = c1, u2 = c1;
        if (s >= 1) { c1 = *(const GAS v4u*)(pr - PN + 256); u1 = *(const GAS v4u*)(pr - PN + 512); }
        if (s >= 2) { c2 = *(const GAS v4u*)(pr - 2 * PN + 256); u2 = *(const GAS v4u*)(pr - 2 * PN + 512); }
        float o[8];
#define CV(i, W, sel) { const float z0 = sel(c0.W) * sel(u0.W), z1 = sel(c1.W) * sel(u1.W), z2 = sel(c2.W) * sel(u2.W); o[i] = sel(bb.W) * (w2[i] * z0 + w1[i] * z1 + w0[i] * z2); }
        CV(0, x, bflo) CV(1, x, bfhi) CV(2, y, bflo) CV(3, y, bfhi) CV(4, z, bflo) CV(5, z, bfhi) CV(6, w, bflo) CV(7, w, bfhi)
#undef CV
        *(GAS v2u*)(MIX + row * DM + 512 + c8) = pack_fp8x8(o[0] * MIX8_SCALE, o[1] * MIX8_SCALE, o[2] * MIX8_SCALE, o[3] * MIX8_SCALE, o[4] * MIX8_SCALE, o[5] * MIX8_SCALE, o[6] * MIX8_SCALE, o[7] * MIX8_SCALE);
    }
}

#define CONV_ROUND() do { { if (F.tid == 0) F.MISC[1] = __hip_atomic_fetch_add(F.ctl + CW_Q + 64 * l + 48, 8u, RLX_AGENT); __syncthreads(); const int it_ = (int)F.MISC[1] + F.wave; __syncthreads(); \
        if (it_ < cvn) { Frame F2 = F; F2.lane = opq(F.lane); int w2_ = F.wave; asm volatile("" : "+s"(w2_)); const bool moe_ = it_ < CV_MOE; convert_item(F2, A, moe_ ? l : l + 1, moe_ ? CV_DENSE + it_ : it_ - CV_MOE, (LAS float*)(F.lds + RING_OFF) + w2_ * (64 * 65)); } __syncthreads(); } } while (0)
#define ATTN_LOOP(TYPE, MODE_, EXTRA) for (int qx_ = 0; qx_ < 8; ) { const int xq_ = (myx + qx_) & 7; \
        if (F.tid == 0) F.MISC[0] = __hip_atomic_fetch_add(F.ctl + CW_QX + (((l * 3 + (TYPE)) * 8 + xq_) << 4), 1u, RLX_AGENT); \
        __syncthreads(); const int idx = __builtin_amdgcn_readfirstlane((int)F.MISC[0]); __syncthreads(); \
        if (idx >= 128) { ++qx_; continue; } \
        constexpr int GB_ = ((TYPE) == 2) ? 4 : 3;            \
        int id2_ = (idx & ((1 << GB_) - 1)) | (((idx >> (GB_ + 3)) << GB_) & 15) | (((idx >> GB_) & 7) << 4); asm volatile("" : "+s"(id2_)); const int qb = 7 - (id2_ >> 4), bh = xq_ * 16 + (id2_ & 15); attn_unit<MODE_>(F, A, l, bh >> 2, bh & 3, qb); EXTRA }
__device__ __forceinline__ void attn_phase(Frame& F, CArgs& A, int l) {
    const int cvn = (l + 1 < DEPTH) ? CV_LAYER : CV_MOE; const int myx = (int)xb_xcc_id() & 7;
    int nd = 0;
    ATTN_LOOP(0, 2, if (nd == (F.c & 3)) { for (int rr = 0; rr < 13; ++rr) CONV_ROUND(); } ++nd;)
    ATTN_LOOP(1, 0, )
    ATTN_LOOP(2, 1, )
    for (int tile = F.c; tile < NTOK / 256; tile += F.G) conv_unit(F, A, l, tile);
    for (;;) {
        if (F.tid == 0) F.MISC[1] = __hip_atomic_fetch_add(F.ctl + CW_Q + 64 * l + 48, 8u, RLX_AGENT);
        __syncthreads(); const int it0 = (int)F.MISC[1]; __syncthreads();
        if (it0 >= cvn) break;
        const int it1 = it0 + F.wave; const bool moe1 = it1 < CV_MOE;
        if (it1 < cvn) convert_item(F, A, moe1 ? l : l + 1, moe1 ? CV_DENSE + it1 : it1 - CV_MOE, (LAS float*)(F.lds + RING_OFF) + F.wave * (64 * 65));
        __syncthreads(); }
}

__device__ __forceinline__ void ffn_router_phase(Frame& F, CArgs& A, int l) {
    const float* MOD = WSP(float, WS_MOD); const bf16* WRT = WSP(bf16, WS_WRT) + (size_t)l * 2 * NLOG * DM; const float* SSp = WSP(float, WS_SS);
    bf16* H = WSP(bf16, WS_H); int* DEST = WSP(int, WS_DEST); float* GATE = WSP(float, WS_GATE); int* LIST = WSP(int, WS_LIST);
    LAS float* G2P = (LAS float*)(F.lds + RING_OFF); LAS float* SHF = G2P + 1024; LAS float* SHWB = G2P + 2048; LAS int* hist = (LAS int*)(G2P + 2176); LAS int* base = hist + 64;
    LAS int* rinfo = (LAS int*)(G2P + 2304);
    LAS unsigned char* WST = F.lds + RING_OFF + 20480;
    LAS float* LG = (LAS float*)WST + F.wave * 2560;
    const int tk = F.lane & 15, kg = F.lane >> 4;
    for (int tile = F.c; tile < NTOK / 256; tile += F.G) {
        const int b = tile >> 3;
#define RT_DMA(st, bufo) do { _Pragma("unroll") for (int q = 0; q < 5; ++q) { const int j = F.wave * 5 + q, sp = j / 10, hl = (j % 10) / 5, nb = j % 5; \
            __builtin_amdgcn_global_load_lds((const GAS unsigned*)(WRT + (size_t)(hl * NLOG + 16 * nb + (F.lane >> 2)) * DM + 128 * (st) + 32 * sp + 8 * (F.lane & 3)), (LAS unsigned*)(WST + (bufo) + j * 1024), 16, 0, 0); } } while (0)
        RT_DMA(0, 0);
        for (int k = F.tid; k < DM; k += 512) { G2P[k] = IN_g_ffn[l * DM + k] * (1.f + MOD[((size_t)l * NB + b) * 6144 + 4 * 1024 + k]); SHF[k] = MOD[((size_t)l * NB + b) * 6144 + 3 * 1024 + k]; }
        if (F.tid < 64) hist[F.tid] = 0;
        __syncthreads();
        if (F.tid < NLOG) SHWB[F.tid] = WSP(float, WS_SHWB)[((size_t)l * NB + b) * NLOG + F.tid];
        const size_t rowA = (size_t)tile * 256 + F.wave * 32 + tk, rowB = rowA + 16;
        float rsA, rsB;
        { const f32x4 a0 = *(const GAS f32x4*)(SSp + rowA * 16), a1 = *(const GAS f32x4*)(SSp + rowA * 16 + 4), a2 = *(const GAS f32x4*)(SSp + rowA * 16 + 8), a3 = *(const GAS f32x4*)(SSp + rowA * 16 + 12);
          const f32x4 b0 = *(const GAS f32x4*)(SSp + rowB * 16), b1 = *(const GAS f32x4*)(SSp + rowB * 16 + 4), b2 = *(const GAS f32x4*)(SSp + rowB * 16 + 8), b3 = *(const GAS f32x4*)(SSp + rowB * 16 + 12);
          const float sa = (((a0.x + a0.y) + (a0.z + a0.w)) + ((a1.x + a1.y) + (a1.z + a1.w))) + (((a2.x + a2.y) + (a2.z + a2.w)) + ((a3.x + a3.y) + (a3.z + a3.w)));
          const float sb = (((b0.x + b0.y) + (b0.z + b0.w)) + ((b1.x + b1.y) + (b1.z + b1.w))) + (((b2.x + b2.y) + (b2.z + b2.w)) + ((b3.x + b3.y) + (b3.z + b3.w)));
          rsA = 1.f / sqrtf(sa * (1.f / DM) + EPS); rsB = 1.f / sqrtf(sb * (1.f / DM) + EPS); }
        f32x4 acc[2][5];
#pragma unroll
        for (int rb = 0; rb < 2; ++rb)
#pragma unroll
            for (int nb = 0; nb < 5; ++nb) acc[rb][nb] = (f32x4){0.f, 0.f, 0.f, 0.f};
        const f16* xa = WSP(f16, WS_XR) + rowA * DM + 8 * kg; const f16* xb = WSP(f16, WS_XR) + rowB * DM + 8 * kg;
        f16x8 nxa = *(const GAS f16x8*)(xa), nxb = *(const GAS f16x8*)(xb);
        for (int st = 0; st < 8; ++st) {
            if (st == 0) VM_WAIT(); else asm volatile("s_waitcnt vmcnt(16)" ::: "memory");
            __syncthreads();
            if (st + 1 < 8) RT_DMA(st + 1, ((st + 1) & 1) * 40960);
            const LAS unsigned char* wb = WST + (st & 1) * 40960 + (tk * 4 + kg) * 16;
#pragma unroll
            for (int sp = 0; sp < 4; ++sp) {
                const int s = 4 * st + sp, k = 32 * s + 8 * kg;
                const f32x4 xa0 = (f32x4){(float)nxa[0], (float)nxa[1], (float)nxa[2], (float)nxa[3]}, xa1 = (f32x4){(float)nxa[4], (float)nxa[5], (float)nxa[6], (float)nxa[7]}, xb0 = (f32x4){(float)nxb[0], (float)nxb[1], (float)nxb[2], (float)nxb[3]}, xb1 = (f32x4){(float)nxb[4], (float)nxb[5], (float)nxb[6], (float)nxb[7]};
                if (s + 1 < 32) { nxa = *(const GAS f16x8*)(xa + 32 * (s + 1)); nxb = *(const GAS f16x8*)(xb + 32 * (s + 1)); }
                const f32x4 g0 = *(const LAS f32x4*)(G2P + k), g1 = *(const LAS f32x4*)(G2P + k + 4), h0 = *(const LAS f32x4*)(SHF + k), h1 = *(const LAS f32x4*)(SHF + k + 4);
                const f32x4 ua0 = xa0 * g0, ua1 = xa1 * g1, ub0 = xb0 * g0, ub1 = xb1 * g1;
                { const f32x4 a0 = ua0 * rsA + h0, a1 = ua1 * rsA + h1, b0 = ub0 * rsB + h0, b1 = ub1 * rsB + h1;
                  unsigned char* H8 = WSP(unsigned char, WS_H8);
                  *(GAS v2u*)(H8 + rowA * DM + k) = pack_fp8x8(a0.x * A8_SCALE, a0.y * A8_SCALE, a0.z * A8_SCALE, a0.w * A8_SCALE, a1.x * A8_SCALE, a1.y * A8_SCALE, a1.z * A8_SCALE, a1.w * A8_SCALE);
                  *(GAS v2u*)(H8 + rowB * DM + k) = pack_fp8x8(b0.x * A8_SCALE, b0.y * A8_SCALE, b0.z * A8_SCALE, b0.w * A8_SCALE, b1.x * A8_SCALE, b1.y * A8_SCALE, b1.z * A8_SCALE, b1.w * A8_SCALE); }
                bf16x8 hA, lA, hB, lB;
#define SPLIT2(HW, LW, X, Y) { HW = pg8::cvt_pk_bf16(X, Y); LW = pg8::cvt_pk_bf16(X - __builtin_bit_cast(float, HW << 16), Y - __builtin_bit_cast(float, HW & 0xffff0000u)); }
#define SPLIT8(H_, L_, U0, U1) { v4u hw, lw; SPLIT2(hw.x, lw.x, U0.x, U0.y) SPLIT2(hw.y, lw.y, U0.z, U0.w) SPLIT2(hw.z, lw.z, U1.x, U1.y) SPLIT2(hw.w, lw.w, U1.z, U1.w) \
                H_ = __builtin_bit_cast(bf16x8, hw); L_ = __builtin_bit_cast(bf16x8, lw); }
                SPLIT8(hA, lA, ua0, ua1) SPLIT8(hB, lB, ub0, ub1)
#undef SPLIT8
#undef SPLIT2
#pragma unroll
                for (int nb = 0; nb < 5; ++nb) {
                    const bf16x8 wh = *(const LAS bf16x8*)(wb + ((sp * 2 + 0) * 5 + nb) * 1024), wl = *(const LAS bf16x8*)(wb + ((sp * 2 + 1) * 5 + nb) * 1024);
                    acc[0][nb] = __builtin_amdgcn_mfma_f32_16x16x32_bf16(wh, hA, acc[0][nb], 0, 0, 0); acc[0][nb] = __builtin_amdgcn_mfma_f32_16x16x32_bf16(wh, lA, acc[0][nb], 0, 0, 0); acc[0][nb] = __builtin_amdgcn_mfma_f32_16x16x32_bf16(wl, hA, acc[0][nb], 0, 0, 0);
                    acc[1][nb] = __builtin_amdgcn_mfma_f32_16x16x32_bf16(wh, hB, acc[1][nb], 0, 0, 0); acc[1][nb] = __builtin_amdgcn_mfma_f32_16x16x32_bf16(wh, lB, acc[1][nb], 0, 0, 0); acc[1][nb] = __builtin_amdgcn_mfma_f32_16x16x32_bf16(wl, hB, acc[1][nb], 0, 0, 0);
                }
            }
        }
#undef RT_DMA
        __syncthreads();
#pragma unroll
        for (int nb = 0; nb < 5; ++nb) { const f32x4 sb = *(const LAS f32x4*)(SHWB + 16 * nb + 4 * kg);
            *(LAS f32x4*)(LG + tk * NLOG + 16 * nb + 4 * kg) = acc[0][nb] * rsA + sb; *(LAS f32x4*)(LG + (16 + tk) * NLOG + 16 * nb + 4 * kg) = acc[1][nb] * rsB + sb; }
        LDS_WAIT(); asm volatile("" ::: "memory");
        if (F.lane < 32) {
            const LAS float* lg = LG + F.lane * NLOG;
            float gl[8];
#pragma unroll
            for (int j = 0; j < 8; ++j) gl[j] = lg[j];
            int g = 0; float mx = gl[0];
#pragma unroll
            for (int j = 1; j < 8; ++j) if (gl[j] > mx) { mx = gl[j]; g = j; }
            float Z = 0.f;
#pragma unroll
            for (int j = 0; j < 8; ++j) Z += expf(gl[j] - mx);
            const float pg = 1.f / Z;
            const LAS float* el = lg + 8 + 8 * g; float ev[8];
#pragma unroll
            for (int j = 0; j < 8; ++j) ev[j] = el[j];
            int i1 = 0; float m1v = ev[0];
#pragma unroll
            for (int j = 1; j < 8; ++j) if (ev[j] > m1v) { m1v = ev[j]; i1 = j; }
            int i2 = -1; float m2v = -3.0e38f;
#pragma unroll
            for (int j = 0; j < 8; ++j) if (j != i1 && ev[j] > m2v) { m2v = ev[j]; i2 = j; }
            float one_ = 1.f; asm("" : "+s"(one_));
            const float eb = expf(m2v - m1v), den = 1.f / __builtin_fmaf(eb, one_, 1.f);
            const int e0 = 8 * g + i1, e1 = 8 * g + i2;
            const int r0 = __hip_atomic_fetch_add(hist + e0, 1, __ATOMIC_RELAXED, __HIP_MEMORY_SCOPE_WORKGROUP), r1 = __hip_atomic_fetch_add(hist + e1, 1, __ATOMIC_RELAXED, __HIP_MEMORY_SCOPE_WORKGROUP);
            LAS int* ri = rinfo + (F.wave * 32 + F.lane) * 8;
            ri[0] = e0; ri[1] = r0; ri[2] = e1; ri[3] = r1; ri[4] = __float_as_int(pg * den); ri[5] = __float_as_int(pg * eb * den);
        }
        __syncthreads();
        if (F.tid < 64) { const int hc = hist[F.tid]; base[F.tid] = hc ? (int)__hip_atomic_fetch_add(F.ctl + CW_GCNT + (l * 64 + F.tid) * 16, (unsigned)hc, RLX_AGENT) : 0; }
        __syncthreads();
        if (F.tid < 256) { const LAS int* ri = rinfo + F.tid * 8; const size_t row = (size_t)tile * 256 + F.tid;
            const int e0 = ri[0], s0 = base[e0] + ri[1], e1 = ri[2], s1 = base[e1] + ri[3];
            LIST[(size_t)e0 * 65536 + s0] = (int)row; LIST[(size_t)e1 * 65536 + s1] = (int)row;
            *(GAS i32x4*)(DEST + row * 4) = (i32x4){e0, s0, e1, s1}; *(GAS f32x2*)(GATE + row * 2) = (f32x2){__int_as_float(ri[4]), __int_as_float(ri[5])}; }
        __syncthreads();
    }
}

template <bool GATHER_TOK>
__device__ __forceinline__ int moe_build_tables(Frame& F, int l, int chunk) {
    LAS int* ut = (LAS int*)(F.lds + UT_OFF); LAS unsigned* tokt = (LAS unsigned*)(F.lds + TAB_OFF);
    const LAS int* mbs = (const LAS int*)(F.lds + UT_OFF + 256); const LAS int* cnts = mbs + 72;
    const int NU = 4 * mbs[64];
    if (F.tid < 16) {
        const int i = F.tid + 16 * chunk; int e = 0, mbid = 0, pnl = 0; bool ok;
        if ((F.G & 31) == 0) { const int q = F.G >> 5; mbid = i * (F.G >> 2) + (F.c & 7) * q + ((F.c >> 3) % q); pnl = (F.c >> 3) / q; ok = mbid < (NU >> 2); }
        else { const int U = F.c + i * F.G; mbid = U >> 2; pnl = U & 3; ok = U < NU; }
        if (ok) { for (int j = 1; j < 64; ++j) if (mbs[j] <= mbid) e = j; }
        ut[4 * F.tid] = mbid; ut[4 * F.tid + 1] = e * 4 + pnl; ut[4 * F.tid + 2] = F.tid; ut[4 * F.tid + 3] = ok ? e : -1; }
    __syncthreads();
    int n = 0;
    for (int i = 0; i < 16; ++i) if (ut[4 * i + 3] >= 0) n = i + 1;
    if (GATHER_TOK) {
        const int* LIST = WSP(int, WS_LIST);
        for (int i = F.tid >> 8; i < n; i += 2) { const int e = ut[4 * i + 3], mbid = ut[4 * i], sl = F.tid & 255; const int s = 256 * (mbid - mbs[e]) + sl;
            tokt[i * 256 + sl] = (s < cnts[e]) ? (unsigned)LIST[(size_t)e * 65536 + s] : 0u; }
    }
    __syncthreads();
    return n;
}
__device__ __forceinline__ void moe_gateup_phase(Frame& F, int l) {
    moe_block_starts(F, l);
    const int NU = 4 * ((const LAS int*)(F.lds + UT_OFF + 256))[64];
    for (int chunk = 0; chunk * 16 * F.G < NU; ++chunk) {
        const int n = moe_build_tables<true>(F, l, chunk);
        pg8::Gemm g{WSP(bf16, WS_H8), (const bf16*)(WSP(unsigned char, WS_WGU) + (size_t)l * NEXP * 1024 * 1024), DM / 2, DM / 2, A8_E8M0};
        pg8::TableOrder S{(const LAS int*)(F.lds + UT_OFF), (const LAS unsigned*)(F.lds + TAB_OFF), n};
        EpiGateUp E{WSP(unsigned char, WS_HID)};
        pg8::gemm_phase<EpiGateUp, pg8::TableOrder, true, true, true>(F.lds + RING_OFF, g, S, E, F.tid);
        __syncthreads();
    }
}
__device__ __forceinline__ void moe_down_phase(Frame& F, int l) {
    moe_block_starts(F, l);
    const int NU = 4 * ((const LAS int*)(F.lds + UT_OFF + 256))[64];
    for (int chunk = 0; chunk * 16 * F.G < NU; ++chunk) {
        const int n = moe_build_tables<false>(F, l, chunk);
        pg8::Gemm g{WSP(bf16, WS_HID), (const bf16*)(WSP(unsigned char, WS_WD) + (size_t)l * NEXP * 1024 * DEXP), DEXP / 2, DEXP / 2, HID8_E8M0};
        pg8::TableOrder S{(const LAS int*)(F.lds + UT_OFF), (const LAS unsigned*)(F.lds + TAB_OFF), n};
        EpiStoreFp8 E{WSP(unsigned char, WS_Y), DM, 3, Y8_SCALE};
        pg8::gemm_phase<EpiStoreFp8, pg8::TableOrder, true, false, true>(F.lds + RING_OFF, g, S, E, F.tid);
        __syncthreads();
    }
}

template <int PHSEL>
__global__ void __launch_bounds__(512, 2) trunk_fwd(Args args) {
    extern __shared__ __attribute__((aligned(16))) unsigned char lds_raw[];
    Frame F;
    F.lds = (LAS unsigned char*)lds_raw; F.MISC = (volatile LAS unsigned*)(F.lds + MISC_OFF);
    F.tid = threadIdx.x; F.lane = F.tid & 63; F.wave = __builtin_amdgcn_readfirstlane(F.tid >> 6); F.G = gridDim.x; F.c = blockIdx.x;
    const int wave0 = F.wave;
    F.ws = args.ws; F.out = args.out; F.ctl = (gu32*)(args.ws + WS_CTL);
    for (int u = F.tid; u < 32; u += 512) F.MISC[u] = 0u;
    __syncthreads();
    const int lo = args.ph_lo, hi = args.ph_hi;
    if (hi - lo > 1) (void)xcd_barrier_post((unsigned*)(F.ctl + CW_BAR), F.MISC + 8);
#define EN(j) (PHSEL < 0 || PHSEL == (j))
#define PB() CArgs* Ap_ = (CArgs*)__builtin_amdgcn_kernarg_segment_ptr(); asm volatile("" : "+s"(Ap_)); CArgs& A_ = *Ap_; do { { int c_ = (int)blockIdx.x, g_ = (int)gridDim.x, w_ = wave0; asm volatile("" : "+s"(c_), "+s"(g_), "+s"(w_)); F.c = c_; F.G = g_; F.wave = w_; } { int ln_; asm volatile("v_mbcnt_lo_u32_b32 %0, -1, 0\n\tv_mbcnt_hi_u32_b32 %0, -1, %0" : "=v"(ln_)); F.lane = ln_; } F.tid = F.wave * 64 + F.lane; F.ws = A_.ws; F.out = A_.out; F.ctl = (gu32*)(A_.ws + WS_CTL); } while (0)
#define IN(k) (lo <= (k) && (k) < hi)
#ifdef PROBE_MASK
    unsigned long long pt_acc = 0ull, pt_t0 = 0ull;
#define PT0() do { pt_t0 = __builtin_amdgcn_s_memrealtime(); } while (0)
#define PT1(j) do { if ((PROBE_MASK >> (j)) & 1) pt_acc += __builtin_amdgcn_s_memrealtime() - pt_t0; } while (0)
#else
#define PT0() do {} while (0)
#define PT1(j) do {} while (0)
#endif
#define SEAM(k) do { if (IN(k) && IN((k) + 1)) { XcdBarrier b_; b_.bar = (unsigned*)(F.ctl + CW_BAR); b_.x = xb_xcc_id(); b_.st = F.MISC + 8; xcd_barrier(b_); } } while (0)
    if (EN(0) && IN(0)) { PB(); PT0(); prologue(F, A_); SEAM(0); PT1(0); }
    for (int l = 0; l < DEPTH; ++l) {
        const int p0 = 1 + 8 * l;
        if (EN(1) && IN(p0)) { PB(); PT0(); int lq = l; asm volatile("" : "+s"(lq)); if (lq == 0) mix_norm_phase<false, false>(F, A_, lq); else mix_norm_phase<false, true>(F, A_, lq); SEAM(p0); PT1(1); }
        if (EN(2) && IN(p0 + 1)) { PB(); PT0(); int lq = l; asm volatile("" : "+s"(lq));
            pg8::Gemm g{WSP(bf16, WS_H), WSP(bf16, WS_WIN) + (size_t)lq * PN * DM, DM, DM}; pg8::StaticOrder S; S.init(NTOK, PN, F.G, F.c);
            EpiStoreBf16 E{WSP(bf16, WS_PROJ), PN, 0xffff};
            pg8::gemm_phase<EpiStoreBf16, pg8::StaticOrder, true, false>(F.lds + RING_OFF, g, S, E, F.tid);
            SEAM(p0 + 1); PT1(2); }
        if (EN(3) && IN(p0 + 2)) { PB(); PT0(); int lq = l; asm volatile("" : "+s"(lq)); mla_up_phase(F, A_, lq); SEAM(p0 + 2); PT1(3); }
        if (EN(4) && IN(p0 + 3)) { PB(); PT0(); int lq = l; asm volatile("" : "+s"(lq)); attn_phase(F, A_, lq); SEAM(p0 + 3); PT1(4); }
        if (EN(5) && IN(p0 + 4)) { PB(); PT0(); int lq = l; asm volatile("" : "+s"(lq));
            pg8::Gemm g{WSP(bf16, WS_MIX), (const bf16*)(WSP(unsigned char, WS_WOUT) + (size_t)lq * DM * DM), DM / 2, DM / 2, MIX8_E8M0}; pg8::StaticOrder S; S.init(NTOK, DM, F.G, F.c);
            EpiOut E{lq == 0 ? (const float*)A_.in[0] : nullptr, WSP(f16, WS_XR), WSP(f16, WS_XR), WSP(float, WS_MOD) + (size_t)lq * NB * 6144 + 2 * 1024, WSP(float, WS_SS)};
            pg8::gemm_phase<EpiOut, pg8::StaticOrder, true, false, true>(F.lds + RING_OFF, g, S, E, F.tid);
            SEAM(p0 + 4); PT1(5); }
        if (EN(6) && IN(p0 + 5)) { PB(); PT0(); int lq = l; asm volatile("" : "+s"(lq)); ffn_router_phase(F, A_, lq); SEAM(p0 + 5); PT1(6); }
        if (EN(7) && IN(p0 + 6)) { PB(); PT0(); int lq = l; asm volatile("" : "+s"(lq)); moe_gateup_phase(F, lq); SEAM(p0 + 6); PT1(7); }
        if (EN(8) && IN(p0 + 7)) { PB(); PT0(); int lq = l; asm volatile("" : "+s"(lq)); moe_down_phase(F, lq); SEAM(p0 + 7); PT1(8); }
    }
    if (EN(9) && IN(NPHASE - 1)) { PB(); PT0(); mix_norm_phase<true, true>(F, A_, DEPTH); PT1(9);
#ifdef PROBE_MASK
        __syncthreads(); VM_WAIT(); if (blockIdx.x == 0 && F.tid == 0) F.out[0] += (float)pt_acc * (0.01f / 20.f);
#endif
    }
#undef IN
#undef SEAM
}

extern "C" void kernel_launch(void* const* d_in, const int* in_sizes, int n_in, void* d_out, int out_size, void* d_ws, size_t ws_size, hipStream_t stream) {
    static int grid = 0;
    if (grid == 0) {
        if (n_in != 26 || out_size != NTOK * DM || ws_size < WS_END) { fprintf(stderr, "kernel_launch: unexpected shapes (n_in %d, out %d, ws %zu < %zu); nothing launched\n", n_in, out_size, ws_size, (size_t)WS_END); grid = -1; return; }
        int dev = 0, cus = 0, per_cu = 0;
        if (hipGetDevice(&dev) != hipSuccess || hipDeviceGetAttribute(&cus, hipDeviceAttributeMultiprocessorCount, dev) != hipSuccess) { grid = -1; return; }
#if MK_MULTI
#define SA(T) if (hipFuncSetAttribute((const void*)trunk_fwd<T>, hipFuncAttributeMaxDynamicSharedMemorySize, LDS_BYTES) != hipSuccess) { fprintf(stderr, "kernel_launch: hipFuncSetAttribute failed\n"); grid = -1; return; }
        SA(0) SA(1) SA(2) SA(3) SA(4) SA(5) SA(6) SA(7) SA(8) SA(9)
#undef SA
#else
        if (hipFuncSetAttribute((const void*)trunk_fwd<-1>, hipFuncAttributeMaxDynamicSharedMemorySize, LDS_BYTES) != hipSuccess) { fprintf(stderr, "kernel_launch: hipFuncSetAttribute failed\n"); grid = -1; return; }
        if (hipOccupancyMaxActiveBlocksPerMultiprocessor(&per_cu, (const void*)trunk_fwd<-1>, 512, LDS_BYTES) != hipSuccess || per_cu < 1) { fprintf(stderr, "kernel_launch: occupancy query says %d\n", per_cu); (void)hipGetLastError(); }
#endif
        (void)per_cu;
        grid = cus;
    }
    if (grid < 0) return;
    (void)hipMemsetAsync((char*)d_ws + WS_CTL, 0, CTL_ZERO_BYTES, stream);
    Args a{};
    for (int i = 0; i < 26; ++i) a.in[i] = d_in[i];
    a.out = (float*)d_out; a.ws = (unsigned char*)d_ws;
#if MK_MULTI
    for (int p = 0; p < NPHASE; ++p) { a.ph_lo = p; a.ph_hi = p + 1; const int ty = (p == 0) ? 0 : (p == NPHASE - 1) ? 9 : 1 + (p - 1) % 8;
        switch (ty) {
#define LK(T) case T: hipLaunchKernelGGL(trunk_fwd<T>, dim3(grid), dim3(512), LDS_BYTES, stream, a); break;
            LK(0) LK(1) LK(2) LK(3) LK(4) LK(5) LK(6) LK(7) LK(8) LK(9)
#undef LK
        } }
#else
    a.ph_lo = 0; a.ph_hi = NPHASE;
    hipLaunchKernelGGL(trunk_fwd<-1>, dim3(grid), dim3(512), LDS_BYTES, stream, a);
#endif
    const hipError_t le = hipPeekAtLastError();
    if (le != hipSuccess) fprintf(stderr, "kernel_launch: launch failed: %s\n", hipGetErrorName(le));
}
```
